# Optimizing an MI355X kernel written in HIP

```python
import math
import jax
import jax.numpy as jnp
from jax import lax
import numpy as np

D_MODEL = 1024
BATCH = 4
SEQ = 8192
DEPTH = 2

GDN_HEADS = 4
GDN_DK = 128
GDN_DV = 128
GDN_CONV = 5
GDN_CHUNK = 64
MLA_HEADS = 8
MLA_NOPE = 64
MLA_ROPE = 32
MLA_V = 64
MLA_Q_LORA = 384
MLA_KV_LORA = 256
MLA_QBLOCK = 128
ROPE_THETA = 10000.0
D_FF = 2816
RES_HALF = 0.5
N_BRANCH = 2
EPS = 1e-6

GDN_QK = GDN_HEADS * GDN_DK
GDN_VW = GDN_HEADS * GDN_DV
MLA_QK = MLA_NOPE + MLA_ROPE
MLA_OUT = MLA_HEADS * MLA_V
IN_SPLITS = (GDN_QK, GDN_QK, GDN_VW, GDN_VW, 2 * GDN_HEADS, 2 * GDN_HEADS,
             MLA_Q_LORA, MLA_KV_LORA, MLA_ROPE, N_BRANCH * D_MODEL)
D_IN = sum(IN_SPLITS)

kernel_name = "hybrid_gdn_mla_macaron_encoder"


def rmsnorm(x, w):
    xf = x.astype(jnp.float32)
    y = xf * lax.rsqrt(jnp.mean(xf * xf, axis=-1, keepdims=True) + EPS)
    return (y * w.astype(jnp.float32)).astype(x.dtype)


def l2norm(x):
    xf = x.astype(jnp.float32)
    return (xf * lax.rsqrt(jnp.sum(xf * xf, axis=-1, keepdims=True) + EPS)).astype(x.dtype)


def swiglu(x, w_gate, w_up, w_down):
    return (jax.nn.silu(x @ w_gate) * (x @ w_up)) @ w_down


def split_cols(t):
    parts, start = [], 0
    for width in IN_SPLITS:
        parts.append(t[..., start:start + width])
        start += width
    return parts


def centred_short_conv(x, w):
    pad = GDN_CONV // 2
    y = lax.conv_general_dilated(x, w[:, None, :].astype(x.dtype), (1,), [(pad, pad)],
                                 dimension_numbers=("NWC", "WIO", "NWC"),
                                 feature_group_count=x.shape[-1])
    return jax.nn.silu(y)


def rope(x, cos, sin):
    half = x.shape[-1] // 2
    x1, x2 = x[..., :half], x[..., half:]
    return jnp.concatenate([x1 * cos - x2 * sin, x2 * cos + x1 * sin], axis=-1).astype(x.dtype)


def gated_delta_chunked(q, k, v, g, beta):
    out_dtype = v.dtype
    f32 = jnp.float32
    q, k, v, g, beta = (t.astype(f32) for t in (q, k, v, g, beta))
    B, S, H, Dk = q.shape
    Dv = v.shape[-1]
    C = GDN_CHUNK
    N = S // C

    def to_chunks(t):
        return jnp.moveaxis(t.reshape((B, N, C, H) + t.shape[3:]), (1, 3), (0, 2))

    qc, kc, vc, bc = to_chunks(q), to_chunks(k), to_chunks(v), to_chunks(beta)
    gc = jnp.cumsum(to_chunks(g), axis=-1)
    incl = jnp.tril(jnp.ones((C, C), bool))
    strict = jnp.tril(jnp.ones((C, C), bool), -1)
    decay = jnp.exp(jnp.where(incl, gc[..., :, None] - gc[..., None, :], -jnp.inf))
    kb = kc * bc[..., None]
    lower = jnp.where(strict, jnp.einsum("nbhik,nbhjk->nbhij", kb, kc) * decay, 0.0)
    unit = jnp.eye(C, dtype=f32) + lower
    rhs = jnp.concatenate([vc * bc[..., None], kb * jnp.exp(gc)[..., None]], axis=-1)
    uw = lax.linalg.triangular_solve(unit, rhs, left_side=True, lower=True, unit_diagonal=True)
    u, w = uw[..., :Dv], uw[..., Dv:]
    intra = jnp.where(incl, jnp.einsum("nbhik,nbhjk->nbhij", qc, kc) * decay, 0.0)

    def step(state, xs):
        q_i, k_i, u_i, w_i, g_i, a_i = xs
        v_new = u_i - jnp.einsum("bhck,bhkv->bhcv", w_i, state)
        o_i = (jnp.einsum("bhck,bhkv->bhcv", q_i * jnp.exp(g_i)[..., None], state)
               + jnp.einsum("bhij,bhjv->bhiv", a_i, v_new))
        g_last = g_i[..., -1:]
        state = (state * jnp.exp(g_last)[..., None]
                 + jnp.einsum("bhck,bhcv->bhkv", k_i * jnp.exp(g_last - g_i)[..., None], v_new))
        return state, o_i

    state0 = jnp.zeros((B, H, Dk, Dv), f32)
    _, o = lax.scan(step, state0, (qc, kc, u, w, gc, intra))
    return jnp.moveaxis(o, (0, 2), (1, 3)).reshape(B, S, H, Dv).astype(out_dtype)


def gdn_branch(q, k, v, z, b, a, conv_w, A_log, dt_bias, norm_w, w_proj):
    B, S, _ = q.shape
    f32 = jnp.float32
    qkv = centred_short_conv(jnp.concatenate([q, k, v], axis=-1), conv_w)
    qh = l2norm(qkv[..., :GDN_QK].reshape(B, S, GDN_HEADS, GDN_DK)) * GDN_DK ** -0.5
    kh = l2norm(qkv[..., GDN_QK:2 * GDN_QK].reshape(B, S, GDN_HEADS, GDN_DK))
    vh = qkv[..., 2 * GDN_QK:].reshape(B, S, GDN_HEADS, GDN_DV)
    beta = jax.nn.sigmoid(b.astype(f32)).reshape(B, S, 2, GDN_HEADS)
    g = -jnp.exp(A_log.astype(f32)) * jax.nn.softplus(
        a.astype(f32).reshape(B, S, 2, GDN_HEADS) + dt_bias.astype(f32))
    o_fwd = gated_delta_chunked(qh, kh, vh, g[:, :, 0], beta[:, :, 0])
    flip = lambda t: jnp.flip(t, axis=1)
    o_bwd = flip(gated_delta_chunked(flip(qh), flip(kh), flip(vh), flip(g[:, :, 1]), flip(beta[:, :, 1])))
    o = rmsnorm(o_fwd + o_bwd, norm_w) * jax.nn.silu(z.reshape(B, S, GDN_HEADS, GDN_DV))
    return o.reshape(B, S, GDN_VW) @ w_proj


def mla_branch(c_q, c_kv, k_rope, cos, sin, q_norm, w_uq, kv_norm, w_ukv, w_proj):
    B, S, _ = c_q.shape
    scale = MLA_QK ** -0.5
    q = (rmsnorm(c_q, q_norm) @ w_uq).reshape(B, S, MLA_HEADS, MLA_QK)
    q_nope = q[..., :MLA_NOPE] * scale
    q_rope = rope(q[..., MLA_NOPE:], cos[:, :, None, :], sin[:, :, None, :]) * scale
    kv = (rmsnorm(c_kv, kv_norm) @ w_ukv).reshape(B, S, MLA_HEADS, MLA_NOPE + MLA_V)
    k_nope, v = kv[..., :MLA_NOPE], kv[..., MLA_NOPE:]
    k_r = rope(k_rope, cos, sin)
    nb = S // MLA_QBLOCK

    def blocks(t):
        return jnp.moveaxis(t.reshape((B, nb, MLA_QBLOCK) + t.shape[2:]), 1, 0)

    def attend(qb):
        qn, qr = qb
        s = (jnp.einsum("bqhd,bkhd->bhqk", qn, k_nope)
             + jnp.einsum("bqhr,bkr->bhqk", qr, k_r))
        p = jax.nn.softmax(s.astype(jnp.float32), axis=-1).astype(v.dtype)
        return jnp.einsum("bhqk,bkhd->bqhd", p, v)

    o = lax.map(attend, (blocks(q_nope), blocks(q_rope)))
    o = jnp.moveaxis(o, 0, 1).reshape(B, S, MLA_OUT)
    return o @ w_proj


def setup_inputs(seed: int = 0) -> dict:
    key = jax.random.key(seed)
    ks = jax.random.split(key, 32)
    f32 = jnp.float32

    def dense(k, fan_in, *shape):
        return jax.random.normal(k, (DEPTH,) + shape, f32) * fan_in ** -0.5

    def gain(k, *shape):
        return 1.0 + 0.02 * jax.random.normal(k, shape, f32)

    x = jax.random.normal(ks[0], (BATCH, SEQ, D_MODEL), f32)
    positions = (jax.random.randint(ks[1], (BATCH, 1), 0, 1024, jnp.int32)
                 + jnp.arange(SEQ, dtype=jnp.int32)[None, :])
    gdn_A_log = jnp.log(jax.random.uniform(ks[2], (DEPTH, 2, GDN_HEADS), f32, 1.0, 16.0))
    dt = jnp.exp(jax.random.uniform(ks[3], (DEPTH, 2, GDN_HEADS), f32, math.log(1e-3), math.log(1e-1)))
    gdn_dt_bias = dt + jnp.log(-jnp.expm1(-dt))
    return {
        "x": x,
        "positions": positions,
        "norm_ffn1": gain(ks[4], DEPTH, D_MODEL),
        "ffn1_w_gate": dense(ks[5], D_MODEL, D_MODEL, D_FF),
        "ffn1_w_up": dense(ks[6], D_MODEL, D_MODEL, D_FF),
        "ffn1_w_down": dense(ks[7], D_FF, D_FF, D_MODEL),
        "norm_mix": gain(ks[8], DEPTH, D_MODEL),
        "w_in": dense(ks[9], D_MODEL, D_MODEL, D_IN),
        "gdn_conv": dense(ks[10], GDN_CONV, GDN_CONV, 2 * GDN_QK + GDN_VW),
        "gdn_A_log": gdn_A_log,
        "gdn_dt_bias": gdn_dt_bias,
        "gdn_norm": gain(ks[11], DEPTH, GDN_DV),
        "gdn_proj": dense(ks[12], GDN_VW, GDN_VW, D_MODEL),
        "mla_q_norm": gain(ks[13], DEPTH, MLA_Q_LORA),
        "mla_w_uq": dense(ks[14], MLA_Q_LORA, MLA_Q_LORA, MLA_HEADS * MLA_QK),
        "mla_kv_norm": gain(ks[15], DEPTH, MLA_KV_LORA),
        "mla_w_ukv": dense(ks[16], MLA_KV_LORA, MLA_KV_LORA, MLA_HEADS * (MLA_NOPE + MLA_V)),
        "mla_proj": dense(ks[17], MLA_OUT, MLA_OUT, D_MODEL),
        "w_out": dense(ks[18], D_MODEL, D_MODEL, D_MODEL),
        "norm_ffn2": gain(ks[19], DEPTH, D_MODEL),
        "ffn2_w_gate": dense(ks[20], D_MODEL, D_MODEL, D_FF),
        "ffn2_w_up": dense(ks[21], D_MODEL, D_MODEL, D_FF),
        "ffn2_w_down": dense(ks[22], D_FF, D_FF, D_MODEL),
        "final_norm": gain(ks[23], D_MODEL),
    }


def reference(x, positions, norm_ffn1, ffn1_w_gate, ffn1_w_up, ffn1_w_down, norm_mix, w_in,
              gdn_conv, gdn_A_log, gdn_dt_bias, gdn_norm, gdn_proj, mla_q_norm, mla_w_uq,
              mla_kv_norm, mla_w_ukv, mla_proj, w_out, norm_ffn2, ffn2_w_gate, ffn2_w_up,
              ffn2_w_down, final_norm):
    B, S, D = x.shape
    inv_freq = jnp.power(ROPE_THETA, -jnp.arange(0, MLA_ROPE, 2, dtype=jnp.float32) / MLA_ROPE)
    ang = positions.astype(jnp.float32)[..., None] * inv_freq
    cos, sin = jnp.cos(ang), jnp.sin(ang)
    for l in range(DEPTH):
        h = rmsnorm(x, norm_ffn1[l])
        x = x + RES_HALF * swiglu(h, ffn1_w_gate[l], ffn1_w_up[l], ffn1_w_down[l])
        h = rmsnorm(x, norm_mix[l])
        gq, gk, gv, gz, gb, ga, c_q, c_kv, k_rope, gate_logits = split_cols(h @ w_in[l])
        y_a = gdn_branch(gq, gk, gv, gz, gb, ga, gdn_conv[l], gdn_A_log[l], gdn_dt_bias[l],
                         gdn_norm[l], gdn_proj[l])
        y_b = mla_branch(c_q, c_kv, k_rope, cos, sin, mla_q_norm[l], mla_w_uq[l],
                         mla_kv_norm[l], mla_w_ukv[l], mla_proj[l])
        gates = jax.nn.sigmoid(gate_logits.astype(jnp.float32)).astype(x.dtype).reshape(B, S, N_BRANCH, D)
        x = x + (gates[:, :, 0] * y_a + gates[:, :, 1] * y_b) @ w_out[l]
        h = rmsnorm(x, norm_ffn2[l])
        x = x + RES_HALF * swiglu(h, ffn2_w_gate[l], ffn2_w_up[l], ffn2_w_down[l])
    return rmsnorm(x, final_norm)
```

```cpp
#include <hip/hip_runtime.h>
#include <hip/hip_cooperative_groups.h>
#include <cstdio>
#include <cmath>
namespace cg = cooperative_groups;

#ifndef COOP
#define COOP 1
#endif
#ifndef PHMASK
#define PHMASK 0xffffffffu
#endif
#define EN(k) ((PHMASK >> (k)) & 1u)
#ifndef PROBE_ST
#define PROBE_ST (-1)
#endif
constexpr int NS_ = 15 + (PROBE_ST >= 0 ? 1 : 0), NPH_ = 2 + 2 * NS_;
#ifndef PROBE_SYNC
#define PROBE_SYNC 0
#endif

#define LAS __attribute__((address_space(3)))
#define DI __device__ __forceinline__
typedef unsigned short bf16_t;
typedef short bf16x8 __attribute__((ext_vector_type(8)));
typedef short s16x4 __attribute__((ext_vector_type(4)));
typedef float f32x4 __attribute__((ext_vector_type(4)));
typedef float f32x16 __attribute__((ext_vector_type(16)));
typedef unsigned u32x4 __attribute__((ext_vector_type(4)));
typedef unsigned u32x2 __attribute__((ext_vector_type(2)));

constexpr int T_ = 32768, S_ = 8192, NB_ = 4, D_ = 1024, FF_ = 2816;
constexpr int LDS_BYTES = 131072 + 64;
constexpr float EPS_ = 1e-6f;
constexpr size_t MiB = 1u << 20;
constexpr size_t WS_W = 0;
constexpr size_t W_GU = WS_W, W_D = WS_W + 11 * MiB;
constexpr size_t W_IN = WS_W, W_G = WS_W + 5632 * 1024, W_PA = WS_W + 9728 * 1024, W_PB = W_PA + MiB, W_OUT = W_PB + MiB,
                 W_UQ = W_OUT + 2 * MiB, W_UK = W_UQ + MiB, W_UV = W_UK + 256 * 1024;
constexpr size_t WS_H = 20 * MiB;
constexpr size_t WS_KT = 20 * MiB, WS_OF = 52 * MiB;
constexpr size_t WS_BIG = 84 * MiB;
constexpr size_t WS_GQKV = WS_BIG, WS_Z = WS_BIG + 96 * MiB, WS_REST = WS_BIG + 128 * MiB;
constexpr size_t WS_KN = 84 * MiB, WS_VT = 116 * MiB, WS_OB = 148 * MiB;
constexpr size_t WS_H2 = 84 * MiB;
constexpr size_t WS_AO = 212 * MiB;
constexpr size_t WS_X2 = 260 * MiB;
constexpr size_t WS_QH = 260 * MiB, WS_WF = 292 * MiB, WS_WB = 324 * MiB;
constexpr size_t WS_UF = 356 * MiB, WS_UB = 388 * MiB;
constexpr size_t WS_IF = 420 * MiB, WS_IB = 436 * MiB;
constexpr size_t WS_Q = 452 * MiB;
constexpr size_t WS_BETA = 500 * MiB, WS_G = 501 * MiB, WS_KR = 502 * MiB, WS_COS = 504 * MiB, WS_SIN = 506 * MiB,
                 WS_EG = 508 * MiB, WS_EK = 509 * MiB, WS_ETOT = 510 * MiB, WS_CTR = 510 * MiB + 512 * 1024;
constexpr size_t WS_AG = 420 * MiB;
constexpr size_t WS_YA = 260 * MiB, WS_YB = 324 * MiB, WS_Y = 388 * MiB;
constexpr size_t WS_BAR = 510 * MiB + 768 * 1024;
constexpr size_t WS_END = 511 * MiB;

typedef __bf16 bf16v2 __attribute__((ext_vector_type(2)));
typedef float f32x2 __attribute__((ext_vector_type(2)));
DI unsigned pk2(float lo, float hi) { return __builtin_bit_cast(unsigned, __builtin_convertvector((f32x2){lo, hi}, bf16v2)); }
DI unsigned cvt_pk_bf16(float lo, float hi) { unsigned r; asm volatile("v_cvt_pk_bf16_f32 %0, %1, %2" : "=v"(r) : "v"(lo), "v"(hi)); return r; }
DI float bf2f(bf16_t b) { return __uint_as_float(((unsigned)b) << 16); }
DI float bflo(unsigned w) { return __uint_as_float(w << 16); }
DI float bfhi(unsigned w) { return __uint_as_float(w & 0xffff0000u); }
DI float sigmoidf_(float x) { return __builtin_amdgcn_rcpf(1.0f + __expf(-x)); }
DI float siluf_(float x) { return x * sigmoidf_(x); }
DI int otid(int wv) { int z; asm volatile("s_mov_b32 %0, 0" : "=s"(z)); return wv * 64 + (int)__builtin_amdgcn_mbcnt_hi(~0u, __builtin_amdgcn_mbcnt_lo(~0u, (unsigned)z)); }
DI float lane_xor(float v, int lane, int o) { return __int_as_float(__builtin_amdgcn_ds_bpermute((lane ^ o) << 2, __float_as_int(v))); }
DI float wave_sum(float v, int lane) {
#pragma unroll
    for (int o = 32; o >= 1; o >>= 1) v += lane_xor(v, lane, o);
    return v; }

namespace pg8 {
constexpr int BM = 256, BK = 64, HALF = 128, HTB = HALF * BK * 2, NXCD = 8, WGM = 8;
DI int lds_byte(int r, int c) { const int st = (r >> 4) * 2 + (c >> 5), rr = r & 15, cc = c & 31, ob = rr * 64 + cc * 2; return st * 1024 + (ob ^ (((ob >> 9) & 1) << 5)); }
DI void stage_rc(int b, int& R, int& C) { const int st = b / 1024, sb = b % 1024, swz = sb ^ (((sb >> 9) & 1) << 5); R = (st >> 1) * 16 + swz / 64; C = (st & 1) * 32 + (swz % 64) / 2; }
DI int perm32(int rho) { const int n = rho >> 4, i = rho & 15; return 8 * (i >> 2) + 4 * n + (i & 3); }
struct Unit { int pm, pn; };
struct Gemm { const bf16_t* A; const bf16_t* Bt; int M, N, K, lda, ldb; };
struct StaticOrder {
    int nM, nN, nwg, G, c;
    DI void init(int M, int N, int G_, int c_) { nM = M / BM; nN = N / BM; nwg = nM * nN; G = G_; c = c_; }
    DI bool next(int i, Unit& u) const {
        const long L = (long)i * G + c; if (L >= nwg) return false;
        int wgid = (int)L; { const int q = nwg / NXCD, r = nwg % NXCD, xcd = wgid % NXCD, off = wgid / NXCD; wgid = (xcd < r ? xcd * (q + 1) : r * (q + 1) + (xcd - r) * q) + off; }
        const int nig = WGM * nN, gid = wgid / nig, fm = gid * WGM, gsz = (nM - fm) < WGM ? (nM - fm) : WGM;
        u.pm = fm + ((wgid % nig) % gsz); u.pn = (wgid % nig) / gsz; return true;
    }
};
template <class Epi>
DI void gemm_phase(LAS unsigned char* lds, const Gemm g, const StaticOrder& S, const Epi& E, const int wv) {
    const int tid = otid(wv), wid = __builtin_amdgcn_readfirstlane(tid >> 6), lane = tid & 63, wr = wid >> 2, wc = wid & 3, fr = lane & 15, fq = lane >> 4;
    const int K = g.K, nt = K / BK;
    unsigned voffA[2], voffB[2];
#pragma unroll
    for (int i = 0; i < 2; ++i) { int R, C; stage_rc(tid * 16 + i * 8192, R, C); const int Rb = Epi::PERM ? ((R & ~31) + perm32(R & 31)) : R;
        voffA[i] = (unsigned)(R * g.lda + C) * 2u; voffB[i] = (unsigned)(Rb * g.ldb + C) * 2u; }
    const size_t kstep = (size_t)(BK * 2);
    const size_t hstepA = (size_t)HALF * g.lda * 2, hstepB = (size_t)HALF * g.ldb * 2;
    const size_t tstepA = 2 * hstepA, tstepB = 2 * hstepB;
    const unsigned ldsw = (unsigned)wid * 1024u;
    const int aoff = lds_byte(wr * 64 + fr, fq * 8), boff = lds_byte(wc * 32 + fr, fq * 8);
#define PG8_SA(b, h) (((b) * 2 + (h)) * HTB)
#define PG8_SB(b, h) ((4 + (b) * 2 + (h)) * HTB)
#define PG8_STAGE(bufoff, gbase, voff) do { _Pragma("unroll") for (int _i = 0; _i < 2; ++_i) \
        __builtin_amdgcn_global_load_lds((const unsigned*)((const char*)(gbase) + (voff)[_i]), (LAS unsigned*)(lds + (bufoff) + ldsw + _i * 8192), 16, 0, 0); } while (0)
#define PG8_LDA(dst, b, h) do { _Pragma("unroll") for (int m = 0; m < 4; ++m) _Pragma("unroll") for (int k = 0; k < 2; ++k) dst[m][k] = *(const LAS bf16x8*)(lds + PG8_SA(b, h) + aoff + m * 2048 + k * 1024); } while (0)
#define PG8_LDB(dst, b, h) do { _Pragma("unroll") for (int n = 0; n < 2; ++n) _Pragma("unroll") for (int k = 0; k < 2; ++k) dst[n][k] = *(const LAS bf16x8*)(lds + PG8_SB(b, h) + boff + n * 2048 + k * 1024); } while (0)
#define PG8_MMA(ai, bj, At, Bt) do { __builtin_amdgcn_s_setprio(1); _Pragma("unroll") for (int m = 0; m < 4; ++m) _Pragma("unroll") for (int n = 0; n < 2; ++n) _Pragma("unroll") for (int k = 0; k < 2; ++k) \
        acc[ai][bj][m][n] = __builtin_amdgcn_mfma_f32_16x16x32_bf16(Bt[n][k], At[m][k], acc[ai][bj][m][n], 0, 0, 0); __builtin_amdgcn_s_setprio(0); } while (0)
#define PG8_WAIT_V(n) asm volatile("s_waitcnt vmcnt(" #n ")" ::: "memory")
#define PG8_WAIT_L(n) asm volatile("s_waitcnt lgkmcnt(" #n ")" ::: "memory")
#define PG8_BAR __builtin_amdgcn_s_barrier()
#define PG8_SCHED __builtin_amdgcn_sched_barrier(0)
    Unit cur, nxt; int ui = 0;
    if (!S.next(0, cur)) return;
    f32x4 acc[2][2][4][2];
#pragma unroll
    for (int a = 0; a < 2; ++a)
#pragma unroll
        for (int b = 0; b < 2; ++b)
#pragma unroll
            for (int m = 0; m < 4; ++m)
#pragma unroll
                for (int n = 0; n < 2; ++n) acc[a][b][m][n] = (f32x4){0.f, 0.f, 0.f, 0.f};
    bf16x8 At[4][2], B0[2][2], B1[2][2];
    const char* cA = (const char*)g.A + (size_t)cur.pm * tstepA; const char* cB = (const char*)g.Bt + (size_t)cur.pn * tstepB;
    PG8_STAGE(PG8_SB(0, 0), cB, voffB); PG8_STAGE(PG8_SA(0, 0), cA, voffA); PG8_STAGE(PG8_SB(0, 1), cB + hstepB, voffB); PG8_STAGE(PG8_SA(0, 1), cA + hstepA, voffA);
    if (wr == 1) PG8_BAR;
    PG8_WAIT_V(4); PG8_BAR;
    PG8_STAGE(PG8_SB(1, 0), cB + kstep, voffB); PG8_STAGE(PG8_SA(1, 0), cA + kstep, voffA); PG8_STAGE(PG8_SB(1, 1), cB + hstepB + kstep, voffB);
    PG8_WAIT_V(6); PG8_BAR;
    for (;;) {
        const bool has_next = S.next(ui + 1, nxt);
        const char* nA = has_next ? (const char*)g.A + (size_t)nxt.pm * tstepA : cA; const char* nB = has_next ? (const char*)g.Bt + (size_t)nxt.pn * tstepB : cB;
        for (int t = 0; t < nt; t += 2) {
            const bool last = (t == nt - 2);
            const char* a1 = cA + (size_t)(t + 1) * kstep;
            const char* a2 = last ? nA : cA + (size_t)(t + 2) * kstep; const char* b2 = last ? nB : cB + (size_t)(t + 2) * kstep;
            const char* a3 = a2 + kstep; const char* b3 = b2 + kstep;
            PG8_LDB(B0, 0, 0); PG8_SCHED; PG8_LDA(At, 0, 0); PG8_STAGE(PG8_SA(1, 1), a1 + hstepA, voffA);
            PG8_WAIT_L(8); PG8_BAR; PG8_WAIT_L(0); PG8_MMA(0, 0, At, B0); PG8_BAR; PG8_SCHED;
            PG8_LDB(B1, 0, 1); PG8_STAGE(PG8_SB(0, 0), b2, voffB);
            PG8_BAR; PG8_WAIT_L(0); PG8_MMA(0, 1, At, B1); PG8_BAR;
            PG8_LDA(At, 0, 1); PG8_STAGE(PG8_SA(0, 0), a2, voffA);
            PG8_BAR; PG8_WAIT_L(0); PG8_MMA(1, 0, At, B0); PG8_BAR; PG8_SCHED;
            PG8_STAGE(PG8_SB(0, 1), b2 + hstepB, voffB);
            PG8_WAIT_V(6); PG8_BAR; PG8_MMA(1, 1, At, B1); PG8_BAR;
            PG8_LDB(B0, 1, 0); PG8_SCHED; PG8_LDA(At, 1, 0); PG8_STAGE(PG8_SA(0, 1), a2 + hstepA, voffA);
            PG8_WAIT_L(8); PG8_BAR; PG8_WAIT_L(0); PG8_MMA(0, 0, At, B0); PG8_BAR; PG8_SCHED;
            PG8_LDB(B1, 1, 1); PG8_STAGE(PG8_SB(1, 0), b3, voffB);
            PG8_BAR; PG8_WAIT_L(0); PG8_MMA(0, 1, At, B1); PG8_BAR;
            PG8_LDA(At, 1, 1); PG8_STAGE(PG8_SA(1, 0), a3, voffA);
            PG8_BAR; PG8_WAIT_L(0); PG8_MMA(1, 0, At, B0); PG8_BAR; PG8_SCHED;
            PG8_STAGE(PG8_SB(1, 1), b3 + hstepB, voffB);
            PG8_WAIT_V(6); PG8_BAR; PG8_MMA(1, 1, At, B1); PG8_BAR;
        }
        E(acc, cur, wr, wc, fr, fq);
        if (!has_next) break;
#pragma unroll
        for (int a = 0; a < 2; ++a)
#pragma unroll
            for (int b = 0; b < 2; ++b)
#pragma unroll
                for (int m = 0; m < 4; ++m)
#pragma unroll
                    for (int n = 0; n < 2; ++n) acc[a][b][m][n] = (f32x4){0.f, 0.f, 0.f, 0.f};
        cur = nxt; cA = nA; cB = nB; ++ui;
    }
    PG8_WAIT_V(0);
    if (wr == 0) PG8_BAR;
    PG8_BAR;
#undef PG8_SA
#undef PG8_SB
#undef PG8_STAGE
#undef PG8_LDA
#undef PG8_LDB
#undef PG8_MMA
#undef PG8_WAIT_V
#undef PG8_WAIT_L
#undef PG8_BAR
#undef PG8_SCHED
}
typedef f32x4 Acc[2][2][4][2];

struct EpiSwiglu {
    static constexpr bool PERM = true; bf16_t* O; int ldc;
    DI void operator()(const Acc& acc, const Unit& u, int wr, int wc, int fr, int fq) const {
        const int row0 = u.pm * BM + wr * 64 + fr, col0 = u.pn * 128 + wc * 32 + 8 * fq;
#pragma unroll
        for (int ai = 0; ai < 2; ++ai)
#pragma unroll
            for (int m = 0; m < 4; ++m) {
                bf16_t* rowp = O + (size_t)(row0 + ai * HALF + m * 16) * ldc + col0; float r[8];
#pragma unroll
                for (int n = 0; n < 2; ++n)
#pragma unroll
                    for (int j = 0; j < 4; ++j) { const float gg = acc[ai][0][m][n][j], uu = acc[ai][1][m][n][j]; r[n * 4 + j] = siluf_(gg) * uu; }
                u32x4 w; w.x = cvt_pk_bf16(r[0], r[1]); w.y = cvt_pk_bf16(r[2], r[3]); w.z = cvt_pk_bf16(r[4], r[5]); w.w = cvt_pk_bf16(r[6], r[7]);
                *(u32x4*)rowp = w; }
    }
};
struct EpiResid {
    static constexpr bool PERM = false; const float* X; float* Y; float alpha;
    DI void operator()(const Acc& acc, const Unit& u, int wr, int wc, int fr, int fq) const {
        const int row0 = u.pm * BM + wr * 64 + fr, col0 = u.pn * BM + wc * 32 + 4 * fq;
#pragma unroll
        for (int ai = 0; ai < 2; ++ai)
#pragma unroll
            for (int m = 0; m < 4; ++m) { const size_t off = (size_t)(row0 + ai * HALF + m * 16) * D_ + col0;
#pragma unroll
                for (int bj = 0; bj < 2; ++bj)
#pragma unroll
                    for (int n = 0; n < 2; ++n) { const f32x4 xv = *(const f32x4*)(X + off + bj * HALF + n * 16); *(f32x4*)(Y + off + bj * HALF + n * 16) = xv + alpha * acc[ai][bj][m][n]; }
                asm volatile("" ::: "memory"); }
    }
};
struct EpiBf16 {
    static constexpr bool PERM = true;
    bf16_t* O0; int ld0; int t1; bf16_t* O1; int ld1; int t2; bf16_t* O2; int ld2; float scale;
    DI void operator()(const Acc& acc, const Unit& u, int wr, int wc, int fr, int fq) const {
        bf16_t* base = O0; int ld = ld0, colt = u.pn * BM;
        if (u.pn >= t2) { base = O2; ld = ld2; colt = (u.pn - t2) * BM; } else if (u.pn >= t1) { base = O1; ld = ld1; colt = (u.pn - t1) * BM; }
        const int row0 = u.pm * BM + wr * 64 + fr, col0 = colt + wc * 32 + 8 * fq;
#pragma unroll
        for (int ai = 0; ai < 2; ++ai)
#pragma unroll
            for (int m = 0; m < 4; ++m) { const int row = row0 + ai * HALF + m * 16; bf16_t* rowp = base + (size_t)row * ld + col0;
#pragma unroll
                for (int bj = 0; bj < 2; ++bj) { const f32x4 v0 = acc[ai][bj][m][0] * scale, v1 = acc[ai][bj][m][1] * scale;
                    u32x4 w; w.x = cvt_pk_bf16(v0[0], v0[1]); w.y = cvt_pk_bf16(v0[2], v0[3]); w.z = cvt_pk_bf16(v1[0], v1[1]); w.w = cvt_pk_bf16(v1[2], v1[3]);
                    *(u32x4*)(rowp + bj * HALF) = w; } }
    }
};
struct EpiGate {
    static constexpr bool PERM = true; const bf16_t* YA; const bf16_t* YB; bf16_t* Y;
    DI void operator()(const Acc& acc, const Unit& u, int wr, int wc, int fr, int fq) const {
        const int row0 = u.pm * BM + wr * 64 + fr, col0 = u.pn * 128 + wc * 32 + 8 * fq;
#pragma unroll
        for (int ai = 0; ai < 2; ++ai)
#pragma unroll
            for (int m = 0; m < 4; ++m) { const size_t off = (size_t)(row0 + ai * HALF + m * 16) * D_ + col0;
                const u32x4 a = *(const u32x4*)(YA + off), b = *(const u32x4*)(YB + off); float r[8];
#pragma unroll
                for (int n = 0; n < 2; ++n)
#pragma unroll
                    for (int jj = 0; jj < 2; ++jj) { const unsigned aw = a[n * 2 + jj], bw = b[n * 2 + jj];
                        r[n * 4 + jj * 2] = sigmoidf_(acc[ai][0][m][n][jj * 2]) * bflo(aw) + sigmoidf_(acc[ai][1][m][n][jj * 2]) * bflo(bw);
                        r[n * 4 + jj * 2 + 1] = sigmoidf_(acc[ai][0][m][n][jj * 2 + 1]) * bfhi(aw) + sigmoidf_(acc[ai][1][m][n][jj * 2 + 1]) * bfhi(bw); }
                u32x4 w; w.x = cvt_pk_bf16(r[0], r[1]); w.y = cvt_pk_bf16(r[2], r[3]); w.z = cvt_pk_bf16(r[4], r[5]); w.w = cvt_pk_bf16(r[6], r[7]);
                *(u32x4*)(Y + off) = w;
                asm volatile("" ::: "memory"); }
    }
};
}

struct Params { const float* in[24]; float* out; unsigned char* ws; double invf_rev[16]; int ph_lo, ph_hi; };

DI int conv_col(int n, int mode, bool& second) {
    second = false; int col = n;
    if (mode == 1) { const int t = n >> 8, r = n & 255; col = t * 128 + (r & 127); second = r >= 128; }
    else if (mode == 2) { if (n < 2048) col = n; else if (n < 2720) col = 2064 + (n - 2048); else if (n < 2736) col = 2048 + (n - 2720); else col = -1; }
    else if (mode == 3) { const int t = n >> 8, r = n & 255; col = 2736 + ((r >= 128) ? 1024 : 0) + t * 128 + (r & 127); }
    else if (mode == 4) { col = (n >> 6) * 128 + (n & 63); }
    else if (mode == 5) { col = (n >> 6) * 128 + 64 + (n & 63); }
    return col;
}
DI void conv_w(const float* src0, const float* src1, int ldsrc, bf16_t* dst, int N, int K, int mode, const float* kscale, int gtid, int gstride) {
    const int total = N * (K / 8);
    for (int idx = gtid; idx < total; idx += 2 * gstride) {
        const int idx2 = idx + gstride; const bool has2 = idx2 < total;
        const int nA = idx % N, kA = idx / N, nB = has2 ? idx2 % N : nA, kB = has2 ? idx2 / N : kA;
        bool sA, sB; const int cA = conv_col(nA, mode, sA), cB = conv_col(nB, mode, sB);
        const float* pA = sA ? src1 : src0; const float* pB = sB ? src1 : src0;
        float vA[8], vB[8];
#pragma unroll
        for (int j = 0; j < 8; ++j) { vA[j] = (cA >= 0) ? pA[(size_t)(kA * 8 + j) * ldsrc + cA] : 0.f; vB[j] = (cB >= 0) ? pB[(size_t)(kB * 8 + j) * ldsrc + cB] : 0.f; }
        if (kscale) {
#pragma unroll
            for (int j = 0; j < 8; ++j) { vA[j] *= kscale[kA * 8 + j]; vB[j] *= kscale[kB * 8 + j]; } }
        u32x4 w; w.x = cvt_pk_bf16(vA[0], vA[1]); w.y = cvt_pk_bf16(vA[2], vA[3]); w.z = cvt_pk_bf16(vA[4], vA[5]); w.w = cvt_pk_bf16(vA[6], vA[7]);
        *(u32x4*)(dst + (size_t)nA * K + kA * 8) = w;
        if (has2) { u32x4 w2; w2.x = cvt_pk_bf16(vB[0], vB[1]); w2.y = cvt_pk_bf16(vB[2], vB[3]); w2.z = cvt_pk_bf16(vB[4], vB[5]); w2.w = cvt_pk_bf16(vB[6], vB[7]);
            *(u32x4*)(dst + (size_t)nB * K + kB * 8) = w2; }
    }
}

template <bool F32OUT>
DI void rms_rows(const float* x, const float* w, void* out, const int wv) {
    const int tid_ = otid(wv); const int lane = tid_ & 63, wid = tid_ >> 6;
    f32x4 wv4[4];
#pragma unroll
    for (int i = 0; i < 4; ++i) wv4[i] = *(const f32x4*)(w + i * 256 + lane * 4);
    for (int row = (blockIdx.x * 8 + wid) * 4; row < T_; row += gridDim.x * 32) {
        f32x4 v[4][4]; float ss[4] = {0.f, 0.f, 0.f, 0.f};
#pragma unroll
        for (int rr = 0; rr < 4; ++rr)
#pragma unroll
            for (int i = 0; i < 4; ++i) v[rr][i] = *(const f32x4*)(x + (size_t)(row + rr) * D_ + i * 256 + lane * 4);
#pragma unroll
        for (int rr = 0; rr < 4; ++rr)
#pragma unroll
            for (int i = 0; i < 4; ++i) ss[rr] += v[rr][i][0] * v[rr][i][0] + v[rr][i][1] * v[rr][i][1] + v[rr][i][2] * v[rr][i][2] + v[rr][i][3] * v[rr][i][3];
#pragma unroll
        for (int o = 32; o >= 1; o >>= 1) { ss[0] += lane_xor(ss[0], lane, o); ss[1] += lane_xor(ss[1], lane, o); ss[2] += lane_xor(ss[2], lane, o); ss[3] += lane_xor(ss[3], lane, o); }
#pragma unroll
        for (int rr = 0; rr < 4; ++rr) { const float rstd = rsqrtf(ss[rr] * (1.0f / D_) + EPS_);
#pragma unroll
            for (int i = 0; i < 4; ++i) { const f32x4 y = v[rr][i] * rstd * wv4[i];
                if (F32OUT) *(f32x4*)((float*)out + (size_t)(row + rr) * D_ + i * 256 + lane * 4) = y;
                else { u32x2 pk; pk.x = cvt_pk_bf16(y[0], y[1]); pk.y = cvt_pk_bf16(y[2], y[3]); *(u32x2*)((bf16_t*)out + (size_t)(row + rr) * D_ + i * 256 + lane * 4) = pk; } } }
    }
}

DI void mla_latent_pass(const Params& p, unsigned char* ws, int l, const int wv) {
    const int tid_ = otid(wv); const int lane = tid_ & 63, wid = tid_ >> 6;
    bf16_t* restw = (bf16_t*)(ws + WS_REST); bf16_t* kr = (bf16_t*)(ws + WS_KR); const float* qnw = p.in[13] + l * 384; const float* kvnw = p.in[15] + l * 256;
    const float* cosT = (const float*)(ws + WS_COS); const float* sinT = (const float*)(ws + WS_SIN);
    for (int t0 = (blockIdx.x * 8 + wid) * 2; t0 < T_; t0 += gridDim.x * 16) {
        float cq[2][6], ck[2][4], s1[2] = {0.f, 0.f}, s2[2] = {0.f, 0.f};
#pragma unroll
        for (int rr = 0; rr < 2; ++rr) { const bf16_t* r = restw + (size_t)(t0 + rr) * 768;
#pragma unroll
            for (int i = 0; i < 6; ++i) cq[rr][i] = bf2f(r[i * 64 + lane]);
#pragma unroll
            for (int i = 0; i < 4; ++i) ck[rr][i] = bf2f(r[384 + i * 64 + lane]); }
#pragma unroll
        for (int rr = 0; rr < 2; ++rr) {
#pragma unroll
            for (int i = 0; i < 6; ++i) s1[rr] += cq[rr][i] * cq[rr][i];
#pragma unroll
            for (int i = 0; i < 4; ++i) s2[rr] += ck[rr][i] * ck[rr][i]; }
#pragma unroll
        for (int o = 32; o >= 1; o >>= 1) { s1[0] += lane_xor(s1[0], lane, o); s1[1] += lane_xor(s1[1], lane, o); s2[0] += lane_xor(s2[0], lane, o); s2[1] += lane_xor(s2[1], lane, o); }
#pragma unroll
        for (int rr = 0; rr < 2; ++rr) { const int t = t0 + rr; bf16_t* r = restw + (size_t)t * 768;
            const float r1 = rsqrtf(s1[rr] * (1.0f / 384.f) + EPS_), r2 = rsqrtf(s2[rr] * (1.0f / 256.f) + EPS_);
#pragma unroll
            for (int i = 0; i < 6; ++i) r[i * 64 + lane] = (bf16_t)(cvt_pk_bf16(cq[rr][i] * r1 * qnw[i * 64 + lane], 0.f) & 0xffff);
#pragma unroll
            for (int i = 0; i < 4; ++i) r[384 + i * 64 + lane] = (bf16_t)(cvt_pk_bf16(ck[rr][i] * r2 * kvnw[i * 64 + lane], 0.f) & 0xffff);
            if (lane < 16) { const float x1 = bf2f(r[640 + lane]), x2 = bf2f(r[656 + lane]), c = cosT[(size_t)t * 16 + lane], sn = sinT[(size_t)t * 16 + lane];
                const unsigned w = cvt_pk_bf16(x1 * c - x2 * sn, x2 * c + x1 * sn); kr[(size_t)t * 32 + lane] = (bf16_t)(w & 0xffff); kr[(size_t)t * 32 + 16 + lane] = (bf16_t)(w >> 16); } }
    }
}

constexpr int CP_QS = 0, CP_KS = 17408, CP_KT = 34816, CP_VT = CP_KT + 18432, CP_T = CP_VT + 18432, CP_SM = CP_T + 36864;
DI bf16x8 pack8n(const f32x16& x, int s) {
    u32x4 pk;
    if (s == 0) { pk.x = pk2(x[0], x[1]); pk.y = pk2(x[2], x[3]); pk.z = pk2(x[4], x[5]); pk.w = pk2(x[6], x[7]); }
    else { pk.x = pk2(x[8], x[9]); pk.y = pk2(x[10], x[11]); pk.z = pk2(x[12], x[13]); pk.w = pk2(x[14], x[15]); }
    return __builtin_bit_cast(bf16x8, pk);
}
DI void tri_solve(const LAS float* L, LAS bf16_t* Tu, LAS bf16_t* Tw, int c, const LAS float* bet, const LAS float* gc, bool rev) {
    float Tc[64];
#pragma unroll
    for (int i = 0; i < 64; ++i) {
        float a = (i == c) ? 1.f : 0.f, a1 = 0.f, a2 = 0.f, a3 = 0.f;
#pragma unroll
        for (int j4 = 0; j4 < (i + 3) / 4; ++j4) { const f32x4 lv = *(const LAS f32x4*)(L + i * 64 + j4 * 4);
            if (j4 * 4 + 0 < i) a -= lv[0] * Tc[j4 * 4 + 0];
            if (j4 * 4 + 1 < i) a1 -= lv[1] * Tc[j4 * 4 + 1];
            if (j4 * 4 + 2 < i) a2 -= lv[2] * Tc[j4 * 4 + 2];
            if (j4 * 4 + 3 < i) a3 -= lv[3] * Tc[j4 * 4 + 3]; }
        a = (a + a1) + (a2 + a3);
        asm volatile("" : "+v"(a));
        Tc[i] = a;
    }
    const int col = rev ? 63 - c : c; const float su = bet[col], sw = su * __expf(gc[col]);
#pragma unroll
    for (int i = 0; i < 64; ++i) { const int row = rev ? 63 - i : i; const unsigned w = pk2(Tc[i] * su, Tc[i] * sw);
        Tu[row * 72 + col] = (bf16_t)(w & 0xffff); Tw[row * 72 + col] = (bf16_t)(w >> 16); }
}
DI void gdn_chunk_pre(LAS unsigned char* lds, unsigned char* ws, const float* cw, const float* Alog, const float* dtb, int unit, const int wv) {
    const int b = unit >> 9, n = (unit >> 2) & 127, hh = unit & 3; const size_t t0 = (size_t)b * S_ + (size_t)n * 64;
    const bf16_t* gqkv = (const bf16_t*)(ws + WS_GQKV); const bf16_t* rest = (const bf16_t*)(ws + WS_REST); bf16_t* qh = (bf16_t*)(ws + WS_QH);
    const int tid = otid(wv), wid = tid >> 6, lane = tid & 63, r = lane & 31, h = lane >> 5;
    LAS bf16_t* kT = (LAS bf16_t*)(lds + CP_KT); LAS bf16_t* vT = (LAS bf16_t*)(lds + CP_VT);
    LAS float* sm = (LAS float*)(lds + CP_SM); LAS float* betf = sm; LAS float* betb = sm + 64; LAS float* gcf = sm + 128; LAS float* gcb = sm + 192;
    {
        const int pc = tid & 15, ig = tid >> 4, sp0 = n * 64 + 2 * ig - 2;
#pragma unroll
        for (int part = 0; part < 3; ++part) {
            const int col = part * 512 + hh * 128 + pc * 8;
            f32x4 wt[5][2];
#pragma unroll
            for (int j = 0; j < 5; ++j) { wt[j][0] = *(const f32x4*)(cw + j * 1536 + col); wt[j][1] = *(const f32x4*)(cw + j * 1536 + col + 4); }
            u32x4 rows[6];
#pragma unroll
            for (int rr = 0; rr < 6; ++rr) { const int sp = sp0 + rr; rows[rr] = (sp >= 0 && sp < S_) ? *(const u32x4*)(gqkv + ((size_t)b * S_ + sp) * 1536 + col) : (u32x4){0u, 0u, 0u, 0u}; }
#pragma unroll
            for (int tk = 0; tk < 2; ++tk) {
                float y[8];
#pragma unroll
                for (int e = 0; e < 8; ++e) y[e] = 0.f;
#pragma unroll
                for (int j = 0; j < 5; ++j)
#pragma unroll
                    for (int e = 0; e < 4; ++e) { const unsigned w = rows[tk + j][e]; y[2 * e] += bflo(w) * wt[j][(2 * e) >> 2][(2 * e) & 3]; y[2 * e + 1] += bfhi(w) * wt[j][(2 * e + 1) >> 2][(2 * e + 1) & 3]; }
                float ss = 0.f;
#pragma unroll
                for (int e = 0; e < 8; ++e) { y[e] = siluf_(y[e]); ss += y[e] * y[e]; }
                float sc = 1.f;
                if (part < 2) { ss += lane_xor(ss, lane, 1); ss += lane_xor(ss, lane, 2); ss += lane_xor(ss, lane, 4); ss += lane_xor(ss, lane, 8);
                    sc = rsqrtf(ss + EPS_) * (part == 0 ? 0.08838834764831845f : 1.f); }
                u32x4 o; o.x = pk2(y[0] * sc, y[1] * sc); o.y = pk2(y[2] * sc, y[3] * sc); o.z = pk2(y[4] * sc, y[5] * sc); o.w = pk2(y[6] * sc, y[7] * sc);
                const int i = 2 * ig + tk;
                if (part == 0) { *(LAS u32x4*)(lds + CP_QS + i * 272 + pc * 16) = o; *(u32x4*)(qh + (t0 + i) * 512 + hh * 128 + pc * 8) = o; }
                else { if (part == 1) *(LAS u32x4*)(lds + CP_KS + i * 272 + pc * 16) = o;
                    LAS bf16_t* dstT = (part == 1) ? kT : vT;
#pragma unroll
                    for (int e = 0; e < 4; ++e) { dstT[(pc * 8 + 2 * e) * 72 + i] = (bf16_t)(o[e] & 0xffff); dstT[(pc * 8 + 2 * e + 1) * 72 + i] = (bf16_t)(o[e] >> 16); } }
            }
        }
        if (tid < 128) { const int i = tid & 63, dir = tid >> 6, di = dir * 4 + hh;
            const float bb = bf2f(rest[(t0 + i) * 768 + 672 + di]), aa = bf2f(rest[(t0 + i) * 768 + 680 + di]);
            const float xx = aa + dtb[di]; const float ey = __expf(-fabsf(xx)); const float sp = fmaxf(xx, 0.f) + (ey < 0.01f ? ey * (1.f - ey * (0.5f - ey * 0.33333333f)) : __logf(1.f + ey));
            (dir ? betb : betf)[i] = sigmoidf_(bb); (dir ? gcb : gcf)[i] = -__expf(Alog[di]) * sp; }
    }
    __syncthreads();
    if (wv < 2) {
        LAS float* gp = wv ? gcb : gcf; const int idx = wv ? 63 - lane : lane; float v = gp[idx];
#pragma unroll
        for (int o = 1; o < 64; o <<= 1) { const float t = __int_as_float(__builtin_amdgcn_ds_bpermute((lane - o) << 2, __float_as_int(v))); if (lane >= o) v += t; }
        gp[idx] = v; }
    const int mat = wid >> 2, bi = (wid >> 1) & 1, bj = wid & 1;
    f32x16 acc;
#pragma unroll
    for (int i = 0; i < 16; ++i) acc[i] = 0.f;
#pragma unroll
    for (int ks = 0; ks < 8; ++ks) { const bf16x8 a = *(const LAS bf16x8*)(lds + (mat ? CP_QS : CP_KS) + (32 * bi + r) * 272 + (ks * 16 + 8 * h) * 2);
        const bf16x8 bb = *(const LAS bf16x8*)(lds + CP_KS + (32 * bj + r) * 272 + (ks * 16 + 8 * h) * 2);
        acc = __builtin_amdgcn_mfma_f32_32x32x16_bf16(a, bb, acc, 0, 0, 0); }
    __syncthreads();
    LAS float* Lf = (LAS float*)(lds + CP_QS); LAS float* Lb = Lf + 4096;
    { const int j = 32 * bj + r; const float gfj = gcf[j], gbj = gcb[j];
        bf16_t* inf = (bf16_t*)(ws + WS_IF); bf16_t* inb = (bf16_t*)(ws + WS_IB);
#pragma unroll
        for (int x = 0; x < 16; ++x) { const int i = 32 * bi + (x & 3) + 8 * (x >> 2) + 4 * h; const float v = acc[x];
            const float df = __expf(fminf(gcf[i] - gfj, 0.f)), db = __expf(fminf(gcb[i] - gbj, 0.f));
            if (mat == 0) { Lf[i * 64 + j] = (j < i) ? betf[i] * v * df : 0.f; Lb[(63 - i) * 64 + (63 - j)] = (j > i) ? betb[i] * v * db : 0.f; }
            else { const size_t o = ((t0 + i) * 4 + hh) * 64 + j; inf[o] = (bf16_t)(pk2((j <= i) ? v * df : 0.f, 0.f) & 0xffff); inb[o] = (bf16_t)(pk2((j >= i) ? v * db : 0.f, 0.f) & 0xffff); } } }
    __syncthreads();
    if (wv == 0) tri_solve(Lf, (LAS bf16_t*)(lds + CP_T), (LAS bf16_t*)(lds + CP_T + 9216), lane, betf, gcf, false);
    else if (wv == 1) tri_solve(Lb, (LAS bf16_t*)(lds + CP_T + 18432), (LAS bf16_t*)(lds + CP_T + 27648), lane, betb, gcb, true);
    else if (wv == 2) {
        float* eg = (float*)(ws + WS_EG); float* ek = (float*)(ws + WS_EK); float* etot = (float*)(ws + WS_ETOT);
        const float gtf = gcf[63], gtb = gcb[0];
        eg[(t0 + lane) * 8 + hh] = __expf(gcf[lane]); ek[(t0 + lane) * 8 + hh] = __expf(gtf - gcf[lane]);
        eg[(t0 + lane) * 8 + 4 + hh] = __expf(gcb[lane]); ek[(t0 + lane) * 8 + 4 + hh] = __expf(gtb - gcb[lane]);
        if (lane == 0) { etot[((size_t)b * 128 + n) * 8 + hh] = __expf(gtf); etot[((size_t)b * 128 + n) * 8 + 4 + hh] = __expf(gtb); }
    } else if (wv >= 4) {
        bf16_t* kTg = (bf16_t*)(ws + WS_KT);
        for (int ch = tid - 256; ch < 1024; ch += 256) { const int dk = ch >> 3, pc = ch & 7;
            *(u32x4*)(kTg + ((size_t)(b * 4 + hh) * 128 + dk) * S_ + (size_t)n * 64 + pc * 8) = *(const LAS u32x4*)(lds + CP_KT + dk * 144 + pc * 16); }
    }
    __syncthreads();
    { const int dir = wid >> 2, wq = wid & 3; const LAS unsigned char* Tu = lds + CP_T + dir * 18432; const LAS unsigned char* Tw = Tu + 9216;
        if (wq < 2) { const int tb = wq; bf16_t* uT = (bf16_t*)(ws + (dir ? WS_UB : WS_UF));
#pragma unroll
            for (int nb = 0; nb < 4; ++nb) { f32x16 c;
#pragma unroll
                for (int i = 0; i < 16; ++i) c[i] = 0.f;
#pragma unroll
                for (int s = 0; s < 4; ++s) { const bf16x8 a = *(const LAS bf16x8*)(Tu + (32 * tb + r) * 144 + (16 * s + 8 * h) * 2);
                    const bf16x8 bb = *(const LAS bf16x8*)(lds + CP_VT + (32 * nb + r) * 144 + (16 * s + 8 * h) * 2);
                    c = __builtin_amdgcn_mfma_f32_32x32x16_bf16(a, bb, c, 0, 0, 0); }
                bf16_t* dst = uT + ((size_t)(b * 4 + hh) * 128 + 32 * nb + r) * S_ + (size_t)n * 64 + 32 * tb + 4 * h;
#pragma unroll
                for (int g4 = 0; g4 < 4; ++g4) { u32x2 w; w.x = pk2(c[4 * g4], c[4 * g4 + 1]); w.y = pk2(c[4 * g4 + 2], c[4 * g4 + 3]); *(u32x2*)(dst + 8 * g4) = w; } }
        } else { const int ib = wq - 2; bf16_t* wd = (bf16_t*)(ws + (dir ? WS_WB : WS_WF));
#pragma unroll
            for (int kb = 0; kb < 4; ++kb) { f32x16 c;
#pragma unroll
                for (int i = 0; i < 16; ++i) c[i] = 0.f;
#pragma unroll
                for (int s = 0; s < 4; ++s) { const bf16x8 a = *(const LAS bf16x8*)(lds + CP_KT + (32 * kb + r) * 144 + (16 * s + 8 * h) * 2);
                    const bf16x8 bb = *(const LAS bf16x8*)(Tw + (32 * ib + r) * 144 + (16 * s + 8 * h) * 2);
                    c = __builtin_amdgcn_mfma_f32_32x32x16_bf16(a, bb, c, 0, 0, 0); }
                bf16_t* dst = wd + (t0 + 32 * ib + r) * 512 + hh * 128 + 32 * kb + 4 * h;
#pragma unroll
                for (int g4 = 0; g4 < 4; ++g4) { u32x2 w; w.x = pk2(c[4 * g4], c[4 * g4 + 1]); w.y = pk2(c[4 * g4 + 2], c[4 * g4 + 3]); *(u32x2*)(dst + 8 * g4) = w; } }
        } }
    __syncthreads();
}

constexpr int SC_W = 0, SC_Q = 16896, SC_KT = 33792, SC_IN = SC_KT + 17408, SC_EG = SC_IN + 8704, SC_BUF = SC_EG + 528;
DI void gdn_scan(LAS unsigned char* lds, unsigned char* ws, int chain, const int wv) {
    const int b = chain >> 3, hh = (chain >> 1) & 3, dir = chain & 1;
    const bf16_t* wg = (const bf16_t*)(ws + (dir ? WS_WB : WS_WF)); const bf16_t* qg = (const bf16_t*)(ws + WS_QH); const bf16_t* kTg = (const bf16_t*)(ws + WS_KT);
    const bf16_t* ing = (const bf16_t*)(ws + (dir ? WS_IB : WS_IF)); const bf16_t* uTg = (const bf16_t*)(ws + (dir ? WS_UB : WS_UF));
    const float* egg = (const float*)(ws + WS_EG); const float* ekg = (const float*)(ws + WS_EK); const float* etg = (const float*)(ws + WS_ETOT);
    bf16_t* out = (bf16_t*)(ws + (dir ? WS_OB : WS_OF));
    const int tid = otid(wv), wid = tid >> 6, lane = tid & 63, r = lane & 31, h = lane >> 5;
    const int di = dir * 4 + hh;
    if (wv >= 4) {
        const int lt = tid - 256;
        for (int c = -1; c < 127; ++c) {
            const int n = dir ? 127 - (c + 1) : (c + 1); const size_t t0 = (size_t)b * S_ + (size_t)n * 64;
            LAS unsigned char* buf = lds + ((c + 1) & 1) * SC_BUF;
            u32x4 rw[4], rq[4], rk[4], ri[2];
#pragma unroll
            for (int k = 0; k < 4; ++k) { const int ch = lt + k * 256, i = ch >> 4, pc = ch & 15; const size_t src = (t0 + i) * 512 + hh * 128 + pc * 8; rw[k] = *(const u32x4*)(wg + src); rq[k] = *(const u32x4*)(qg + src); }
#pragma unroll
            for (int k = 0; k < 4; ++k) { const int ch = lt + k * 256, dk = ch >> 3, pc = ch & 7; rk[k] = *(const u32x4*)(kTg + ((size_t)(b * 4 + hh) * 128 + dk) * S_ + (size_t)n * 64 + pc * 8); }
#pragma unroll
            for (int k = 0; k < 2; ++k) { const int ch = lt + k * 256, i = ch >> 3, pc = ch & 7; ri[k] = *(const u32x4*)(ing + ((t0 + i) * 4 + hh) * 64 + pc * 8); }
            float ev = 0.f;
            if (lt < 64) ev = egg[(t0 + lt) * 8 + di]; else if (lt < 128) ev = ekg[(t0 + lt - 64) * 8 + di]; else if (lt == 128) ev = etg[((size_t)b * 128 + n) * 8 + di];
#pragma unroll
            for (int k = 0; k < 4; ++k) { const int ch = lt + k * 256, i = ch >> 4, pc = ch & 15;
                *(LAS u32x2*)(buf + SC_W + i * 264 + pc * 16) = (u32x2){rw[k].x, rw[k].y}; *(LAS u32x2*)(buf + SC_W + i * 264 + pc * 16 + 8) = (u32x2){rw[k].z, rw[k].w};
                *(LAS u32x2*)(buf + SC_Q + i * 264 + pc * 16) = (u32x2){rq[k].x, rq[k].y}; *(LAS u32x2*)(buf + SC_Q + i * 264 + pc * 16 + 8) = (u32x2){rq[k].z, rq[k].w}; }
#pragma unroll
            for (int k = 0; k < 4; ++k) { const int ch = lt + k * 256, dk = ch >> 3, pc = ch & 7;
                *(LAS u32x2*)(buf + SC_KT + dk * 136 + pc * 16) = (u32x2){rk[k].x, rk[k].y}; *(LAS u32x2*)(buf + SC_KT + dk * 136 + pc * 16 + 8) = (u32x2){rk[k].z, rk[k].w}; }
#pragma unroll
            for (int k = 0; k < 2; ++k) { const int ch = lt + k * 256, i = ch >> 3, pc = ch & 7;
                *(LAS u32x2*)(buf + SC_IN + i * 136 + pc * 16) = (u32x2){ri[k].x, ri[k].y}; *(LAS u32x2*)(buf + SC_IN + i * 136 + pc * 16 + 8) = (u32x2){ri[k].z, ri[k].w}; }
            if (lt <= 128) *(LAS float*)(buf + SC_EG + lt * 4) = ev;
            __syncthreads();
        }
        __syncthreads();
    } else {
        const int nb = wid;
        f32x16 Sa[4];
#pragma unroll
        for (int kb = 0; kb < 4; ++kb)
#pragma unroll
            for (int i = 0; i < 16; ++i) Sa[kb][i] = 0.f;
        u32x2 ur[2][4], un[2][4];
        { const int n0 = dir ? 127 : 0; const bf16_t* up = uTg + ((size_t)(b * 4 + hh) * 128 + 32 * nb + r) * S_ + (size_t)n0 * 64 + 4 * h;
#pragma unroll
            for (int tb = 0; tb < 2; ++tb)
#pragma unroll
                for (int g4 = 0; g4 < 4; ++g4) un[tb][g4] = *(const u32x2*)(up + 32 * tb + 8 * g4); }
        __syncthreads();
        for (int c = 0; c < 128; ++c) {
            const int n = dir ? 127 - c : c; const size_t t0 = (size_t)b * S_ + (size_t)n * 64;
            const LAS unsigned char* buf = lds + (c & 1) * SC_BUF;
#pragma unroll
            for (int tb = 0; tb < 2; ++tb)
#pragma unroll
                for (int g4 = 0; g4 < 4; ++g4) ur[tb][g4] = un[tb][g4];
            if (c + 1 < 128) { const int n1 = dir ? 126 - c : c + 1; const bf16_t* up = uTg + ((size_t)(b * 4 + hh) * 128 + 32 * nb + r) * S_ + (size_t)n1 * 64 + 4 * h;
#pragma unroll
                for (int tb = 0; tb < 2; ++tb)
#pragma unroll
                    for (int g4 = 0; g4 < 4; ++g4) un[tb][g4] = *(const u32x2*)(up + 32 * tb + 8 * g4); }
            bf16x8 Sb[4][2];
#pragma unroll
            for (int kb = 0; kb < 4; ++kb) { Sb[kb][0] = pack8n(Sa[kb], 0); Sb[kb][1] = pack8n(Sa[kb], 1); }
            f32x16 X[2], Y[2];
#pragma unroll
            for (int i = 0; i < 16; ++i) { X[0][i] = 0.f; X[1][i] = 0.f; Y[0][i] = 0.f; Y[1][i] = 0.f; }
#pragma unroll
            for (int kb = 0; kb < 4; ++kb)
#pragma unroll
                for (int s = 0; s < 2; ++s)
#pragma unroll
                    for (int tb = 0; tb < 2; ++tb) { const int off = (32 * tb + r) * 264 + (32 * kb + 16 * s + 4 * h) * 2;
                        const s16x4 w0 = *(const LAS s16x4*)(buf + SC_W + off), w1 = *(const LAS s16x4*)(buf + SC_W + off + 16);
                        const s16x4 q0 = *(const LAS s16x4*)(buf + SC_Q + off), q1 = *(const LAS s16x4*)(buf + SC_Q + off + 16);
                        X[tb] = __builtin_amdgcn_mfma_f32_32x32x16_bf16(__builtin_shufflevector(w0, w1, 0, 1, 2, 3, 4, 5, 6, 7), Sb[kb][s], X[tb], 0, 0, 0);
                        Y[tb] = __builtin_amdgcn_mfma_f32_32x32x16_bf16(__builtin_shufflevector(q0, q1, 0, 1, 2, 3, 4, 5, 6, 7), Sb[kb][s], Y[tb], 0, 0, 0); }
            f32x16 vn[2];
#pragma unroll
            for (int tb = 0; tb < 2; ++tb)
#pragma unroll
                for (int g4 = 0; g4 < 4; ++g4) { const u32x2 uu = ur[tb][g4];
                    vn[tb][4 * g4] = bflo(uu.x) - X[tb][4 * g4]; vn[tb][4 * g4 + 1] = bfhi(uu.x) - X[tb][4 * g4 + 1];
                    vn[tb][4 * g4 + 2] = bflo(uu.y) - X[tb][4 * g4 + 2]; vn[tb][4 * g4 + 3] = bfhi(uu.y) - X[tb][4 * g4 + 3]; }
            bf16x8 vb[2][2];
#pragma unroll
            for (int tb = 0; tb < 2; ++tb) { vb[tb][0] = pack8n(vn[tb], 0); vb[tb][1] = pack8n(vn[tb], 1); }
#pragma unroll
            for (int tb = 0; tb < 2; ++tb)
#pragma unroll
                for (int g4 = 0; g4 < 4; ++g4) { const f32x4 e4 = *(const LAS f32x4*)(buf + SC_EG + (32 * tb + 8 * g4 + 4 * h) * 4);
#pragma unroll
                    for (int e = 0; e < 4; ++e) Y[tb][4 * g4 + e] *= e4[e]; }
#pragma unroll
            for (int tb = 0; tb < 2; ++tb)
#pragma unroll
                for (int t2 = 0; t2 < 2; ++t2)
#pragma unroll
                    for (int s = 0; s < 2; ++s) { const int off = (32 * tb + r) * 136 + (32 * t2 + 16 * s + 4 * h) * 2;
                        const s16x4 a0 = *(const LAS s16x4*)(buf + SC_IN + off), a1 = *(const LAS s16x4*)(buf + SC_IN + off + 16);
                        Y[tb] = __builtin_amdgcn_mfma_f32_32x32x16_bf16(__builtin_shufflevector(a0, a1, 0, 1, 2, 3, 4, 5, 6, 7), vb[t2][s], Y[tb], 0, 0, 0); }
#pragma unroll
            for (int tb = 0; tb < 2; ++tb)
#pragma unroll
                for (int g4 = 0; g4 < 4; ++g4) { const f32x4 e4 = *(const LAS f32x4*)(buf + SC_EG + 256 + (32 * tb + 8 * g4 + 4 * h) * 4);
#pragma unroll
                    for (int e = 0; e < 4; ++e) vn[tb][4 * g4 + e] *= e4[e]; }
#pragma unroll
            for (int tb = 0; tb < 2; ++tb) { vb[tb][0] = pack8n(vn[tb], 0); vb[tb][1] = pack8n(vn[tb], 1); }
            const float et = *(const LAS float*)(buf + SC_EG + 512);
#pragma unroll
            for (int kb = 0; kb < 4; ++kb) {
#pragma unroll
                for (int i = 0; i < 16; ++i) Sa[kb][i] *= et;
#pragma unroll
                for (int tb = 0; tb < 2; ++tb)
#pragma unroll
                    for (int s = 0; s < 2; ++s) { const int off = (32 * kb + r) * 136 + (32 * tb + 16 * s + 4 * h) * 2;
                        const s16x4 a0 = *(const LAS s16x4*)(buf + SC_KT + off), a1 = *(const LAS s16x4*)(buf + SC_KT + off + 16);
                        Sa[kb] = __builtin_amdgcn_mfma_f32_32x32x16_bf16(__builtin_shufflevector(a0, a1, 0, 1, 2, 3, 4, 5, 6, 7), vb[tb][s], Sa[kb], 0, 0, 0); } }
#pragma unroll
            for (int tb = 0; tb < 2; ++tb)
#pragma unroll
                for (int x = 0; x < 16; ++x) { const int i = 32 * tb + (x & 3) + 8 * (x >> 2) + 4 * h;
                    out[(t0 + i) * 512 + hh * 128 + 32 * nb + r] = (bf16_t)(pk2(Y[tb][x], 0.f) & 0xffff); }
            __syncthreads();
        }
    }
}

DI bf16x8 pack8(const f32x16& x, int s) {
    u32x4 pk;
    if (s == 0) asm volatile("v_cvt_pk_bf16_f32 %0, %4, %5\n\tv_cvt_pk_bf16_f32 %1, %6, %7\n\tv_cvt_pk_bf16_f32 %2, %8, %9\n\tv_cvt_pk_bf16_f32 %3, %10, %11\n\ts_nop 1"
               : "=&v"(pk[0]), "=&v"(pk[1]), "=&v"(pk[2]), "=&v"(pk[3]) : "v"(x[0]), "v"(x[1]), "v"(x[2]), "v"(x[3]), "v"(x[4]), "v"(x[5]), "v"(x[6]), "v"(x[7]));
    else asm volatile("v_cvt_pk_bf16_f32 %0, %4, %5\n\tv_cvt_pk_bf16_f32 %1, %6, %7\n\tv_cvt_pk_bf16_f32 %2, %8, %9\n\tv_cvt_pk_bf16_f32 %3, %10, %11\n\ts_nop 1"
               : "=&v"(pk[0]), "=&v"(pk[1]), "=&v"(pk[2]), "=&v"(pk[3]) : "v"(x[8]), "v"(x[9]), "v"(x[10]), "v"(x[11]), "v"(x[12]), "v"(x[13]), "v"(x[14]), "v"(x[15]));
    return __builtin_bit_cast(bf16x8, pk);
}
constexpr int AT_KROW = 208, AT_VROW = 136, AT_KBYTES = 64 * AT_KROW, AT_BUF = AT_KBYTES + 64 * AT_VROW;
DI void attn_tile(const LAS unsigned char* kcur, const LAS unsigned char* vcur, const bf16x8 (&bq)[2][6], f32x16 (&oT)[2][2],
                  float (&mrun)[2], float (&lrun)[2], int lane, int r, int hf, int kh) {
    f32x16 sT[2];
#pragma unroll
    for (int i = 0; i < 16; ++i) { sT[0][i] = 0.f; sT[1][i] = 0.f; }
#pragma unroll
    for (int ks = 0; ks < 6; ++ks) { const bf16x8 a = *(const LAS bf16x8*)(kcur + (kh * 32 + r) * AT_KROW + (ks * 16 + 8 * hf) * 2);
        sT[0] = __builtin_amdgcn_mfma_f32_32x32x16_bf16(a, bq[0][ks], sT[0], 0, 0, 0);
        sT[1] = __builtin_amdgcn_mfma_f32_32x32x16_bf16(a, bq[1][ks], sT[1], 0, 0, 0); }
#pragma unroll
    for (int qb = 0; qb < 2; ++qb) {
        float mx = sT[qb][0];
#pragma unroll
        for (int i = 1; i < 16; ++i) mx = fmaxf(mx, sT[qb][i]);
        mx = fmaxf(mx, lane_xor(mx, lane, 32));
        if (__builtin_amdgcn_ballot_w64(mx > mrun[qb] + 8.0f) != 0ull) {
            const float mnew = fmaxf(mrun[qb], mx), alpha = __builtin_amdgcn_exp2f(mrun[qb] - mnew); mrun[qb] = mnew; lrun[qb] *= alpha;
#pragma unroll
            for (int i = 0; i < 16; ++i) { oT[qb][0][i] *= alpha; oT[qb][1][i] *= alpha; }
        }
        float rs = 0.f;
#pragma unroll
        for (int i = 0; i < 16; ++i) { sT[qb][i] = __builtin_amdgcn_exp2f(sT[qb][i] - mrun[qb]); rs += sT[qb][i]; }
        lrun[qb] += rs;
    }
#pragma unroll
    for (int s = 0; s < 2; ++s) { const bf16x8 bp0 = pack8n(sT[0], s), bp1 = pack8n(sT[1], s);
#pragma unroll
        for (int dvb = 0; dvb < 2; ++dvb) { const LAS unsigned char* va = vcur + (dvb * 32 + r) * AT_VROW + (kh * 32 + 16 * s + 4 * hf) * 2;
            const s16x4 lo = *(const LAS s16x4*)va, hi = *(const LAS s16x4*)(va + 16); const bf16x8 a = __builtin_shufflevector(lo, hi, 0, 1, 2, 3, 4, 5, 6, 7);
            oT[0][dvb] = __builtin_amdgcn_mfma_f32_32x32x16_bf16(a, bp0, oT[0][dvb], 0, 0, 0);
            oT[1][dvb] = __builtin_amdgcn_mfma_f32_32x32x16_bf16(a, bp1, oT[1][dvb], 0, 0, 0); } }
}
constexpr int AT_XCH = 45056;
DI void attn_unit(LAS unsigned char* lds, const bf16_t* Q, const bf16_t* Kn, const bf16_t* Kr, const bf16_t* Vt, bf16_t* O, const float* cosT, const float* sinT, int b, int hh, int qblk, const int wv) {
    const int tid = otid(wv), wid = tid >> 6, lane = tid & 63, r = lane & 31, hf = lane >> 5, g = wv & 3, kh = wv >> 2;
    const size_t q0 = (size_t)b * S_ + (size_t)qblk * 256 + g * 64;
    const int kc0 = tid, kc1 = tid + 512; const bool has1 = tid < 256;
    const int key0 = kc0 / 12, part0 = kc0 % 12, key1 = has1 ? kc1 / 12 : 0, part1 = has1 ? kc1 % 12 : 0;
    const bf16_t* ks0 = (part0 < 8) ? Kn + ((size_t)b * S_ + key0) * 512 + hh * 64 + part0 * 8 : Kr + ((size_t)b * S_ + key0) * 32 + (part0 - 8) * 8;
    const bf16_t* ks1 = (part1 < 8) ? Kn + ((size_t)b * S_ + key1) * 512 + hh * 64 + part1 * 8 : Kr + ((size_t)b * S_ + key1) * 32 + (part1 - 8) * 8;
    const size_t kst0 = (part0 < 8) ? 512 : 32, kst1 = (part1 < 8) ? 512 : 32;
    const int kd0 = key0 * AT_KROW + part0 * 16, kd1 = key1 * AT_KROW + part1 * 16;
    const int vdv = tid >> 3, vpart = tid & 7;
    const bf16_t* vsrc = Vt + (size_t)(hh * 64 + vdv) * T_ + (size_t)b * S_ + vpart * 8;
    const int vd = AT_KBYTES + vdv * AT_VROW + vpart * 16;
    u32x4 kr0, kr1 = (u32x4){0, 0, 0, 0}, vr;
    kr0 = *(const u32x4*)ks0; if (has1) kr1 = *(const u32x4*)ks1; vr = *(const u32x4*)vsrc;
    bf16x8 bq[2][6];
#pragma unroll
    for (int qb = 0; qb < 2; ++qb) {
#pragma unroll
        for (int ks = 0; ks < 6; ++ks) bq[qb][ks] = *(const bf16x8*)(Q + (q0 + qb * 32 + r) * 768 + hh * 96 + ks * 16 + 8 * hf);
        const float* cp = cosT + (q0 + qb * 32 + r) * 16 + 8 * hf; const float* sp = sinT + (q0 + qb * 32 + r) * 16 + 8 * hf;
        const f32x4 c0 = *(const f32x4*)cp, c1 = *(const f32x4*)(cp + 4), s0 = *(const f32x4*)sp, s1 = *(const f32x4*)(sp + 4);
        const u32x4 x1 = __builtin_bit_cast(u32x4, bq[qb][4]), x2 = __builtin_bit_cast(u32x4, bq[qb][5]); u32x4 y1, y2;
#pragma unroll
        for (int e = 0; e < 4; ++e) { const float a0 = bflo(x1[e]), a1 = bfhi(x1[e]), b0 = bflo(x2[e]), b1 = bfhi(x2[e]);
            const float cc0 = e < 2 ? c0[2 * e] : c1[2 * e - 4], cc1 = e < 2 ? c0[2 * e + 1] : c1[2 * e - 3], ss0 = e < 2 ? s0[2 * e] : s1[2 * e - 4], ss1 = e < 2 ? s0[2 * e + 1] : s1[2 * e - 3];
            y1[e] = pk2(a0 * cc0 - b0 * ss0, a1 * cc1 - b1 * ss1); y2[e] = pk2(b0 * cc0 + a0 * ss0, b1 * cc1 + a1 * ss1); }
        bq[qb][4] = __builtin_bit_cast(bf16x8, y1); bq[qb][5] = __builtin_bit_cast(bf16x8, y2); }
    f32x16 oT[2][2];
#pragma unroll
    for (int i = 0; i < 16; ++i) { oT[0][0][i] = 0.f; oT[0][1][i] = 0.f; oT[1][0][i] = 0.f; oT[1][1][i] = 0.f; }
    float mrun[2] = {-1e30f, -1e30f}, lrun[2] = {0.f, 0.f};
    *(LAS u32x4*)(lds + kd0) = kr0; if (has1) *(LAS u32x4*)(lds + kd1) = kr1;
    *(LAS u32x2*)(lds + vd) = (u32x2){vr.x, vr.y}; *(LAS u32x2*)(lds + vd + 8) = (u32x2){vr.z, vr.w};
    __syncthreads();
    for (int t = 0; t < 128; ++t) {
        const LAS unsigned char* kb_ = lds + (t & 1) * AT_BUF;
        if (t + 1 < 128) { const size_t ko = (size_t)(t + 1) * 64; kr0 = *(const u32x4*)(ks0 + ko * kst0); if (has1) kr1 = *(const u32x4*)(ks1 + ko * kst1); vr = *(const u32x4*)(vsrc + ko); }
        attn_tile(kb_, kb_ + AT_KBYTES, bq, oT, mrun, lrun, lane, r, hf, kh);
        if (t + 1 < 128) { LAS unsigned char* nb = lds + ((t + 1) & 1) * AT_BUF;
            *(LAS u32x4*)(nb + kd0) = kr0; if (has1) *(LAS u32x4*)(nb + kd1) = kr1;
            *(LAS u32x2*)(nb + vd) = (u32x2){vr.x, vr.y}; *(LAS u32x2*)(nb + vd + 8) = (u32x2){vr.z, vr.w}; }
        __syncthreads();
    }
    LAS float* xw = (LAS float*)(lds + AT_XCH) + g * (68 * 64) + lane;
    if (kh == 1) {
#pragma unroll
        for (int qb = 0; qb < 2; ++qb) { xw[(64 + qb) * 64] = mrun[qb]; xw[(64 + 2 + qb) * 64 - 128 + 128] = lrun[qb];
#pragma unroll
            for (int dvb = 0; dvb < 2; ++dvb)
#pragma unroll
                for (int i = 0; i < 16; ++i) xw[((qb * 2 + dvb) * 16 + i) * 64] = oT[qb][dvb][i]; }
    }
    __syncthreads();
    if (kh == 0) {
#pragma unroll
        for (int qb = 0; qb < 2; ++qb) { const float m1 = xw[(64 + qb) * 64], l1 = xw[(66 + qb) * 64 - 128 + 128];
            const float m = fmaxf(mrun[qb], m1), a0 = __builtin_amdgcn_exp2f(mrun[qb] - m), a1 = __builtin_amdgcn_exp2f(m1 - m);
            float l = lrun[qb] * a0 + l1 * a1; l += lane_xor(l, lane, 32); const float inv = 1.0f / l, f0 = a0 * inv, f1 = a1 * inv;
#pragma unroll
            for (int dvb = 0; dvb < 2; ++dvb)
#pragma unroll
                for (int g4 = 0; g4 < 4; ++g4) { float o[4];
#pragma unroll
                    for (int e = 0; e < 4; ++e) o[e] = oT[qb][dvb][4 * g4 + e] * f0 + xw[((qb * 2 + dvb) * 16 + 4 * g4 + e) * 64] * f1;
                    u32x2 w; w.x = pk2(o[0], o[1]); w.y = pk2(o[2], o[3]);
                    *(u32x2*)(O + (q0 + qb * 32 + r) * 512 + hh * 64 + dvb * 32 + 8 * g4 + 4 * hf) = w; } }
    }
}

DI void gdn_gate_norm(const Params& p, unsigned char* ws, int l, const int wv) {
    const bf16_t* of = (const bf16_t*)(ws + WS_OF); const bf16_t* ob = (const bf16_t*)(ws + WS_OB); const bf16_t* z = (const bf16_t*)(ws + WS_Z);
    bf16_t* ag = (bf16_t*)(ws + WS_AG); const float* nw = p.in[11] + l * 128;
    const int tid_ = otid(wv); const int lane = tid_ & 63, wid = tid_ >> 6;
    const f32x4 n0 = *(const f32x4*)(nw + (lane & 15) * 8), n1 = *(const f32x4*)(nw + (lane & 15) * 8 + 4);
    for (int t = (blockIdx.x * 8 + wid) * 2; t < T_; t += gridDim.x * 16) {
        u32x4 a[2], b[2], zz[2];
#pragma unroll
        for (int rr = 0; rr < 2; ++rr) { const size_t o = (size_t)(t + rr) * 512 + lane * 8; a[rr] = *(const u32x4*)(of + o); b[rr] = *(const u32x4*)(ob + o); zz[rr] = *(const u32x4*)(z + o); }
#pragma unroll
        for (int rr = 0; rr < 2; ++rr) { float v[8]; float ss = 0.f;
#pragma unroll
            for (int e = 0; e < 4; ++e) { v[2 * e] = bflo(a[rr][e]) + bflo(b[rr][e]); v[2 * e + 1] = bfhi(a[rr][e]) + bfhi(b[rr][e]); ss += v[2 * e] * v[2 * e] + v[2 * e + 1] * v[2 * e + 1]; }
            ss += lane_xor(ss, lane, 1); ss += lane_xor(ss, lane, 2); ss += lane_xor(ss, lane, 4); ss += lane_xor(ss, lane, 8);
            const float rstd = rsqrtf(ss * (1.0f / 128.f) + EPS_); u32x4 w;
#pragma unroll
            for (int e = 0; e < 4; ++e) { const float w0 = (2 * e < 4) ? n0[2 * e] : n1[2 * e - 4], w1 = (2 * e + 1 < 4) ? n0[2 * e + 1] : n1[2 * e - 3];
                w[e] = pk2(v[2 * e] * rstd * w0 * siluf_(bflo(zz[rr][e])), v[2 * e + 1] * rstd * w1 * siluf_(bfhi(zz[rr][e]))); }
            *(u32x4*)(ag + (size_t)(t + rr) * 512 + lane * 8) = w; }
    }
}

#define XB_TMO      128
#define XB_XCNT(j)  (256  + 64 * (j))
#define XB_XSUB(j)  (1280 + 64 * (j))
#define XB_XGEN(j)  (2304 + 64 * (j))
#define XB_TOP      3328
#define XB_TOPGEN   3392
#define XCD_BAR_WORDS 3456
#define XB_SPIN_CAP (1u << 18)
DI unsigned xb_ld(unsigned* p)              { return __hip_atomic_load(p, __ATOMIC_RELAXED, __HIP_MEMORY_SCOPE_AGENT); }
DI unsigned xb_add(unsigned* p, unsigned v) { return __hip_atomic_fetch_add(p, v, __ATOMIC_RELAXED, __HIP_MEMORY_SCOPE_AGENT); }
DI unsigned xb_xcc_id() { return (unsigned)__builtin_amdgcn_s_getreg((3 << 11) | 20) & 0xFu; }
#define XB_SPIN(cond, bar) do { unsigned _sp = 0; while (cond) { __builtin_amdgcn_s_sleep(1); \
    if ((++_sp & 255u) == 0u) { if (xb_ld(&(bar)[XB_TMO])) break; if (_sp > XB_SPIN_CAP) { atomicAdd(&(bar)[XB_TMO], 1u); break; } } } } while (0)
DI void xcd_barrier_complete(unsigned* bar, unsigned x, unsigned G, unsigned& nloc, unsigned& nx) {
    unsigned sum, cnt, mine, sp = 0u;
    for (;;) {
        sum = 0u; cnt = 0u; mine = 0u;
#pragma unroll
        for (unsigned j = 0; j < 16; ++j) { const unsigned c = xb_ld(&bar[XB_XCNT(j)]); sum += c; cnt += (c > 0u) ? 1u : 0u; mine = (j == x) ? c : mine; }
        if (sum == G) break;
        __builtin_amdgcn_s_sleep(1);
        if ((++sp & 255u) == 0u) { if (xb_ld(&bar[XB_TMO])) break; if (sp > XB_SPIN_CAP) { atomicAdd(&bar[XB_TMO], 1u); break; } }
    }
    nloc = mine > 0u ? mine : 1u; nx = cnt > 0u ? cnt : 1u;
}
DI void xcd_barrier(unsigned* bar, volatile LAS unsigned* st, unsigned G, const int wv) {
    asm volatile("s_waitcnt vmcnt(0)" ::: "memory");
    __syncthreads();
    if (otid(wv) == 0) {
        const unsigned x = xb_xcc_id();
        __builtin_amdgcn_s_waitcnt(0);
        unsigned nloc = st[0], nx = st[1];
        if (nloc == 0u) { xcd_barrier_complete(bar, x, G, nloc, nx); st[0] = nloc; st[1] = nx; }
        const unsigned old = xb_add(&bar[XB_XSUB(x)], 1u);
        const unsigned gen = old / nloc;
        if (old + 1u == (gen + 1u) * nloc) {
            __builtin_amdgcn_fence(__ATOMIC_RELEASE, "agent");
            asm volatile("s_waitcnt vmcnt(0)" ::: "memory");
            const unsigned og = xb_add(&bar[XB_TOP], 1u);
            const unsigned tg = og / nx;
            if (og + 1u == (tg + 1u) * nx) xb_add(&bar[XB_TOPGEN], 1u);
            else XB_SPIN(xb_ld(&bar[XB_TOPGEN]) == tg, bar);
            __builtin_amdgcn_fence(__ATOMIC_ACQUIRE, "agent");
            xb_add(&bar[XB_XGEN(x)], 1u);
            asm volatile("s_waitcnt vmcnt(0)" ::: "memory");
        } else {
            XB_SPIN(xb_ld(&bar[XB_XGEN(x)]) == gen, bar);
            __builtin_amdgcn_fence(__ATOMIC_ACQUIRE, "agent");
            asm volatile("s_waitcnt vmcnt(0)" ::: "memory");
        }
    }
    __syncthreads();
}

__global__ void __launch_bounds__(512, 2) mega(Params p) {
    extern __shared__ __attribute__((aligned(16))) unsigned char shm[];
    LAS unsigned char* lds = (LAS unsigned char*)shm;
    const int wv = __builtin_amdgcn_readfirstlane(threadIdx.x >> 6);
    volatile LAS unsigned* xst = (volatile LAS unsigned*)(lds + 131072);
    if (threadIdx.x < 2) xst[threadIdx.x] = 0u;
    __syncthreads();
    if (threadIdx.x == 0) (void)xb_add((unsigned*)(p.ws + WS_BAR) + XB_XCNT(xb_xcc_id()), 1u);
    const int ph_lo = __builtin_amdgcn_readfirstlane(p.ph_lo), ph_hi = __builtin_amdgcn_readfirstlane(p.ph_hi);
    for (int ph = ph_lo; ph < ph_hi; ++ph) {
        size_t zoff = 0; int G = gridDim.x, bid = blockIdx.x;
        asm volatile("" : "+s"(zoff), "+s"(G), "+s"(bid));
        unsigned char* ws = p.ws + zoff;
        const int gstride = G * 512;
        if (ph == 0) {
            const int gtid = bid * 512 + otid(wv);
            if (bid == 0 && gtid < 16) *((unsigned*)(ws + WS_CTR) + gtid * 64) = 0u;
            const int* pos = (const int*)p.in[1]; float* cosT = (float*)(ws + WS_COS); float* sinT = (float*)(ws + WS_SIN);
            for (int idx = gtid; idx < T_ * 16; idx += gstride) { const int t = idx >> 4, i = idx & 15;
                const double rev = (double)pos[t] * p.invf_rev[i]; const float fr = (float)(rev - rint(rev));
                cosT[idx] = __builtin_amdgcn_cosf(fr); sinT[idx] = __builtin_amdgcn_sinf(fr); }
        } else if (ph == NPH_ - 1) {
            rms_rows<true>(p.out, p.in[23], p.out, wv);
        } else {
            const int l = (ph - 1) / NS_, sl = (ph - 1) % NS_, st = (PROBE_ST >= 0 && sl > PROBE_ST) ? sl - 1 : sl;
            const bool ffn2 = st >= 12; const int fs = ffn2 ? st - 12 : st;
            const float* xin = (l == 0 && st < 3) ? p.in[0] : p.out;
            if ((st < 3 || ffn2)) {
                const int ig = ffn2 ? 20 : 3, iu = ffn2 ? 21 : 4, idn = ffn2 ? 22 : 5, inw = ffn2 ? 19 : 2;
                if (fs == 0 && EN(0)) {
                    const int gtid = bid * 512 + otid(wv);
                    rms_rows<false>(xin, p.in[inw] + (size_t)l * D_, ws + WS_H, wv);
                    conv_w(p.in[ig] + (size_t)l * D_ * FF_, p.in[iu] + (size_t)l * D_ * FF_, FF_, (bf16_t*)(ws + W_GU), 5632, 1024, 1, nullptr, gtid, gstride);
                    conv_w(p.in[idn] + (size_t)l * D_ * FF_, nullptr, D_, (bf16_t*)(ws + W_D), 1024, FF_, 0, nullptr, gtid, gstride);
                } else if (fs == 1 && EN(1)) {
                    pg8::Gemm g{(const bf16_t*)(ws + WS_H), (const bf16_t*)(ws + W_GU), T_, 5632, 1024, 1024, 1024}; pg8::StaticOrder S; S.init(T_, 5632, G, bid);
                    pg8::EpiSwiglu E{(bf16_t*)(ws + WS_BIG), FF_}; pg8::gemm_phase(lds, g, S, E, wv);
                } else if (EN(2)) {
                    pg8::Gemm g{(const bf16_t*)(ws + WS_BIG), (const bf16_t*)(ws + W_D), T_, 1024, FF_, FF_, FF_}; pg8::StaticOrder S; S.init(T_, 1024, G, bid);
                    pg8::EpiResid E{xin, p.out, 0.5f}; pg8::gemm_phase(lds, g, S, E, wv);
                }
            } else if (st == 3 && EN(3)) {
                const int gtid = bid * 512 + otid(wv);
                rms_rows<false>(p.out, p.in[6] + (size_t)l * D_, ws + WS_H, wv);
                const float* win = p.in[7] + (size_t)l * D_ * 4784;
                conv_w(win, nullptr, 4784, (bf16_t*)(ws + W_IN), 2816, 1024, 2, nullptr, gtid, gstride);
                conv_w(win, nullptr, 4784, (bf16_t*)(ws + W_G), 2048, 1024, 3, nullptr, gtid, gstride);
                conv_w(p.in[12] + (size_t)l * 512 * 1024, nullptr, 1024, (bf16_t*)(ws + W_PA), 1024, 512, 0, nullptr, gtid, gstride);
                conv_w(p.in[17] + (size_t)l * 512 * 1024, nullptr, 1024, (bf16_t*)(ws + W_PB), 1024, 512, 0, nullptr, gtid, gstride);
                conv_w(p.in[18] + (size_t)l * 1024 * 1024, nullptr, 1024, (bf16_t*)(ws + W_OUT), 1024, 1024, 0, nullptr, gtid, gstride);
                conv_w(p.in[14] + (size_t)l * 384 * 768, nullptr, 768, (bf16_t*)(ws + W_UQ), 768, 384, 0, nullptr, gtid, gstride);
                conv_w(p.in[16] + (size_t)l * 256 * 1024, nullptr, 1024, (bf16_t*)(ws + W_UK), 512, 256, 4, nullptr, gtid, gstride);
                conv_w(p.in[16] + (size_t)l * 256 * 1024, nullptr, 1024, (bf16_t*)(ws + W_UV), 512, 256, 5, nullptr, gtid, gstride);
            } else if (st == 4 && EN(4)) {
                pg8::Gemm g{(const bf16_t*)(ws + WS_H), (const bf16_t*)(ws + W_IN), T_, 2816, 1024, 1024, 1024}; pg8::StaticOrder S; S.init(T_, 2816, G, bid);
                pg8::EpiBf16 E{(bf16_t*)(ws + WS_GQKV), 1536, 6, (bf16_t*)(ws + WS_Z), 512, 8, (bf16_t*)(ws + WS_REST), 768, 1.0f};
                pg8::gemm_phase(lds, g, S, E, wv);
            } else if (st == 5 && EN(5)) {
                const float* cw = p.in[8] + (size_t)l * 5 * 1536;
                for (int u = bid; u < 2048; u += G) gdn_chunk_pre(lds, ws, cw, p.in[9] + l * 8, p.in[10] + l * 8, u, wv);
                mla_latent_pass(p, ws, l, wv);
            } else if (st == 6 && EN(6)) {
                const bf16_t* rest = (const bf16_t*)(ws + WS_REST);
                if (EN(16)) { pg8::Gemm g{rest, (const bf16_t*)(ws + W_UQ), T_, 768, 384, 768, 384}; pg8::StaticOrder S; S.init(T_, 768, G, bid);
                  pg8::EpiBf16 E{(bf16_t*)(ws + WS_Q), 768, 1000, nullptr, 0, 1000, nullptr, 0, 0.10206207261596575f * 1.4426950408889634f};
                  pg8::gemm_phase(lds, g, S, E, wv); }
                if (EN(17)) { pg8::Gemm g{rest + 384, (const bf16_t*)(ws + W_UK), T_, 512, 256, 768, 256}; pg8::StaticOrder S; S.init(T_, 512, G, bid);
                  pg8::EpiBf16 E{(bf16_t*)(ws + WS_KN), 512, 1000, nullptr, 0, 1000, nullptr, 0, 1.0f};
                  pg8::gemm_phase(lds, g, S, E, wv); }
                if (EN(18)) { pg8::Gemm g{(const bf16_t*)(ws + W_UV), rest + 384, 512, T_, 256, 256, 768}; pg8::StaticOrder S; S.init(512, T_, G, bid);
                  pg8::EpiBf16 E{(bf16_t*)(ws + WS_VT), T_, 1000, nullptr, 0, 1000, nullptr, 0, 1.0f};
                  pg8::gemm_phase(lds, g, S, E, wv); }
            } else if (st == 7 && EN(7)) {
                if (bid < 32) gdn_scan(lds, ws, bid, wv);
                const bf16_t* Q = (const bf16_t*)(ws + WS_Q); const bf16_t* Kn = (const bf16_t*)(ws + WS_KN); const bf16_t* Kr = (const bf16_t*)(ws + WS_KR);
                const bf16_t* Vt = (const bf16_t*)(ws + WS_VT); bf16_t* AO = (bf16_t*)(ws + WS_AO);
                if (G == 256) { const int xcd = bid & 7; unsigned* ctr = (unsigned*)(ws + WS_CTR) + (l * 8 + xcd) * 64;
                    const bool t0 = otid(wv) == 0; unsigned nxt = 0u; if (t0) nxt = atomicAdd(ctr, 1u);
                    for (;;) { __syncthreads(); if (t0) *(LAS unsigned*)(lds + 131072 + 32) = nxt; __syncthreads();
                        const unsigned u = *(const LAS unsigned*)(lds + 131072 + 32); if (u >= 128u) break;
                        if (t0) nxt = atomicAdd(ctr, 1u);
                        const int pair = (int)(u >> 5) * 8 + xcd; attn_unit(lds, Q, Kn, Kr, Vt, AO, (const float*)(ws + WS_COS), (const float*)(ws + WS_SIN), pair >> 3, pair & 7, (int)(u & 31), wv); } }
                else for (int u = bid; u < 1024; u += G) { const int pair = u >> 5; attn_unit(lds, Q, Kn, Kr, Vt, AO, (const float*)(ws + WS_COS), (const float*)(ws + WS_SIN), pair >> 3, pair & 7, u & 31, wv); }
            } else if (st == 8 && EN(8)) {
                gdn_gate_norm(p, ws, l, wv);
                rms_rows<false>(p.out, p.in[6] + (size_t)l * D_, ws + WS_H2, wv);
            } else if (st == 9 && EN(9)) {
                { pg8::Gemm g{(const bf16_t*)(ws + WS_AG), (const bf16_t*)(ws + W_PA), T_, 1024, 512, 512, 512}; pg8::StaticOrder S; S.init(T_, 1024, G, bid);
                  pg8::EpiBf16 E{(bf16_t*)(ws + WS_YA), 1024, 1000, nullptr, 0, 1000, nullptr, 0, 1.0f}; pg8::gemm_phase(lds, g, S, E, wv); }
                { pg8::Gemm g{(const bf16_t*)(ws + WS_AO), (const bf16_t*)(ws + W_PB), T_, 1024, 512, 512, 512}; pg8::StaticOrder S; S.init(T_, 1024, G, bid);
                  pg8::EpiBf16 E{(bf16_t*)(ws + WS_YB), 1024, 1000, nullptr, 0, 1000, nullptr, 0, 1.0f}; pg8::gemm_phase(lds, g, S, E, wv); }
            } else if (st == 10 && EN(10)) {
                pg8::Gemm g{(const bf16_t*)(ws + WS_H2), (const bf16_t*)(ws + W_G), T_, 2048, 1024, 1024, 1024}; pg8::StaticOrder S; S.init(T_, 2048, G, bid);
                pg8::EpiGate E{(const bf16_t*)(ws + WS_YA), (const bf16_t*)(ws + WS_YB), (bf16_t*)(ws + WS_Y)}; pg8::gemm_phase(lds, g, S, E, wv);
            } else if (st == 11 && EN(11)) {
                pg8::Gemm g{(const bf16_t*)(ws + WS_Y), (const bf16_t*)(ws + W_OUT), T_, 1024, 1024, 1024, 1024}; pg8::StaticOrder S; S.init(T_, 1024, G, bid);
                pg8::EpiResid E{p.out, p.out, 1.0f}; pg8::gemm_phase(lds, g, S, E, wv);
            }
        }
        if (ph + 1 < ph_hi) {
            if (ph == ph_lo) cg::this_grid().sync(); else xcd_barrier((unsigned*)(ws + WS_BAR), xst, (unsigned)G, wv);
            for (int e = 0; e < PROBE_SYNC; ++e) xcd_barrier((unsigned*)(ws + WS_BAR), xst, (unsigned)G, wv); }
    }
}

extern "C" void kernel_launch(void* const* d_in, const int* in_sizes, int n_in, void* d_out, int out_size, void* d_ws, size_t ws_size, hipStream_t stream) {
    static int grid = 0;
    if (grid == 0) {
        if (ws_size < WS_END) { fprintf(stderr, "kernel_launch: workspace too small: %zu < %zu\n", ws_size, (size_t)WS_END); grid = -1; return; }
        int dev = 0, cus = 0;
        hipGetDevice(&dev); hipDeviceGetAttribute(&cus, hipDeviceAttributeMultiprocessorCount, dev);
        if (hipFuncSetAttribute((const void*)mega, hipFuncAttributeMaxDynamicSharedMemorySize, LDS_BYTES) != hipSuccess) { fprintf(stderr, "hipFuncSetAttribute failed\n"); grid = -1; return; }
        int per_cu = 0;
        if (hipOccupancyMaxActiveBlocksPerMultiprocessor(&per_cu, (const void*)mega, 512, LDS_BYTES) != hipSuccess || per_cu < 1) { fprintf(stderr, "occupancy query: %d\n", per_cu); per_cu = 1; }
        (void)hipGetLastError();
        grid = cus;
    }
    if (grid < 0) return;
    Params p{};
    for (int i = 0; i < 24; ++i) p.in[i] = (const float*)d_in[i];
    p.out = (float*)d_out; p.ws = (unsigned char*)d_ws;
    for (int i = 0; i < 16; ++i) p.invf_rev[i] = pow(10000.0, -(double)i / 16.0) / 6.283185307179586476925286766559;
#if COOP
    (void)hipMemsetAsync((unsigned char*)d_ws + WS_BAR, 0, 3456 * 4, stream);
    p.ph_lo = 0; p.ph_hi = NPH_;
    void* args[] = {&p};
    hipError_t e = hipLaunchCooperativeKernel((const void*)mega, dim3(grid), dim3(512), args, LDS_BYTES, stream);
    if (e != hipSuccess) fprintf(stderr, "cooperative launch failed: %s\n", hipGetErrorString(e));
#else
    for (int ph = 0; ph < NPH_; ++ph) { p.ph_lo = ph; p.ph_hi = ph + 1; hipLaunchKernelGGL(mega, dim3(grid), dim3(512), LDS_BYTES, stream, p); }
#endif
}
```

```cpp
#include <hip/hip_runtime.h>
#include <hip/hip_cooperative_groups.h>
#include <cstdio>
#include <cmath>
namespace cg = cooperative_groups;

#ifndef COOP
#define COOP 1
#endif
#ifndef PHMASK
#define PHMASK 0xffffffffu
#endif
#define EN(k) ((PHMASK >> (k)) & 1u)
#ifndef PROBE_ST
#define PROBE_ST (-1)
#endif
constexpr int NS_ = 15 + (PROBE_ST >= 0 ? 1 : 0), NPH_ = 2 + 2 * NS_;
#ifndef PROBE_SYNC
#define PROBE_SYNC 0
#endif

#define LAS __attribute__((address_space(3)))
#define DI __device__ __forceinline__
typedef unsigned short bf16_t;
typedef short bf16x8 __attribute__((ext_vector_type(8)));
typedef short s16x4 __attribute__((ext_vector_type(4)));
typedef float f32x4 __attribute__((ext_vector_type(4)));
typedef float f32x16 __attribute__((ext_vector_type(16)));
typedef unsigned u32x4 __attribute__((ext_vector_type(4)));
typedef unsigned u32x2 __attribute__((ext_vector_type(2)));

constexpr int T_ = 32768, S_ = 8192, NB_ = 4, D_ = 1024, FF_ = 2816;
constexpr int LDS_BYTES = 131072 + 64;
constexpr float EPS_ = 1e-6f;
constexpr size_t MiB = 1u << 20;
constexpr size_t WS_W = 0;
constexpr size_t W_GU = WS_W, W_D = WS_W + 11 * MiB;
constexpr size_t W_IN = WS_W, W_G = WS_W + 5632 * 1024, W_PA = WS_W + 9728 * 1024, W_PB = W_PA + MiB, W_OUT = W_PB + MiB,
                 W_UQ = W_OUT + 2 * MiB, W_UK = W_UQ + MiB, W_UV = W_UK + 256 * 1024;
constexpr size_t WS_H = 20 * MiB;
constexpr size_t WS_KT = 20 * MiB, WS_OF = 52 * MiB;
constexpr size_t WS_BIG = 84 * MiB;
constexpr size_t WS_GQKV = WS_BIG, WS_Z = WS_BIG + 96 * MiB, WS_REST = WS_BIG + 128 * MiB;
constexpr size_t WS_KN = 84 * MiB, WS_VT = 116 * MiB, WS_OB = 148 * MiB;
constexpr size_t WS_H2 = 84 * MiB;
constexpr size_t WS_AO = 212 * MiB;
constexpr size_t WS_X2 = 260 * MiB;
constexpr size_t WS_QH = 260 * MiB, WS_WF = 292 * MiB, WS_WB = 324 * MiB;
constexpr size_t WS_UF = 356 * MiB, WS_UB = 388 * MiB;
constexpr size_t WS_IF = 420 * MiB, WS_IB = 436 * MiB;
constexpr size_t WS_Q = 452 * MiB;
constexpr size_t WS_BETA = 500 * MiB, WS_G = 501 * MiB, WS_KR = 502 * MiB, WS_COS = 504 * MiB, WS_SIN = 506 * MiB,
                 WS_EG = 508 * MiB, WS_EK = 509 * MiB, WS_ETOT = 510 * MiB, WS_CTR = 510 * MiB + 512 * 1024;
constexpr size_t WS_AG = 420 * MiB;
constexpr size_t WS_YA = 260 * MiB, WS_YB = 324 * MiB, WS_Y = 388 * MiB;
constexpr size_t WS_BAR = 510 * MiB + 768 * 1024;
constexpr size_t WS_END = 511 * MiB;

typedef __bf16 bf16v2 __attribute__((ext_vector_type(2)));
typedef float f32x2 __attribute__((ext_vector_type(2)));
DI unsigned pk2(float lo, float hi) { return __builtin_bit_cast(unsigned, __builtin_convertvector((f32x2){lo, hi}, bf16v2)); }
DI unsigned cvt_pk_bf16(float lo, float hi) { unsigned r; asm volatile("v_cvt_pk_bf16_f32 %0, %1, %2" : "=v"(r) : "v"(lo), "v"(hi)); return r; }
DI float bf2f(bf16_t b) { return __uint_as_float(((unsigned)b) << 16); }
DI float bflo(unsigned w) { return __uint_as_float(w << 16); }
DI float bfhi(unsigned w) { return __uint_as_float(w & 0xffff0000u); }
DI float sigmoidf_(float x) { return __builtin_amdgcn_rcpf(1.0f + __expf(-x)); }
DI float siluf_(float x) { return x * sigmoidf_(x); }
DI int otid(int wv) { int z; asm volatile("s_mov_b32 %0, 0" : "=s"(z)); return wv * 64 + (int)__builtin_amdgcn_mbcnt_hi(~0u, __builtin_amdgcn_mbcnt_lo(~0u, (unsigned)z)); }
DI float lane_xor(float v, int lane, int o) { return __int_as_float(__builtin_amdgcn_ds_bpermute((lane ^ o) << 2, __float_as_int(v))); }
DI float wave_sum(float v, int lane) {
#pragma unroll
    for (int o = 32; o >= 1; o >>= 1) v += lane_xor(v, lane, o);
    return v; }

namespace pg8 {
constexpr int BM = 256, BK = 64, HALF = 128, HTB = HALF * BK * 2, NXCD = 8, WGM = 8;
DI int lds_byte(int r, int c) { const int st = (r >> 4) * 2 + (c >> 5), rr = r & 15, cc = c & 31, ob = rr * 64 + cc * 2; return st * 1024 + (ob ^ (((ob >> 9) & 1) << 5)); }
DI void stage_rc(int b, int& R, int& C) { const int st = b / 1024, sb = b % 1024, swz = sb ^ (((sb >> 9) & 1) << 5); R = (st >> 1) * 16 + swz / 64; C = (st & 1) * 32 + (swz % 64) / 2; }
DI int perm32(int rho) { const int n = rho >> 4, i = rho & 15; return 8 * (i >> 2) + 4 * n + (i & 3); }
struct Unit { int pm, pn; };
struct Gemm { const bf16_t* A; const bf16_t* Bt; int M, N, K, lda, ldb; };
struct StaticOrder {
    int nM, nN, nwg, G, c;
    DI void init(int M, int N, int G_, int c_) { nM = M / BM; nN = N / BM; nwg = nM * nN; G = G_; c = c_; }
    DI bool next(int i, Unit& u) const {
        const long L = (long)i * G + c; if (L >= nwg) return false;
        int wgid = (int)L; { const int q = nwg / NXCD, r = nwg % NXCD, xcd = wgid % NXCD, off = wgid / NXCD; wgid = (xcd < r ? xcd * (q + 1) : r * (q + 1) + (xcd - r) * q) + off; }
        const int nig = WGM * nN, gid = wgid / nig, fm = gid * WGM, gsz = (nM - fm) < WGM ? (nM - fm) : WGM;
        u.pm = fm + ((wgid % nig) % gsz); u.pn = (wgid % nig) / gsz; return true;
    }
};
template <class Epi>
DI void gemm_phase(LAS unsigned char* lds, const Gemm g, const StaticOrder& S, const Epi& E, const int wv) {
    const int tid = otid(wv), wid = __builtin_amdgcn_readfirstlane(tid >> 6), lane = tid & 63, wr = wid >> 2, wc = wid & 3, fr = lane & 15, fq = lane >> 4;
    const int K = g.K, nt = K / BK;
    unsigned voffA[2], voffB[2];
#pragma unroll
    for (int i = 0; i < 2; ++i) { int R, C; stage_rc(tid * 16 + i * 8192, R, C); const int Rb = Epi::PERM ? ((R & ~31) + perm32(R & 31)) : R;
        voffA[i] = (unsigned)(R * g.lda + C) * 2u; voffB[i] = (unsigned)(Rb * g.ldb + C) * 2u; }
    const size_t kstep = (size_t)(BK * 2);
    const size_t hstepA = (size_t)HALF * g.lda * 2, hstepB = (size_t)HALF * g.ldb * 2;
    const size_t tstepA = 2 * hstepA, tstepB = 2 * hstepB;
    const unsigned ldsw = (unsigned)wid * 1024u;
    const int aoff = lds_byte(wr * 64 + fr, fq * 8), boff = lds_byte(wc * 32 + fr, fq * 8);
#define PG8_SA(b, h) (((b) * 2 + (h)) * HTB)
#define PG8_SB(b, h) ((4 + (b) * 2 + (h)) * HTB)
#define PG8_STAGE(bufoff, gbase, voff) do { _Pragma("unroll") for (int _i = 0; _i < 2; ++_i) \
        __builtin_amdgcn_global_load_lds((const unsigned*)((const char*)(gbase) + (voff)[_i]), (LAS unsigned*)(lds + (bufoff) + ldsw + _i * 8192), 16, 0, 0); } while (0)
#define PG8_LDA(dst, b, h) do { _Pragma("unroll") for (int m = 0; m < 4; ++m) _Pragma("unroll") for (int k = 0; k < 2; ++k) dst[m][k] = *(const LAS bf16x8*)(lds + PG8_SA(b, h) + aoff + m * 2048 + k * 1024); } while (0)
#define PG8_LDB(dst, b, h) do { _Pragma("unroll") for (int n = 0; n < 2; ++n) _Pragma("unroll") for (int k = 0; k < 2; ++k) dst[n][k] = *(const LAS bf16x8*)(lds + PG8_SB(b, h) + boff + n * 2048 + k * 1024); } while (0)
#define PG8_MMA(ai, bj, At, Bt) do { __builtin_amdgcn_s_setprio(1); _Pragma("unroll") for (int m = 0; m < 4; ++m) _Pragma("unroll") for (int n = 0; n < 2; ++n) _Pragma("unroll") for (int k = 0; k < 2; ++k) \
        acc[ai][bj][m][n] = __builtin_amdgcn_mfma_f32_16x16x32_bf16(Bt[n][k], At[m][k], acc[ai][bj][m][n], 0, 0, 0); __builtin_amdgcn_s_setprio(0); } while (0)
#define PG8_WAIT_V(n) asm volatile("s_waitcnt vmcnt(" #n ")" ::: "memory")
#define PG8_WAIT_L(n) asm volatile("s_waitcnt lgkmcnt(" #n ")" ::: "memory")
#define PG8_BAR __builtin_amdgcn_s_barrier()
#define PG8_SCHED __builtin_amdgcn_sched_barrier(0)
    Unit cur, nxt; int ui = 0;
    if (!S.next(0, cur)) return;
    f32x4 acc[2][2][4][2];
#pragma unroll
    for (int a = 0; a < 2; ++a)
#pragma unroll
        for (int b = 0; b < 2; ++b)
#pragma unroll
            for (int m = 0; m < 4; ++m)
#pragma unroll
                for (int n = 0; n < 2; ++n) acc[a][b][m][n] = (f32x4){0.f, 0.f, 0.f, 0.f};
    bf16x8 At[4][2], B0[2][2], B1[2][2];
    const char* cA = (const char*)g.A + (size_t)cur.pm * tstepA; const char* cB = (const char*)g.Bt + (size_t)cur.pn * tstepB;
    PG8_STAGE(PG8_SB(0, 0), cB, voffB); PG8_STAGE(PG8_SA(0, 0), cA, voffA); PG8_STAGE(PG8_SB(0, 1), cB + hstepB, voffB); PG8_STAGE(PG8_SA(0, 1), cA + hstepA, voffA);
    if (wr == 1) PG8_BAR;
    PG8_WAIT_V(4); PG8_BAR;
    PG8_STAGE(PG8_SB(1, 0), cB + kstep, voffB); PG8_STAGE(PG8_SA(1, 0), cA + kstep, voffA); PG8_STAGE(PG8_SB(1, 1), cB + hstepB + kstep, voffB);
    PG8_WAIT_V(6); PG8_BAR;
    for (;;) {
        const bool has_next = S.next(ui + 1, nxt);
        const char* nA = has_next ? (const char*)g.A + (size_t)nxt.pm * tstepA : cA; const char* nB = has_next ? (const char*)g.Bt + (size_t)nxt.pn * tstepB : cB;
        for (int t = 0; t < nt; t += 2) {
            const bool last = (t == nt - 2);
            const char* a1 = cA + (size_t)(t + 1) * kstep;
            const char* a2 = last ? nA : cA + (size_t)(t + 2) * kstep; const char* b2 = last ? nB : cB + (size_t)(t + 2) * kstep;
            const char* a3 = a2 + kstep; const char* b3 = b2 + kstep;
            PG8_LDB(B0, 0, 0); PG8_SCHED; PG8_LDA(At, 0, 0); PG8_STAGE(PG8_SA(1, 1), a1 + hstepA, voffA);
            PG8_WAIT_L(8); PG8_BAR; PG8_WAIT_L(0); PG8_MMA(0, 0, At, B0); PG8_BAR; PG8_SCHED;
            PG8_LDB(B1, 0, 1); PG8_STAGE(PG8_SB(0, 0), b2, voffB);
            PG8_BAR; PG8_WAIT_L(0); PG8_MMA(0, 1, At, B1); PG8_BAR;
            PG8_LDA(At, 0, 1); PG8_STAGE(PG8_SA(0, 0), a2, voffA);
            PG8_BAR; PG8_WAIT_L(0); PG8_MMA(1, 0, At, B0); PG8_BAR; PG8_SCHED;
            PG8_STAGE(PG8_SB(0, 1), b2 + hstepB, voffB);
            PG8_WAIT_V(6); PG8_BAR; PG8_MMA(1, 1, At, B1); PG8_BAR;
            PG8_LDB(B0, 1, 0); PG8_SCHED; PG8_LDA(At, 1, 0); PG8_STAGE(PG8_SA(0, 1), a2 + hstepA, voffA);
            PG8_WAIT_L(8); PG8_BAR; PG8_WAIT_L(0); PG8_MMA(0, 0, At, B0); PG8_BAR; PG8_SCHED;
            PG8_LDB(B1, 1, 1); PG8_STAGE(PG8_SB(1, 0), b3, voffB);
            PG8_BAR; PG8_WAIT_L(0); PG8_MMA(0, 1, At, B1); PG8_BAR;
            PG8_LDA(At, 1, 1); PG8_STAGE(PG8_SA(1, 0), a3, voffA);
            PG8_BAR; PG8_WAIT_L(0); PG8_MMA(1, 0, At, B0); PG8_BAR; PG8_SCHED;
            PG8_STAGE(PG8_SB(1, 1), b3 + hstepB, voffB);
            PG8_WAIT_V(6); PG8_BAR; PG8_MMA(1, 1, At, B1); PG8_BAR;
        }
        E(acc, cur, wr, wc, fr, fq);
        if (!has_next) break;
#pragma unroll
        for (int a = 0; a < 2; ++a)
#pragma unroll
            for (int b = 0; b < 2; ++b)
#pragma unroll
                for (int m = 0; m < 4; ++m)
#pragma unroll
                    for (int n = 0; n < 2; ++n) acc[a][b][m][n] = (f32x4){0.f, 0.f, 0.f, 0.f};
        cur = nxt; cA = nA; cB = nB; ++ui;
    }
    PG8_WAIT_V(0);
    if (wr == 0) PG8_BAR;
    PG8_BAR;
#undef PG8_SA
#undef PG8_SB
#undef PG8_STAGE
#undef PG8_LDA
#undef PG8_LDB
#undef PG8_MMA
#undef PG8_WAIT_V
#undef PG8_WAIT_L
#undef PG8_BAR
#undef PG8_SCHED
}
typedef f32x4 Acc[2][2][4][2];

struct EpiSwiglu {
    static constexpr bool PERM = true; bf16_t* O; int ldc;
    DI void operator()(const Acc& acc, const Unit& u, int wr, int wc, int fr, int fq) const {
        const int row0 = u.pm * BM + wr * 64 + fr, col0 = u.pn * 128 + wc * 32 + 8 * fq;
#pragma unroll
        for (int ai = 0; ai < 2; ++ai)
#pragma unroll
            for (int m = 0; m < 4; ++m) {
                bf16_t* rowp = O + (size_t)(row0 + ai * HALF + m * 16) * ldc + col0; float r[8];
#pragma unroll
                for (int n = 0; n < 2; ++n)
#pragma unroll
                    for (int j = 0; j < 4; ++j) { const float gg = acc[ai][0][m][n][j], uu = acc[ai][1][m][n][j]; r[n * 4 + j] = siluf_(gg) * uu; }
                u32x4 w; w.x = cvt_pk_bf16(r[0], r[1]); w.y = cvt_pk_bf16(r[2], r[3]); w.z = cvt_pk_bf16(r[4], r[5]); w.w = cvt_pk_bf16(r[6], r[7]);
                *(u32x4*)rowp = w; }
    }
};
struct EpiResid {
    static constexpr bool PERM = false; const float* X; float* Y; float alpha;
    DI void operator()(const Acc& acc, const Unit& u, int wr, int wc, int fr, int fq) const {
        const int row0 = u.pm * BM + wr * 64 + fr, col0 = u.pn * BM + wc * 32 + 4 * fq;
#pragma unroll
        for (int ai = 0; ai < 2; ++ai)
#pragma unroll
            for (int m = 0; m < 4; ++m) { const size_t off = (size_t)(row0 + ai * HALF + m * 16) * D_ + col0;
#pragma unroll
                for (int bj = 0; bj < 2; ++bj)
#pragma unroll
                    for (int n = 0; n < 2; ++n) { const f32x4 xv = *(const f32x4*)(X + off + bj * HALF + n * 16); *(f32x4*)(Y + off + bj * HALF + n * 16) = xv + alpha * acc[ai][bj][m][n]; }
                asm volatile("" ::: "memory"); }
    }
};
struct EpiBf16 {
    static constexpr bool PERM = true;
    bf16_t* O0; int ld0; int t1; bf16_t* O1; int ld1; int t2; bf16_t* O2; int ld2; float scale;
    DI void operator()(const Acc& acc, const Unit& u, int wr, int wc, int fr, int fq) const {
        bf16_t* base = O0; int ld = ld0, colt = u.pn * BM;
        if (u.pn >= t2) { base = O2; ld = ld2; colt = (u.pn - t2) * BM; } else if (u.pn >= t1) { base = O1; ld = ld1; colt = (u.pn - t1) * BM; }
        const int row0 = u.pm * BM + wr * 64 + fr, col0 = colt + wc * 32 + 8 * fq;
#pragma unroll
        for (int ai = 0; ai < 2; ++ai)
#pragma unroll
            for (int m = 0; m < 4; ++m) { const int row = row0 + ai * HALF + m * 16; bf16_t* rowp = base + (size_t)row * ld + col0;
#pragma unroll
                for (int bj = 0; bj < 2; ++bj) { const f32x4 v0 = acc[ai][bj][m][0] * scale, v1 = acc[ai][bj][m][1] * scale;
                    u32x4 w; w.x = cvt_pk_bf16(v0[0], v0[1]); w.y = cvt_pk_bf16(v0[2], v0[3]); w.z = cvt_pk_bf16(v1[0], v1[1]); w.w = cvt_pk_bf16(v1[2], v1[3]);
                    *(u32x4*)(rowp + bj * HALF) = w; } }
    }
};
struct EpiGate {
    static constexpr bool PERM = true; const bf16_t* YA; const bf16_t* YB; bf16_t* Y;
    DI void operator()(const Acc& acc, const Unit& u, int wr, int wc, int fr, int fq) const {
        const int row0 = u.pm * BM + wr * 64 + fr, col0 = u.pn * 128 + wc * 32 + 8 * fq;
#pragma unroll
        for (int ai = 0; ai < 2; ++ai)
#pragma unroll
            for (int m = 0; m < 4; ++m) { const size_t off = (size_t)(row0 + ai * HALF + m * 16) * D_ + col0;
                const u32x4 a = *(const u32x4*)(YA + off), b = *(const u32x4*)(YB + off); float r[8];
#pragma unroll
                for (int n = 0; n < 2; ++n)
#pragma unroll
                    for (int jj = 0; jj < 2; ++jj) { const unsigned aw = a[n * 2 + jj], bw = b[n * 2 + jj];
                        r[n * 4 + jj * 2] = sigmoidf_(acc[ai][0][m][n][jj * 2]) * bflo(aw) + sigmoidf_(acc[ai][1][m][n][jj * 2]) * bflo(bw);
                        r[n * 4 + jj * 2 + 1] = sigmoidf_(acc[ai][0][m][n][jj * 2 + 1]) * bfhi(aw) + sigmoidf_(acc[ai][1][m][n][jj * 2 + 1]) * bfhi(bw); }
                u32x4 w; w.x = cvt_pk_bf16(r[0], r[1]); w.y = cvt_pk_bf16(r[2], r[3]); w.z = cvt_pk_bf16(r[4], r[5]); w.w = cvt_pk_bf16(r[6], r[7]);
                *(u32x4*)(Y + off) = w;
                asm volatile("" ::: "memory"); }
    }
};
}

struct Params { const float* in[24]; float* out; unsigned char* ws; double invf_rev[16]; int ph_lo, ph_hi; };

DI int conv_col(int n, int mode, bool& second) {
    second = false; int col = n;
    if (mode == 1) { const int t = n >> 8, r = n & 255; col = t * 128 + (r & 127); second = r >= 128; }
    else if (mode == 2) { if (n < 2048) col = n; else if (n < 2720) col = 2064 + (n - 2048); else if (n < 2736) col = 2048 + (n - 2720); else col = -1; }
    else if (mode == 3) { const int t = n >> 8, r = n & 255; col = 2736 + ((r >= 128) ? 1024 : 0) + t * 128 + (r & 127); }
    else if (mode == 4) { col = (n >> 6) * 128 + (n & 63); }
    else if (mode == 5) { col = (n >> 6) * 128 + 64 + (n & 63); }
    return col;
}
DI void conv_w(const float* src0, const float* src1, int ldsrc, bf16_t* dst, int N, int K, int mode, const float* kscale, int gtid, int gstride) {
    const int total = N * (K / 8);
    for (int idx = gtid; idx < total; idx += 2 * gstride) {
        const int idx2 = idx + gstride; const bool has2 = idx2 < total;
        const int nA = idx % N, kA = idx / N, nB = has2 ? idx2 % N : nA, kB = has2 ? idx2 / N : kA;
        bool sA, sB; const int cA = conv_col(nA, mode, sA), cB = conv_col(nB, mode, sB);
        const float* pA = sA ? src1 : src0; const float* pB = sB ? src1 : src0;
        float vA[8], vB[8];
#pragma unroll
        for (int j = 0; j < 8; ++j) { vA[j] = (cA >= 0) ? pA[(size_t)(kA * 8 + j) * ldsrc + cA] : 0.f; vB[j] = (cB >= 0) ? pB[(size_t)(kB * 8 + j) * ldsrc + cB] : 0.f; }
        if (kscale) {
#pragma unroll
            for (int j = 0; j < 8; ++j) { vA[j] *= kscale[kA * 8 + j]; vB[j] *= kscale[kB * 8 + j]; } }
        u32x4 w; w.x = cvt_pk_bf16(vA[0], vA[1]); w.y = cvt_pk_bf16(vA[2], vA[3]); w.z = cvt_pk_bf16(vA[4], vA[5]); w.w = cvt_pk_bf16(vA[6], vA[7]);
        *(u32x4*)(dst + (size_t)nA * K + kA * 8) = w;
        if (has2) { u32x4 w2; w2.x = cvt_pk_bf16(vB[0], vB[1]); w2.y = cvt_pk_bf16(vB[2], vB[3]); w2.z = cvt_pk_bf16(vB[4], vB[5]); w2.w = cvt_pk_bf16(vB[6], vB[7]);
            *(u32x4*)(dst + (size_t)nB * K + kB * 8) = w2; }
    }
}

template <bool F32OUT>
DI void rms_rows(const float* x, const float* w, void* out, const int wv) {
    const int tid_ = otid(wv); const int lane = tid_ & 63, wid = tid_ >> 6;
    f32x4 wv4[4];
#pragma unroll
    for (int i = 0; i < 4; ++i) wv4[i] = *(const f32x4*)(w + (i >> 1) * 512 + lane * 8 + (i & 1) * 4);
    for (int row = (blockIdx.x * 8 + wid) * 4; row < T_; row += gridDim.x * 32) {
        f32x4 v[4][4]; float ss[4] = {0.f, 0.f, 0.f, 0.f};
#pragma unroll
        for (int rr = 0; rr < 4; ++rr)
#pragma unroll
            for (int i = 0; i < 4; ++i) v[rr][i] = *(const f32x4*)(x + (size_t)(row + rr) * D_ + (i >> 1) * 512 + lane * 8 + (i & 1) * 4);
#pragma unroll
        for (int rr = 0; rr < 4; ++rr)
#pragma unroll
            for (int i = 0; i < 4; ++i) ss[rr] += v[rr][i][0] * v[rr][i][0] + v[rr][i][1] * v[rr][i][1] + v[rr][i][2] * v[rr][i][2] + v[rr][i][3] * v[rr][i][3];
#pragma unroll
        for (int o = 32; o >= 1; o >>= 1) { ss[0] += lane_xor(ss[0], lane, o); ss[1] += lane_xor(ss[1], lane, o); ss[2] += lane_xor(ss[2], lane, o); ss[3] += lane_xor(ss[3], lane, o); }
#pragma unroll
        for (int rr = 0; rr < 4; ++rr) { const float rstd = rsqrtf(ss[rr] * (1.0f / D_) + EPS_);
#pragma unroll
            for (int j = 0; j < 2; ++j) { const f32x4 y0 = v[rr][2 * j] * rstd * wv4[2 * j], y1 = v[rr][2 * j + 1] * rstd * wv4[2 * j + 1];
                if (F32OUT) { float* op = (float*)out + (size_t)(row + rr) * D_ + j * 512 + lane * 8; *(f32x4*)op = y0; *(f32x4*)(op + 4) = y1; }
                else { u32x4 pk; pk.x = cvt_pk_bf16(y0[0], y0[1]); pk.y = cvt_pk_bf16(y0[2], y0[3]); pk.z = cvt_pk_bf16(y1[0], y1[1]); pk.w = cvt_pk_bf16(y1[2], y1[3]);
                    *(u32x4*)((bf16_t*)out + (size_t)(row + rr) * D_ + j * 512 + lane * 8) = pk; } } }
    }
}

DI void mla_latent_pass(const Params& p, unsigned char* ws, int l, const int wv) {
    const int tid_ = otid(wv); const int lane = tid_ & 63, wid = tid_ >> 6;
    bf16_t* restw = (bf16_t*)(ws + WS_REST); bf16_t* kr = (bf16_t*)(ws + WS_KR); const float* qnw = p.in[13] + l * 384; const float* kvnw = p.in[15] + l * 256;
    const float* cosT = (const float*)(ws + WS_COS); const float* sinT = (const float*)(ws + WS_SIN);
    for (int t0 = (blockIdx.x * 8 + wid) * 2; t0 < T_; t0 += gridDim.x * 16) {
        float cq[2][6], ck[2][4], s1[2] = {0.f, 0.f}, s2[2] = {0.f, 0.f};
#pragma unroll
        for (int rr = 0; rr < 2; ++rr) { const bf16_t* r = restw + (size_t)(t0 + rr) * 768;
#pragma unroll
            for (int i = 0; i < 6; ++i) cq[rr][i] = bf2f(r[i * 64 + lane]);
#pragma unroll
            for (int i = 0; i < 4; ++i) ck[rr][i] = bf2f(r[384 + i * 64 + lane]); }
#pragma unroll
        for (int rr = 0; rr < 2; ++rr) {
#pragma unroll
            for (int i = 0; i < 6; ++i) s1[rr] += cq[rr][i] * cq[rr][i];
#pragma unroll
            for (int i = 0; i < 4; ++i) s2[rr] += ck[rr][i] * ck[rr][i]; }
#pragma unroll
        for (int o = 32; o >= 1; o >>= 1) { s1[0] += lane_xor(s1[0], lane, o); s1[1] += lane_xor(s1[1], lane, o); s2[0] += lane_xor(s2[0], lane, o); s2[1] += lane_xor(s2[1], lane, o); }
#pragma unroll
        for (int rr = 0; rr < 2; ++rr) { const int t = t0 + rr; bf16_t* r = restw + (size_t)t * 768;
            const float r1 = rsqrtf(s1[rr] * (1.0f / 384.f) + EPS_), r2 = rsqrtf(s2[rr] * (1.0f / 256.f) + EPS_);
#pragma unroll
            for (int i = 0; i < 6; ++i) r[i * 64 + lane] = (bf16_t)(cvt_pk_bf16(cq[rr][i] * r1 * qnw[i * 64 + lane], 0.f) & 0xffff);
#pragma unroll
            for (int i = 0; i < 4; ++i) r[384 + i * 64 + lane] = (bf16_t)(cvt_pk_bf16(ck[rr][i] * r2 * kvnw[i * 64 + lane], 0.f) & 0xffff);
            if (lane < 16) { const float x1 = bf2f(r[640 + lane]), x2 = bf2f(r[656 + lane]), c = cosT[(size_t)t * 16 + lane], sn = sinT[(size_t)t * 16 + lane];
                const unsigned w = cvt_pk_bf16(x1 * c - x2 * sn, x2 * c + x1 * sn); kr[(size_t)t * 32 + lane] = (bf16_t)(w & 0xffff); kr[(size_t)t * 32 + 16 + lane] = (bf16_t)(w >> 16); } }
    }
}

constexpr int CP_QS = 0, CP_KS = 17408, CP_KT = 34816, CP_VT = CP_KT + 18432, CP_T = CP_VT + 18432, CP_SM = CP_T + 36864;
DI bf16x8 pack8n(const f32x16& x, int s) {
    u32x4 pk;
    if (s == 0) { pk.x = pk2(x[0], x[1]); pk.y = pk2(x[2], x[3]); pk.z = pk2(x[4], x[5]); pk.w = pk2(x[6], x[7]); }
    else { pk.x = pk2(x[8], x[9]); pk.y = pk2(x[10], x[11]); pk.z = pk2(x[12], x[13]); pk.w = pk2(x[14], x[15]); }
    return __builtin_bit_cast(bf16x8, pk);
}
DI void tri_solve(const LAS float* L, LAS bf16_t* Tu, LAS bf16_t* Tw, int c, const LAS float* bet, const LAS float* gc, bool rev) {
    float Tc[64];
#pragma unroll
    for (int i = 0; i < 64; ++i) {
        float a = (i == c) ? 1.f : 0.f, a1 = 0.f, a2 = 0.f, a3 = 0.f;
#pragma unroll
        for (int j4 = 0; j4 < (i + 3) / 4; ++j4) { const f32x4 lv = *(const LAS f32x4*)(L + i * 64 + j4 * 4);
            if (j4 * 4 + 0 < i) a -= lv[0] * Tc[j4 * 4 + 0];
            if (j4 * 4 + 1 < i) a1 -= lv[1] * Tc[j4 * 4 + 1];
            if (j4 * 4 + 2 < i) a2 -= lv[2] * Tc[j4 * 4 + 2];
            if (j4 * 4 + 3 < i) a3 -= lv[3] * Tc[j4 * 4 + 3]; }
        a = (a + a1) + (a2 + a3);
        asm volatile("" : "+v"(a));
        Tc[i] = a;
    }
    const int col = rev ? 63 - c : c; const float su = bet[col], sw = su * __expf(gc[col]);
#pragma unroll
    for (int i = 0; i < 64; ++i) { const int row = rev ? 63 - i : i; const unsigned w = pk2(Tc[i] * su, Tc[i] * sw);
        Tu[row * 72 + col] = (bf16_t)(w & 0xffff); Tw[row * 72 + col] = (bf16_t)(w >> 16); }
}
DI void gdn_chunk_pre(LAS unsigned char* lds, unsigned char* ws, const float* cw, const float* Alog, const float* dtb, int unit, const int wv) {
    const int b = unit >> 9, n = (unit >> 2) & 127, hh = unit & 3; const size_t t0 = (size_t)b * S_ + (size_t)n * 64;
    const bf16_t* gqkv = (const bf16_t*)(ws + WS_GQKV); const bf16_t* rest = (const bf16_t*)(ws + WS_REST); bf16_t* qh = (bf16_t*)(ws + WS_QH);
    const int tid = otid(wv), wid = tid >> 6, lane = tid & 63, r = lane & 31, h = lane >> 5;
    LAS bf16_t* kT = (LAS bf16_t*)(lds + CP_KT); LAS bf16_t* vT = (LAS bf16_t*)(lds + CP_VT);
    LAS float* sm = (LAS float*)(lds + CP_SM); LAS float* betf = sm; LAS float* betb = sm + 64; LAS float* gcf = sm + 128; LAS float* gcb = sm + 192;
    {
        const int pc = tid & 15, ig = tid >> 4, sp0 = n * 64 + 2 * ig - 2;
#pragma unroll
        for (int part = 0; part < 3; ++part) {
            const int col = part * 512 + hh * 128 + pc * 8;
            f32x4 wt[5][2];
#pragma unroll
            for (int j = 0; j < 5; ++j) { wt[j][0] = *(const f32x4*)(cw + j * 1536 + col); wt[j][1] = *(const f32x4*)(cw + j * 1536 + col + 4); }
            u32x4 rows[6];
#pragma unroll
            for (int rr = 0; rr < 6; ++rr) { const int sp = sp0 + rr; rows[rr] = (sp >= 0 && sp < S_) ? *(const u32x4*)(gqkv + ((size_t)b * S_ + sp) * 1536 + col) : (u32x4){0u, 0u, 0u, 0u}; }
#pragma unroll
            for (int tk = 0; tk < 2; ++tk) {
                float y[8];
#pragma unroll
                for (int e = 0; e < 8; ++e) y[e] = 0.f;
#pragma unroll
                for (int j = 0; j < 5; ++j)
#pragma unroll
                    for (int e = 0; e < 4; ++e) { const unsigned w = rows[tk + j][e]; y[2 * e] += bflo(w) * wt[j][(2 * e) >> 2][(2 * e) & 3]; y[2 * e + 1] += bfhi(w) * wt[j][(2 * e + 1) >> 2][(2 * e + 1) & 3]; }
                float ss = 0.f;
#pragma unroll
                for (int e = 0; e < 8; ++e) { y[e] = siluf_(y[e]); ss += y[e] * y[e]; }
                float sc = 1.f;
                if (part < 2) { ss += lane_xor(ss, lane, 1); ss += lane_xor(ss, lane, 2); ss += lane_xor(ss, lane, 4); ss += lane_xor(ss, lane, 8);
                    sc = rsqrtf(ss + EPS_) * (part == 0 ? 0.08838834764831845f : 1.f); }
                u32x4 o; o.x = pk2(y[0] * sc, y[1] * sc); o.y = pk2(y[2] * sc, y[3] * sc); o.z = pk2(y[4] * sc, y[5] * sc); o.w = pk2(y[6] * sc, y[7] * sc);
                const int i = 2 * ig + tk;
                if (part == 0) { *(LAS u32x4*)(lds + CP_QS + i * 272 + pc * 16) = o; *(u32x4*)(qh + (t0 + i) * 512 + hh * 128 + pc * 8) = o; }
                else { if (part == 1) *(LAS u32x4*)(lds + CP_KS + i * 272 + pc * 16) = o;
                    LAS bf16_t* dstT = (part == 1) ? kT : vT;
#pragma unroll
                    for (int e = 0; e < 4; ++e) { dstT[(pc * 8 + 2 * e) * 72 + i] = (bf16_t)(o[e] & 0xffff); dstT[(pc * 8 + 2 * e + 1) * 72 + i] = (bf16_t)(o[e] >> 16); } }
            }
        }
        if (tid < 128) { const int i = tid & 63, dir = tid >> 6, di = dir * 4 + hh;
            const float bb = bf2f(rest[(t0 + i) * 768 + 672 + di]), aa = bf2f(rest[(t0 + i) * 768 + 680 + di]);
            const float xx = aa + dtb[di]; const float ey = __expf(-fabsf(xx)); const float sp = fmaxf(xx, 0.f) + (ey < 0.01f ? ey * (1.f - ey * (0.5f - ey * 0.33333333f)) : __logf(1.f + ey));
            (dir ? betb : betf)[i] = sigmoidf_(bb); (dir ? gcb : gcf)[i] = -__expf(Alog[di]) * sp; }
    }
    __syncthreads();
    if (wv < 2) {
        LAS float* gp = wv ? gcb : gcf; const int idx = wv ? 63 - lane : lane; float v = gp[idx];
#pragma unroll
        for (int o = 1; o < 64; o <<= 1) { const float t = __int_as_float(__builtin_amdgcn_ds_bpermute((lane - o) << 2, __float_as_int(v))); if (lane >= o) v += t; }
        gp[idx] = v; }
    const int mat = wid >> 2, bi = (wid >> 1) & 1, bj = wid & 1;
    f32x16 acc;
#pragma unroll
    for (int i = 0; i < 16; ++i) acc[i] = 0.f;
#pragma unroll
    for (int ks = 0; ks < 8; ++ks) { const bf16x8 a = *(const LAS bf16x8*)(lds + (mat ? CP_QS : CP_KS) + (32 * bi + r) * 272 + (ks * 16 + 8 * h) * 2);
        const bf16x8 bb = *(const LAS bf16x8*)(lds + CP_KS + (32 * bj + r) * 272 + (ks * 16 + 8 * h) * 2);
        acc = __builtin_amdgcn_mfma_f32_32x32x16_bf16(a, bb, acc, 0, 0, 0); }
    __syncthreads();
    LAS float* Lf = (LAS float*)(lds + CP_QS); LAS float* Lb = Lf + 4096;
    { const int j = 32 * bj + r; const float gfj = gcf[j], gbj = gcb[j];
        bf16_t* inf = (bf16_t*)(ws + WS_IF); bf16_t* inb = (bf16_t*)(ws + WS_IB);
#pragma unroll
        for (int x = 0; x < 16; ++x) { const int i = 32 * bi + (x & 3) + 8 * (x >> 2) + 4 * h; const float v = acc[x];
            const float df = __expf(fminf(gcf[i] - gfj, 0.f)), db = __expf(fminf(gcb[i] - gbj, 0.f));
            if (mat == 0) { Lf[i * 64 + j] = (j < i) ? betf[i] * v * df : 0.f; Lb[(63 - i) * 64 + (63 - j)] = (j > i) ? betb[i] * v * db : 0.f; }
            else { const size_t o = ((t0 + i) * 4 + hh) * 64 + j; inf[o] = (bf16_t)(pk2((j <= i) ? v * df : 0.f, 0.f) & 0xffff); inb[o] = (bf16_t)(pk2((j >= i) ? v * db : 0.f, 0.f) & 0xffff); } } }
    __syncthreads();
    if (wv == 0) tri_solve(Lf, (LAS bf16_t*)(lds + CP_T), (LAS bf16_t*)(lds + CP_T + 9216), lane, betf, gcf, false);
    else if (wv == 1) tri_solve(Lb, (LAS bf16_t*)(lds + CP_T + 18432), (LAS bf16_t*)(lds + CP_T + 27648), lane, betb, gcb, true);
    else if (wv == 2) {
        float* eg = (float*)(ws + WS_EG); float* ek = (float*)(ws + WS_EK); float* etot = (float*)(ws + WS_ETOT);
        const float gtf = gcf[63], gtb = gcb[0];
        eg[(t0 + lane) * 8 + hh] = __expf(gcf[lane]); ek[(t0 + lane) * 8 + hh] = __expf(gtf - gcf[lane]);
        eg[(t0 + lane) * 8 + 4 + hh] = __expf(gcb[lane]); ek[(t0 + lane) * 8 + 4 + hh] = __expf(gtb - gcb[lane]);
        if (lane == 0) { etot[((size_t)b * 128 + n) * 8 + hh] = __expf(gtf); etot[((size_t)b * 128 + n) * 8 + 4 + hh] = __expf(gtb); }
    } else if (wv >= 4) {
        bf16_t* kTg = (bf16_t*)(ws + WS_KT);
        for (int ch = tid - 256; ch < 1024; ch += 256) { const int dk = ch >> 3, pc = ch & 7;
            *(u32x4*)(kTg + ((size_t)(b * 4 + hh) * 128 + dk) * S_ + (size_t)n * 64 + pc * 8) = *(const LAS u32x4*)(lds + CP_KT + dk * 144 + pc * 16); }
    }
    __syncthreads();
    { const int dir = wid >> 2, wq = wid & 3; const LAS unsigned char* Tu = lds + CP_T + dir * 18432; const LAS unsigned char* Tw = Tu + 9216;
        if (wq < 2) { const int tb = wq; bf16_t* uT = (bf16_t*)(ws + (dir ? WS_UB : WS_UF));
#pragma unroll
            for (int nb = 0; nb < 4; ++nb) { f32x16 c;
#pragma unroll
                for (int i = 0; i < 16; ++i) c[i] = 0.f;
#pragma unroll
                for (int s = 0; s < 4; ++s) { const bf16x8 a = *(const LAS bf16x8*)(Tu + (32 * tb + r) * 144 + (16 * s + 8 * h) * 2);
                    const bf16x8 bb = *(const LAS bf16x8*)(lds + CP_VT + (32 * nb + r) * 144 + (16 * s + 8 * h) * 2);
                    c = __builtin_amdgcn_mfma_f32_32x32x16_bf16(a, bb, c, 0, 0, 0); }
                bf16_t* dst = uT + ((size_t)(b * 4 + hh) * 128 + 32 * nb + r) * S_ + (size_t)n * 64 + 32 * tb + 4 * h;
#pragma unroll
                for (int g4 = 0; g4 < 4; ++g4) { u32x2 w; w.x = pk2(c[4 * g4], c[4 * g4 + 1]); w.y = pk2(c[4 * g4 + 2], c[4 * g4 + 3]); *(u32x2*)(dst + 8 * g4) = w; } }
        } else { const int ib = wq - 2; bf16_t* wd = (bf16_t*)(ws + (dir ? WS_WB : WS_WF));
#pragma unroll
            for (int kb = 0; kb < 4; ++kb) { f32x16 c;
#pragma unroll
                for (int i = 0; i < 16; ++i) c[i] = 0.f;
#pragma unroll
                for (int s = 0; s < 4; ++s) { const bf16x8 a = *(const LAS bf16x8*)(lds + CP_KT + (32 * kb + r) * 144 + (16 * s + 8 * h) * 2);
                    const bf16x8 bb = *(const LAS bf16x8*)(Tw + (32 * ib + r) * 144 + (16 * s + 8 * h) * 2);
                    c = __builtin_amdgcn_mfma_f32_32x32x16_bf16(a, bb, c, 0, 0, 0); }
                bf16_t* dst = wd + (t0 + 32 * ib + r) * 512 + hh * 128 + 32 * kb + 4 * h;
#pragma unroll
                for (int g4 = 0; g4 < 4; ++g4) { u32x2 w; w.x = pk2(c[4 * g4], c[4 * g4 + 1]); w.y = pk2(c[4 * g4 + 2], c[4 * g4 + 3]); *(u32x2*)(dst + 8 * g4) = w; } }
        } }
    __syncthreads();
}

constexpr int SC_W = 0, SC_Q = 16896, SC_KT = 33792, SC_IN = SC_KT + 17408, SC_EG = SC_IN + 8704, SC_BUF = SC_EG + 528;
DI void gdn_scan(LAS unsigned char* lds, unsigned char* ws, int chain, const int wv) {
    const int b = chain >> 3, hh = (chain >> 1) & 3, dir = chain & 1;
    const bf16_t* wg = (const bf16_t*)(ws + (dir ? WS_WB : WS_WF)); const bf16_t* qg = (const bf16_t*)(ws + WS_QH); const bf16_t* kTg = (const bf16_t*)(ws + WS_KT);
    const bf16_t* ing = (const bf16_t*)(ws + (dir ? WS_IB : WS_IF)); const bf16_t* uTg = (const bf16_t*)(ws + (dir ? WS_UB : WS_UF));
    const float* egg = (const float*)(ws + WS_EG); const float* ekg = (const float*)(ws + WS_EK); const float* etg = (const float*)(ws + WS_ETOT);
    bf16_t* out = (bf16_t*)(ws + (dir ? WS_OB : WS_OF));
    const int tid = otid(wv), wid = tid >> 6, lane = tid & 63, r = lane & 31, h = lane >> 5;
    const int di = dir * 4 + hh;
    if (wv >= 4) {
        const int lt = tid - 256;
        for (int c = -1; c < 127; ++c) {
            const int n = dir ? 127 - (c + 1) : (c + 1); const size_t t0 = (size_t)b * S_ + (size_t)n * 64;
            LAS unsigned char* buf = lds + ((c + 1) & 1) * SC_BUF;
            u32x4 rw[4], rq[4], rk[4], ri[2];
#pragma unroll
            for (int k = 0; k < 4; ++k) { const int ch = lt + k * 256, i = ch >> 4, pc = ch & 15; const size_t src = (t0 + i) * 512 + hh * 128 + pc * 8; rw[k] = *(const u32x4*)(wg + src); rq[k] = *(const u32x4*)(qg + src); }
#pragma unroll
            for (int k = 0; k < 4; ++k) { const int ch = lt + k * 256, dk = ch >> 3, pc = ch & 7; rk[k] = *(const u32x4*)(kTg + ((size_t)(b * 4 + hh) * 128 + dk) * S_ + (size_t)n * 64 + pc * 8); }
#pragma unroll
            for (int k = 0; k < 2; ++k) { const int ch = lt + k * 256, i = ch >> 3, pc = ch & 7; ri[k] = *(const u32x4*)(ing + ((t0 + i) * 4 + hh) * 64 + pc * 8); }
            float ev = 0.f;
            if (lt < 64) ev = egg[(t0 + lt) * 8 + di]; else if (lt < 128) ev = ekg[(t0 + lt - 64) * 8 + di]; else if (lt == 128) ev = etg[((size_t)b * 128 + n) * 8 + di];
#pragma unroll
            for (int k = 0; k < 4; ++k) { const int ch = lt + k * 256, i = ch >> 4, pc = ch & 15;
                *(LAS u32x2*)(buf + SC_W + i * 264 + pc * 16) = (u32x2){rw[k].x, rw[k].y}; *(LAS u32x2*)(buf + SC_W + i * 264 + pc * 16 + 8) = (u32x2){rw[k].z, rw[k].w};
                *(LAS u32x2*)(buf + SC_Q + i * 264 + pc * 16) = (u32x2){rq[k].x, rq[k].y}; *(LAS u32x2*)(buf + SC_Q + i * 264 + pc * 16 + 8) = (u32x2){rq[k].z, rq[k].w}; }
#pragma unroll
            for (int k = 0; k < 4; ++k) { const int ch = lt + k * 256, dk = ch >> 3, pc = ch & 7;
                *(LAS u32x2*)(buf + SC_KT + dk * 136 + pc * 16) = (u32x2){rk[k].x, rk[k].y}; *(LAS u32x2*)(buf + SC_KT + dk * 136 + pc * 16 + 8) = (u32x2){rk[k].z, rk[k].w}; }
#pragma unroll
            for (int k = 0; k < 2; ++k) { const int ch = lt + k * 256, i = ch >> 3, pc = ch & 7;
                *(LAS u32x2*)(buf + SC_IN + i * 136 + pc * 16) = (u32x2){ri[k].x, ri[k].y}; *(LAS u32x2*)(buf + SC_IN + i * 136 + pc * 16 + 8) = (u32x2){ri[k].z, ri[k].w}; }
            if (lt <= 128) *(LAS float*)(buf + SC_EG + lt * 4) = ev;
            __syncthreads();
        }
        __syncthreads();
    } else {
        const int nb = wid;
        f32x16 Sa[4];
#pragma unroll
        for (int kb = 0; kb < 4; ++kb)
#pragma unroll
            for (int i = 0; i < 16; ++i) Sa[kb][i] = 0.f;
        __syncthreads();
        for (int c = 0; c < 128; ++c) {
            const int n = dir ? 127 - c : c; const size_t t0 = (size_t)b * S_ + (size_t)n * 64;
            const LAS unsigned char* buf = lds + (c & 1) * SC_BUF;
            u32x2 ur[2][4];
            { const bf16_t* up = uTg + ((size_t)(b * 4 + hh) * 128 + 32 * nb + r) * S_ + (size_t)n * 64 + 4 * h;
#pragma unroll
                for (int tb = 0; tb < 2; ++tb)
#pragma unroll
                    for (int g4 = 0; g4 < 4; ++g4) ur[tb][g4] = *(const u32x2*)(up + 32 * tb + 8 * g4); }
            bf16x8 Sb[4][2];
#pragma unroll
            for (int kb = 0; kb < 4; ++kb) { Sb[kb][0] = pack8n(Sa[kb], 0); Sb[kb][1] = pack8n(Sa[kb], 1); }
            f32x16 X[2], Y[2];
#pragma unroll
            for (int i = 0; i < 16; ++i) { X[0][i] = 0.f; X[1][i] = 0.f; Y[0][i] = 0.f; Y[1][i] = 0.f; }
#pragma unroll
            for (int kb = 0; kb < 4; ++kb)
#pragma unroll
                for (int s = 0; s < 2; ++s)
#pragma unroll
                    for (int tb = 0; tb < 2; ++tb) { const int off = (32 * tb + r) * 264 + (32 * kb + 16 * s + 4 * h) * 2;
                        const s16x4 w0 = *(const LAS s16x4*)(buf + SC_W + off), w1 = *(const LAS s16x4*)(buf + SC_W + off + 16);
                        const s16x4 q0 = *(const LAS s16x4*)(buf + SC_Q + off), q1 = *(const LAS s16x4*)(buf + SC_Q + off + 16);
                        X[tb] = __builtin_amdgcn_mfma_f32_32x32x16_bf16(__builtin_shufflevector(w0, w1, 0, 1, 2, 3, 4, 5, 6, 7), Sb[kb][s], X[tb], 0, 0, 0);
                        Y[tb] = __builtin_amdgcn_mfma_f32_32x32x16_bf16(__builtin_shufflevector(q0, q1, 0, 1, 2, 3, 4, 5, 6, 7), Sb[kb][s], Y[tb], 0, 0, 0); }
            f32x16 vn[2];
#pragma unroll
            for (int tb = 0; tb < 2; ++tb)
#pragma unroll
                for (int g4 = 0; g4 < 4; ++g4) { const u32x2 uu = ur[tb][g4];
                    vn[tb][4 * g4] = bflo(uu.x) - X[tb][4 * g4]; vn[tb][4 * g4 + 1] = bfhi(uu.x) - X[tb][4 * g4 + 1];
                    vn[tb][4 * g4 + 2] = bflo(uu.y) - X[tb][4 * g4 + 2]; vn[tb][4 * g4 + 3] = bfhi(uu.y) - X[tb][4 * g4 + 3]; }
            bf16x8 vb[2][2];
#pragma unroll
            for (int tb = 0; tb < 2; ++tb) { vb[tb][0] = pack8n(vn[tb], 0); vb[tb][1] = pack8n(vn[tb], 1); }
#pragma unroll
            for (int tb = 0; tb < 2; ++tb)
#pragma unroll
                for (int g4 = 0; g4 < 4; ++g4) { const f32x4 e4 = *(const LAS f32x4*)(buf + SC_EG + (32 * tb + 8 * g4 + 4 * h) * 4);
#pragma unroll
                    for (int e = 0; e < 4; ++e) Y[tb][4 * g4 + e] *= e4[e]; }
#pragma unroll
            for (int tb = 0; tb < 2; ++tb)
#pragma unroll
                for (int t2 = 0; t2 < 2; ++t2)
#pragma unroll
                    for (int s = 0; s < 2; ++s) { const int off = (32 * tb + r) * 136 + (32 * t2 + 16 * s + 4 * h) * 2;
                        const s16x4 a0 = *(const LAS s16x4*)(buf + SC_IN + off), a1 = *(const LAS s16x4*)(buf + SC_IN + off + 16);
                        Y[tb] = __builtin_amdgcn_mfma_f32_32x32x16_bf16(__builtin_shufflevector(a0, a1, 0, 1, 2, 3, 4, 5, 6, 7), vb[t2][s], Y[tb], 0, 0, 0); }
#pragma unroll
            for (int tb = 0; tb < 2; ++tb)
#pragma unroll
                for (int g4 = 0; g4 < 4; ++g4) { const f32x4 e4 = *(const LAS f32x4*)(buf + SC_EG + 256 + (32 * tb + 8 * g4 + 4 * h) * 4);
#pragma unroll
                    for (int e = 0; e < 4; ++e) vn[tb][4 * g4 + e] *= e4[e]; }
#pragma unroll
            for (int tb = 0; tb < 2; ++tb) { vb[tb][0] = pack8n(vn[tb], 0); vb[tb][1] = pack8n(vn[tb], 1); }
            const float et = *(const LAS float*)(buf + SC_EG + 512);
#pragma unroll
            for (int kb = 0; kb < 4; ++kb) {
#pragma unroll
                for (int i = 0; i < 16; ++i) Sa[kb][i] *= et;
#pragma unroll
                for (int tb = 0; tb < 2; ++tb)
#pragma unroll
                    for (int s = 0; s < 2; ++s) { const int off = (32 * kb + r) * 136 + (32 * tb + 16 * s + 4 * h) * 2;
                        const s16x4 a0 = *(const LAS s16x4*)(buf + SC_KT + off), a1 = *(const LAS s16x4*)(buf + SC_KT + off + 16);
                        Sa[kb] = __builtin_amdgcn_mfma_f32_32x32x16_bf16(__builtin_shufflevector(a0, a1, 0, 1, 2, 3, 4, 5, 6, 7), vb[tb][s], Sa[kb], 0, 0, 0); } }
#pragma unroll
            for (int tb = 0; tb < 2; ++tb)
#pragma unroll
                for (int x = 0; x < 16; ++x) { const int i = 32 * tb + (x & 3) + 8 * (x >> 2) + 4 * h;
                    out[(t0 + i) * 512 + hh * 128 + 32 * nb + r] = (bf16_t)(pk2(Y[tb][x], 0.f) & 0xffff); }
            __syncthreads();
        }
    }
}

DI bf16x8 pack8(const f32x16& x, int s) {
    u32x4 pk;
    if (s == 0) asm volatile("v_cvt_pk_bf16_f32 %0, %4, %5\n\tv_cvt_pk_bf16_f32 %1, %6, %7\n\tv_cvt_pk_bf16_f32 %2, %8, %9\n\tv_cvt_pk_bf16_f32 %3, %10, %11\n\ts_nop 1"
               : "=&v"(pk[0]), "=&v"(pk[1]), "=&v"(pk[2]), "=&v"(pk[3]) : "v"(x[0]), "v"(x[1]), "v"(x[2]), "v"(x[3]), "v"(x[4]), "v"(x[5]), "v"(x[6]), "v"(x[7]));
    else asm volatile("v_cvt_pk_bf16_f32 %0, %4, %5\n\tv_cvt_pk_bf16_f32 %1, %6, %7\n\tv_cvt_pk_bf16_f32 %2, %8, %9\n\tv_cvt_pk_bf16_f32 %3, %10, %11\n\ts_nop 1"
               : "=&v"(pk[0]), "=&v"(pk[1]), "=&v"(pk[2]), "=&v"(pk[3]) : "v"(x[8]), "v"(x[9]), "v"(x[10]), "v"(x[11]), "v"(x[12]), "v"(x[13]), "v"(x[14]), "v"(x[15]));
    return __builtin_bit_cast(bf16x8, pk);
}
constexpr int AT_KROW = 208, AT_VROW = 136, AT_KBYTES = 64 * AT_KROW, AT_BUF = AT_KBYTES + 64 * AT_VROW;
DI void attn_tile(const LAS unsigned char* kcur, const LAS unsigned char* vcur, const bf16x8 (&bq)[2][6], f32x16 (&oT)[2][2],
                  float (&mrun)[2], float (&lrun)[2], int lane, int r, int hf, int kh) {
    f32x16 sT[2];
#pragma unroll
    for (int i = 0; i < 16; ++i) { sT[0][i] = 0.f; sT[1][i] = 0.f; }
#pragma unroll
    for (int ks = 0; ks < 6; ++ks) { const bf16x8 a = *(const LAS bf16x8*)(kcur + (kh * 32 + r) * AT_KROW + (ks * 16 + 8 * hf) * 2);
        sT[0] = __builtin_amdgcn_mfma_f32_32x32x16_bf16(a, bq[0][ks], sT[0], 0, 0, 0);
        sT[1] = __builtin_amdgcn_mfma_f32_32x32x16_bf16(a, bq[1][ks], sT[1], 0, 0, 0); }
#pragma unroll
    for (int qb = 0; qb < 2; ++qb) {
        float mx = sT[qb][0];
#pragma unroll
        for (int i = 1; i < 16; ++i) mx = fmaxf(mx, sT[qb][i]);
        mx = fmaxf(mx, lane_xor(mx, lane, 32));
        if (__builtin_amdgcn_ballot_w64(mx > mrun[qb] + 8.0f) != 0ull) {
            const float mnew = fmaxf(mrun[qb], mx), alpha = __builtin_amdgcn_exp2f(mrun[qb] - mnew); mrun[qb] = mnew; lrun[qb] *= alpha;
#pragma unroll
            for (int i = 0; i < 16; ++i) { oT[qb][0][i] *= alpha; oT[qb][1][i] *= alpha; }
        }
        float rs = 0.f;
#pragma unroll
        for (int i = 0; i < 16; ++i) { sT[qb][i] = __builtin_amdgcn_exp2f(sT[qb][i] - mrun[qb]); rs += sT[qb][i]; }
        lrun[qb] += rs;
    }
#pragma unroll
    for (int s = 0; s < 2; ++s) { const bf16x8 bp0 = pack8n(sT[0], s), bp1 = pack8n(sT[1], s);
#pragma unroll
        for (int dvb = 0; dvb < 2; ++dvb) { const LAS unsigned char* va = vcur + (dvb * 32 + r) * AT_VROW + (kh * 32 + 16 * s + 4 * hf) * 2;
            const s16x4 lo = *(const LAS s16x4*)va, hi = *(const LAS s16x4*)(va + 16); const bf16x8 a = __builtin_shufflevector(lo, hi, 0, 1, 2, 3, 4, 5, 6, 7);
            oT[0][dvb] = __builtin_amdgcn_mfma_f32_32x32x16_bf16(a, bp0, oT[0][dvb], 0, 0, 0);
            oT[1][dvb] = __builtin_amdgcn_mfma_f32_32x32x16_bf16(a, bp1, oT[1][dvb], 0, 0, 0); } }
}
constexpr int AT_XCH = 45056;
DI void attn_unit(LAS unsigned char* lds, const bf16_t* Q, const bf16_t* Kn, const bf16_t* Kr, const bf16_t* Vt, bf16_t* O, const float* cosT, const float* sinT, int b, int hh, int qblk, const int wv) {
    const int tid = otid(wv), wid = tid >> 6, lane = tid & 63, r = lane & 31, hf = lane >> 5, g = wv & 3, kh = wv >> 2;
    const size_t q0 = (size_t)b * S_ + (size_t)qblk * 256 + g * 64;
    const int kc0 = tid, kc1 = tid + 512; const bool has1 = tid < 256;
    const int key0 = kc0 / 12, part0 = kc0 % 12, key1 = has1 ? kc1 / 12 : 0, part1 = has1 ? kc1 % 12 : 0;
    const bf16_t* ks0 = (part0 < 8) ? Kn + ((size_t)b * S_ + key0) * 512 + hh * 64 + part0 * 8 : Kr + ((size_t)b * S_ + key0) * 32 + (part0 - 8) * 8;
    const bf16_t* ks1 = (part1 < 8) ? Kn + ((size_t)b * S_ + key1) * 512 + hh * 64 + part1 * 8 : Kr + ((size_t)b * S_ + key1) * 32 + (part1 - 8) * 8;
    const size_t kst0 = (part0 < 8) ? 512 : 32, kst1 = (part1 < 8) ? 512 : 32;
    const int kd0 = key0 * AT_KROW + part0 * 16, kd1 = key1 * AT_KROW + part1 * 16;
    const int vdv = tid >> 3, vpart = tid & 7;
    const bf16_t* vsrc = Vt + (size_t)(hh * 64 + vdv) * T_ + (size_t)b * S_ + vpart * 8;
    const int vd = AT_KBYTES + vdv * AT_VROW + vpart * 16;
    u32x4 kr0, kr1 = (u32x4){0, 0, 0, 0}, vr;
    kr0 = *(const u32x4*)ks0; if (has1) kr1 = *(const u32x4*)ks1; vr = *(const u32x4*)vsrc;
    bf16x8 bq[2][6];
#pragma unroll
    for (int qb = 0; qb < 2; ++qb) {
#pragma unroll
        for (int ks = 0; ks < 6; ++ks) bq[qb][ks] = *(const bf16x8*)(Q + (q0 + qb * 32 + r) * 768 + hh * 96 + ks * 16 + 8 * hf);
        const float* cp = cosT + (q0 + qb * 32 + r) * 16 + 8 * hf; const float* sp = sinT + (q0 + qb * 32 + r) * 16 + 8 * hf;
        const f32x4 c0 = *(const f32x4*)cp, c1 = *(const f32x4*)(cp + 4), s0 = *(const f32x4*)sp, s1 = *(const f32x4*)(sp + 4);
        const u32x4 x1 = __builtin_bit_cast(u32x4, bq[qb][4]), x2 = __builtin_bit_cast(u32x4, bq[qb][5]); u32x4 y1, y2;
#pragma unroll
        for (int e = 0; e < 4; ++e) { const float a0 = bflo(x1[e]), a1 = bfhi(x1[e]), b0 = bflo(x2[e]), b1 = bfhi(x2[e]);
            const float cc0 = e < 2 ? c0[2 * e] : c1[2 * e - 4], cc1 = e < 2 ? c0[2 * e + 1] : c1[2 * e - 3], ss0 = e < 2 ? s0[2 * e] : s1[2 * e - 4], ss1 = e < 2 ? s0[2 * e + 1] : s1[2 * e - 3];
            y1[e] = pk2(a0 * cc0 - b0 * ss0, a1 * cc1 - b1 * ss1); y2[e] = pk2(b0 * cc0 + a0 * ss0, b1 * cc1 + a1 * ss1); }
        bq[qb][4] = __builtin_bit_cast(bf16x8, y1); bq[qb][5] = __builtin_bit_cast(bf16x8, y2); }
    f32x16 oT[2][2];
#pragma unroll
    for (int i = 0; i < 16; ++i) { oT[0][0][i] = 0.f; oT[0][1][i] = 0.f; oT[1][0][i] = 0.f; oT[1][1][i] = 0.f; }
    float mrun[2] = {-1e30f, -1e30f}, lrun[2] = {0.f, 0.f};
    *(LAS u32x4*)(lds + kd0) = kr0; if (has1) *(LAS u32x4*)(lds + kd1) = kr1;
    *(LAS u32x2*)(lds + vd) = (u32x2){vr.x, vr.y}; *(LAS u32x2*)(lds + vd + 8) = (u32x2){vr.z, vr.w};
    __syncthreads();
    for (int t = 0; t < 128; ++t) {
        const LAS unsigned char* kb_ = lds + (t & 1) * AT_BUF;
        if (t + 1 < 128) { const size_t ko = (size_t)(t + 1) * 64; kr0 = *(const u32x4*)(ks0 + ko * kst0); if (has1) kr1 = *(const u32x4*)(ks1 + ko * kst1); vr = *(const u32x4*)(vsrc + ko); }
        attn_tile(kb_, kb_ + AT_KBYTES, bq, oT, mrun, lrun, lane, r, hf, kh);
        if (t + 1 < 128) { LAS unsigned char* nb = lds + ((t + 1) & 1) * AT_BUF;
            *(LAS u32x4*)(nb + kd0) = kr0; if (has1) *(LAS u32x4*)(nb + kd1) = kr1;
            *(LAS u32x2*)(nb + vd) = (u32x2){vr.x, vr.y}; *(LAS u32x2*)(nb + vd + 8) = (u32x2){vr.z, vr.w}; }
        __syncthreads();
    }
    LAS float* xw = (LAS float*)(lds + AT_XCH) + g * (68 * 64) + lane;
    if (kh == 1) {
#pragma unroll
        for (int qb = 0; qb < 2; ++qb) { xw[(64 + qb) * 64] = mrun[qb]; xw[(64 + 2 + qb) * 64 - 128 + 128] = lrun[qb];
#pragma unroll
            for (int dvb = 0; dvb < 2; ++dvb)
#pragma unroll
                for (int i = 0; i < 16; ++i) xw[((qb * 2 + dvb) * 16 + i) * 64] = oT[qb][dvb][i]; }
    }
    __syncthreads();
    if (kh == 0) {
#pragma unroll
        for (int qb = 0; qb < 2; ++qb) { const float m1 = xw[(64 + qb) * 64], l1 = xw[(66 + qb) * 64 - 128 + 128];
            const float m = fmaxf(mrun[qb], m1), a0 = __builtin_amdgcn_exp2f(mrun[qb] - m), a1 = __builtin_amdgcn_exp2f(m1 - m);
            float l = lrun[qb] * a0 + l1 * a1; l += lane_xor(l, lane, 32); const float inv = 1.0f / l, f0 = a0 * inv, f1 = a1 * inv;
#pragma unroll
            for (int dvb = 0; dvb < 2; ++dvb)
#pragma unroll
                for (int g4 = 0; g4 < 4; ++g4) { float o[4];
#pragma unroll
                    for (int e = 0; e < 4; ++e) o[e] = oT[qb][dvb][4 * g4 + e] * f0 + xw[((qb * 2 + dvb) * 16 + 4 * g4 + e) * 64] * f1;
                    u32x2 w; w.x = pk2(o[0], o[1]); w.y = pk2(o[2], o[3]);
                    *(u32x2*)(O + (q0 + qb * 32 + r) * 512 + hh * 64 + dvb * 32 + 8 * g4 + 4 * hf) = w; } }
    }
}

DI void gdn_gate_norm(const Params& p, unsigned char* ws, int l, const int wv) {
    const bf16_t* of = (const bf16_t*)(ws + WS_OF); const bf16_t* ob = (const bf16_t*)(ws + WS_OB); const bf16_t* z = (const bf16_t*)(ws + WS_Z);
    bf16_t* ag = (bf16_t*)(ws + WS_AG); const float* nw = p.in[11] + l * 128;
    const int tid_ = otid(wv); const int lane = tid_ & 63, wid = tid_ >> 6;
    const f32x4 n0 = *(const f32x4*)(nw + (lane & 15) * 8), n1 = *(const f32x4*)(nw + (lane & 15) * 8 + 4);
    for (int t = (blockIdx.x * 8 + wid) * 2; t < T_; t += gridDim.x * 16) {
        u32x4 a[2], b[2], zz[2];
#pragma unroll
        for (int rr = 0; rr < 2; ++rr) { const size_t o = (size_t)(t + rr) * 512 + lane * 8; a[rr] = *(const u32x4*)(of + o); b[rr] = *(const u32x4*)(ob + o); zz[rr] = *(const u32x4*)(z + o); }
#pragma unroll
        for (int rr = 0; rr < 2; ++rr) { float v[8]; float ss = 0.f;
#pragma unroll
            for (int e = 0; e < 4; ++e) { v[2 * e] = bflo(a[rr][e]) + bflo(b[rr][e]); v[2 * e + 1] = bfhi(a[rr][e]) + bfhi(b[rr][e]); ss += v[2 * e] * v[2 * e] + v[2 * e + 1] * v[2 * e + 1]; }
            ss += lane_xor(ss, lane, 1); ss += lane_xor(ss, lane, 2); ss += lane_xor(ss, lane, 4); ss += lane_xor(ss, lane, 8);
            const float rstd = rsqrtf(ss * (1.0f / 128.f) + EPS_); u32x4 w;
#pragma unroll
            for (int e = 0; e < 4; ++e) { const float w0 = (2 * e < 4) ? n0[2 * e] : n1[2 * e - 4], w1 = (2 * e + 1 < 4) ? n0[2 * e + 1] : n1[2 * e - 3];
                w[e] = pk2(v[2 * e] * rstd * w0 * siluf_(bflo(zz[rr][e])), v[2 * e + 1] * rstd * w1 * siluf_(bfhi(zz[rr][e]))); }
            *(u32x4*)(ag + (size_t)(t + rr) * 512 + lane * 8) = w; }
    }
}

#define XB_TMO      128
#define XB_XCNT(j)  (256  + 64 * (j))
#define XB_XSUB(j)  (1280 + 64 * (j))
#define XB_XGEN(j)  (2304 + 64 * (j))
#define XB_TOP      3328
#define XB_TOPGEN   3392
#define XCD_BAR_WORDS 3456
#define XB_SPIN_CAP (1u << 18)
DI unsigned xb_ld(unsigned* p)              { return __hip_atomic_load(p, __ATOMIC_RELAXED, __HIP_MEMORY_SCOPE_AGENT); }
DI unsigned xb_add(unsigned* p, unsigned v) { return __hip_atomic_fetch_add(p, v, __ATOMIC_RELAXED, __HIP_MEMORY_SCOPE_AGENT); }
DI unsigned xb_xcc_id() { return (unsigned)__builtin_amdgcn_s_getreg((3 << 11) | 20) & 0xFu; }
#define XB_SPIN(cond, bar) do { unsigned _sp = 0; while (cond) { __builtin_amdgcn_s_sleep(1); \
    if ((++_sp & 255u) == 0u) { if (xb_ld(&(bar)[XB_TMO])) break; if (_sp > XB_SPIN_CAP) { atomicAdd(&(bar)[XB_TMO], 1u); break; } } } } while (0)
DI void xcd_barrier_complete(unsigned* bar, unsigned x, unsigned G, unsigned& nloc, unsigned& nx) {
    unsigned sum, cnt, mine, sp = 0u;
    for (;;) {
        sum = 0u; cnt = 0u; mine = 0u;
#pragma unroll
        for (unsigned j = 0; j < 16; ++j) { const unsigned c = xb_ld(&bar[XB_XCNT(j)]); sum += c; cnt += (c > 0u) ? 1u : 0u; mine = (j == x) ? c : mine; }
        if (sum == G) break;
        __builtin_amdgcn_s_sleep(1);
        if ((++sp & 255u) == 0u) { if (xb_ld(&bar[XB_TMO])) break; if (sp > XB_SPIN_CAP) { atomicAdd(&bar[XB_TMO], 1u); break; } }
    }
    nloc = mine > 0u ? mine : 1u; nx = cnt > 0u ? cnt : 1u;
}
DI void xcd_barrier(unsigned* bar, volatile LAS unsigned* st, unsigned G, const int wv) {
    asm volatile("s_waitcnt vmcnt(0)" ::: "memory");
    __syncthreads();
    if (otid(wv) == 0) {
        const unsigned x = xb_xcc_id();
        __builtin_amdgcn_s_waitcnt(0);
        unsigned nloc = st[0], nx = st[1];
        if (nloc == 0u) { xcd_barrier_complete(bar, x, G, nloc, nx); st[0] = nloc; st[1] = nx; }
        const unsigned old = xb_add(&bar[XB_XSUB(x)], 1u);
        const unsigned gen = old / nloc;
        if (old + 1u == (gen + 1u) * nloc) {
            __builtin_amdgcn_fence(__ATOMIC_RELEASE, "agent");
            asm volatile("s_waitcnt vmcnt(0)" ::: "memory");
            const unsigned og = xb_add(&bar[XB_TOP], 1u);
            const unsigned tg = og / nx;
            if (og + 1u == (tg + 1u) * nx) xb_add(&bar[XB_TOPGEN], 1u);
            else XB_SPIN(xb_ld(&bar[XB_TOPGEN]) == tg, bar);
            __builtin_amdgcn_fence(__ATOMIC_ACQUIRE, "agent");
            xb_add(&bar[XB_XGEN(x)], 1u);
            asm volatile("s_waitcnt vmcnt(0)" ::: "memory");
        } else {
            XB_SPIN(xb_ld(&bar[XB_XGEN(x)]) == gen, bar);
            __builtin_amdgcn_fence(__ATOMIC_ACQUIRE, "agent");
            asm volatile("s_waitcnt vmcnt(0)" ::: "memory");
        }
    }
    __syncthreads();
}

__global__ void __launch_bounds__(512, 2) mega(Params p) {
    extern __shared__ __attribute__((aligned(16))) unsigned char shm[];
    LAS unsigned char* lds = (LAS unsigned char*)shm;
    const int wv = __builtin_amdgcn_readfirstlane(threadIdx.x >> 6);
    volatile LAS unsigned* xst = (volatile LAS unsigned*)(lds + 131072);
    if (threadIdx.x < 2) xst[threadIdx.x] = 0u;
    __syncthreads();
    if (threadIdx.x == 0) (void)xb_add((unsigned*)(p.ws + WS_BAR) + XB_XCNT(xb_xcc_id()), 1u);
    const int ph_lo = __builtin_amdgcn_readfirstlane(p.ph_lo), ph_hi = __builtin_amdgcn_readfirstlane(p.ph_hi);
    for (int ph = ph_lo; ph < ph_hi; ++ph) {
        size_t zoff = 0; int G = gridDim.x, bid = blockIdx.x;
        asm volatile("" : "+s"(zoff), "+s"(G), "+s"(bid));
        unsigned char* ws = p.ws + zoff;
        const int gstride = G * 512;
        if (ph == 0) {
            const int gtid = bid * 512 + otid(wv);
            if (bid == 0 && gtid < 16) *((unsigned*)(ws + WS_CTR) + gtid * 64) = 0u;
            const int* pos = (const int*)p.in[1]; float* cosT = (float*)(ws + WS_COS); float* sinT = (float*)(ws + WS_SIN);
            for (int idx = gtid; idx < T_ * 16; idx += gstride) { const int t = idx >> 4, i = idx & 15;
                const double rev = (double)pos[t] * p.invf_rev[i]; const float fr = (float)(rev - rint(rev));
                cosT[idx] = __builtin_amdgcn_cosf(fr); sinT[idx] = __builtin_amdgcn_sinf(fr); }
        } else if (ph == NPH_ - 1) {
            rms_rows<true>(p.out, p.in[23], p.out, wv);
        } else {
            const int l = (ph - 1) / NS_, sl = (ph - 1) % NS_, st = (PROBE_ST >= 0 && sl > PROBE_ST) ? sl - 1 : sl;
            const bool ffn2 = st >= 12; const int fs = ffn2 ? st - 12 : st;
            const float* xin = (l == 0 && st < 3) ? p.in[0] : p.out;
            if ((st < 3 || ffn2)) {
                const int ig = ffn2 ? 20 : 3, iu = ffn2 ? 21 : 4, idn = ffn2 ? 22 : 5, inw = ffn2 ? 19 : 2;
                if (fs == 0 && EN(0)) {
                    const int gtid = bid * 512 + otid(wv);
                    rms_rows<false>(xin, p.in[inw] + (size_t)l * D_, ws + WS_H, wv);
                    conv_w(p.in[ig] + (size_t)l * D_ * FF_, p.in[iu] + (size_t)l * D_ * FF_, FF_, (bf16_t*)(ws + W_GU), 5632, 1024, 1, nullptr, gtid, gstride);
                    conv_w(p.in[idn] + (size_t)l * D_ * FF_, nullptr, D_, (bf16_t*)(ws + W_D), 1024, FF_, 0, nullptr, gtid, gstride);
                } else if (fs == 1 && EN(1)) {
                    pg8::Gemm g{(const bf16_t*)(ws + WS_H), (const bf16_t*)(ws + W_GU), T_, 5632, 1024, 1024, 1024}; pg8::StaticOrder S; S.init(T_, 5632, G, bid);
                    pg8::EpiSwiglu E{(bf16_t*)(ws + WS_BIG), FF_}; pg8::gemm_phase(lds, g, S, E, wv);
                } else if (EN(2)) {
                    pg8::Gemm g{(const bf16_t*)(ws + WS_BIG), (const bf16_t*)(ws + W_D), T_, 1024, FF_, FF_, FF_}; pg8::StaticOrder S; S.init(T_, 1024, G, bid);
                    pg8::EpiResid E{xin, p.out, 0.5f}; pg8::gemm_phase(lds, g, S, E, wv);
                }
            } else if (st == 3 && EN(3)) {
                const int gtid = bid * 512 + otid(wv);
                rms_rows<false>(p.out, p.in[6] + (size_t)l * D_, ws + WS_H, wv);
                const float* win = p.in[7] + (size_t)l * D_ * 4784;
                conv_w(win, nullptr, 4784, (bf16_t*)(ws + W_IN), 2816, 1024, 2, nullptr, gtid, gstride);
                conv_w(win, nullptr, 4784, (bf16_t*)(ws + W_G), 2048, 1024, 3, nullptr, gtid, gstride);
                conv_w(p.in[12] + (size_t)l * 512 * 1024, nullptr, 1024, (bf16_t*)(ws + W_PA), 1024, 512, 0, nullptr, gtid, gstride);
                conv_w(p.in[17] + (size_t)l * 512 * 1024, nullptr, 1024, (bf16_t*)(ws + W_PB), 1024, 512, 0, nullptr, gtid, gstride);
                conv_w(p.in[18] + (size_t)l * 1024 * 1024, nullptr, 1024, (bf16_t*)(ws + W_OUT), 1024, 1024, 0, nullptr, gtid, gstride);
                conv_w(p.in[14] + (size_t)l * 384 * 768, nullptr, 768, (bf16_t*)(ws + W_UQ), 768, 384, 0, nullptr, gtid, gstride);
                conv_w(p.in[16] + (size_t)l * 256 * 1024, nullptr, 1024, (bf16_t*)(ws + W_UK), 512, 256, 4, nullptr, gtid, gstride);
                conv_w(p.in[16] + (size_t)l * 256 * 1024, nullptr, 1024, (bf16_t*)(ws + W_UV), 512, 256, 5, nullptr, gtid, gstride);
            } else if (st == 4 && EN(4)) {
                pg8::Gemm g{(const bf16_t*)(ws + WS_H), (const bf16_t*)(ws + W_IN), T_, 2816, 1024, 1024, 1024}; pg8::StaticOrder S; S.init(T_, 2816, G, bid);
                pg8::EpiBf16 E{(bf16_t*)(ws + WS_GQKV), 1536, 6, (bf16_t*)(ws + WS_Z), 512, 8, (bf16_t*)(ws + WS_REST), 768, 1.0f};
                pg8::gemm_phase(lds, g, S, E, wv);
            } else if (st == 5 && EN(5)) {
                const float* cw = p.in[8] + (size_t)l * 5 * 1536;
                for (int u = bid; u < 2048; u += G) gdn_chunk_pre(lds, ws, cw, p.in[9] + l * 8, p.in[10] + l * 8, u, wv);
                mla_latent_pass(p, ws, l, wv);
            } else if (st == 6 && EN(6)) {
                const bf16_t* rest = (const bf16_t*)(ws + WS_REST);
                if (EN(16)) { pg8::Gemm g{rest, (const bf16_t*)(ws + W_UQ), T_, 768, 384, 768, 384}; pg8::StaticOrder S; S.init(T_, 768, G, bid);
                  pg8::EpiBf16 E{(bf16_t*)(ws + WS_Q), 768, 1000, nullptr, 0, 1000, nullptr, 0, 0.10206207261596575f * 1.4426950408889634f};
                  pg8::gemm_phase(lds, g, S, E, wv); }
                if (EN(17)) { pg8::Gemm g{rest + 384, (const bf16_t*)(ws + W_UK), T_, 512, 256, 768, 256}; pg8::StaticOrder S; S.init(T_, 512, G, bid);
                  pg8::EpiBf16 E{(bf16_t*)(ws + WS_KN), 512, 1000, nullptr, 0, 1000, nullptr, 0, 1.0f};
                  pg8::gemm_phase(lds, g, S, E, wv); }
                if (EN(18)) { pg8::Gemm g{(const bf16_t*)(ws + W_UV), rest + 384, 512, T_, 256, 256, 768}; pg8::StaticOrder S; S.init(512, T_, G, bid);
                  pg8::EpiBf16 E{(bf16_t*)(ws + WS_VT), T_, 1000, nullptr, 0, 1000, nullptr, 0, 1.0f};
                  pg8::gemm_phase(lds, g, S, E, wv); }
            } else if (st == 7 && EN(7)) {
                if (bid < 32) gdn_scan(lds, ws, bid, wv);
                const bf16_t* Q = (const bf16_t*)(ws + WS_Q); const bf16_t* Kn = (const bf16_t*)(ws + WS_KN); const bf16_t* Kr = (const bf16_t*)(ws + WS_KR);
                const bf16_t* Vt = (const bf16_t*)(ws + WS_VT); bf16_t* AO = (bf16_t*)(ws + WS_AO);
                if (G == 256) { const int xcd = bid & 7; unsigned* ctr = (unsigned*)(ws + WS_CTR) + (l * 8 + xcd) * 64;
                    const bool t0 = otid(wv) == 0; unsigned nxt = 0u; if (t0) nxt = atomicAdd(ctr, 1u);
                    for (;;) { __syncthreads(); if (t0) *(LAS unsigned*)(lds + 131072 + 32) = nxt; __syncthreads();
                        const unsigned u = *(const LAS unsigned*)(lds + 131072 + 32); if (u >= 128u) break;
                        if (t0) nxt = atomicAdd(ctr, 1u);
                        const int pair = (int)(u >> 5) * 8 + xcd; attn_unit(lds, Q, Kn, Kr, Vt, AO, (const float*)(ws + WS_COS), (const float*)(ws + WS_SIN), pair >> 3, pair & 7, (int)(u & 31), wv); } }
                else for (int u = bid; u < 1024; u += G) { const int pair = u >> 5; attn_unit(lds, Q, Kn, Kr, Vt, AO, (const float*)(ws + WS_COS), (const float*)(ws + WS_SIN), pair >> 3, pair & 7, u & 31, wv); }
            } else if (st == 8 && EN(8)) {
                gdn_gate_norm(p, ws, l, wv);
                rms_rows<false>(p.out, p.in[6] + (size_t)l * D_, ws + WS_H2, wv);
            } else if (st == 9 && EN(9)) {
                { pg8::Gemm g{(const bf16_t*)(ws + WS_AG), (const bf16_t*)(ws + W_PA), T_, 1024, 512, 512, 512}; pg8::StaticOrder S; S.init(T_, 1024, G, bid);
                  pg8::EpiBf16 E{(bf16_t*)(ws + WS_YA), 1024, 1000, nullptr, 0, 1000, nullptr, 0, 1.0f}; pg8::gemm_phase(lds, g, S, E, wv); }
                { pg8::Gemm g{(const bf16_t*)(ws + WS_AO), (const bf16_t*)(ws + W_PB), T_, 1024, 512, 512, 512}; pg8::StaticOrder S; S.init(T_, 1024, G, bid);
                  pg8::EpiBf16 E{(bf16_t*)(ws + WS_YB), 1024, 1000, nullptr, 0, 1000, nullptr, 0, 1.0f}; pg8::gemm_phase(lds, g, S, E, wv); }
            } else if (st == 10 && EN(10)) {
                pg8::Gemm g{(const bf16_t*)(ws + WS_H2), (const bf16_t*)(ws + W_G), T_, 2048, 1024, 1024, 1024}; pg8::StaticOrder S; S.init(T_, 2048, G, bid);
                pg8::EpiGate E{(const bf16_t*)(ws + WS_YA), (const bf16_t*)(ws + WS_YB), (bf16_t*)(ws + WS_Y)}; pg8::gemm_phase(lds, g, S, E, wv);
            } else if (st == 11 && EN(11)) {
                pg8::Gemm g{(const bf16_t*)(ws + WS_Y), (const bf16_t*)(ws + W_OUT), T_, 1024, 1024, 1024, 1024}; pg8::StaticOrder S; S.init(T_, 1024, G, bid);
                pg8::EpiResid E{p.out, p.out, 1.0f}; pg8::gemm_phase(lds, g, S, E, wv);
            }
        }
        if (ph + 1 < ph_hi) {
            if (ph == ph_lo) cg::this_grid().sync(); else xcd_barrier((unsigned*)(ws + WS_BAR), xst, (unsigned)G, wv);
            for (int e = 0; e < PROBE_SYNC; ++e) xcd_barrier((unsigned*)(ws + WS_BAR), xst, (unsigned)G, wv); }
    }
}

extern "C" void kernel_launch(void* const* d_in, const int* in_sizes, int n_in, void* d_out, int out_size, void* d_ws, size_t ws_size, hipStream_t stream) {
    static int grid = 0;
    if (grid == 0) {
        if (ws_size < WS_END) { fprintf(stderr, "kernel_launch: workspace too small: %zu < %zu\n", ws_size, (size_t)WS_END); grid = -1; return; }
        int dev = 0, cus = 0;
        hipGetDevice(&dev); hipDeviceGetAttribute(&cus, hipDeviceAttributeMultiprocessorCount, dev);
        if (hipFuncSetAttribute((const void*)mega, hipFuncAttributeMaxDynamicSharedMemorySize, LDS_BYTES) != hipSuccess) { fprintf(stderr, "hipFuncSetAttribute failed\n"); grid = -1; return; }
        int per_cu = 0;
        if (hipOccupancyMaxActiveBlocksPerMultiprocessor(&per_cu, (const void*)mega, 512, LDS_BYTES) != hipSuccess || per_cu < 1) { fprintf(stderr, "occupancy query: %d\n", per_cu); per_cu = 1; }
        (void)hipGetLastError();
        grid = cus;
    }
    if (grid < 0) return;
    Params p{};
    for (int i = 0; i < 24; ++i) p.in[i] = (const float*)d_in[i];
    p.out = (float*)d_out; p.ws = (unsigned char*)d_ws;
    for (int i = 0; i < 16; ++i) p.invf_rev[i] = pow(10000.0, -(double)i / 16.0) / 6.283185307179586476925286766559;
#if COOP
    (void)hipMemsetAsync((unsigned char*)d_ws + WS_BAR, 0, 3456 * 4, stream);
    p.ph_lo = 0; p.ph_hi = NPH_;
    void* args[] = {&p};
    hipError_t e = hipLaunchCooperativeKernel((const void*)mega, dim3(grid), dim3(512), args, LDS_BYTES, stream);
    if (e != hipSuccess) fprintf(stderr, "cooperative launch failed: %s\n", hipGetErrorString(e));
#else
    for (int ph = 0; ph < NPH_; ++ph) { p.ph_lo = ph; p.ph_hi = ph + 1; hipLaunchKernelGGL(mega, dim3(grid), dim3(512), LDS_BYTES, stream, p); }
#endif
}
```

```cpp
#include <hip/hip_runtime.h>
#include <hip/hip_cooperative_groups.h>
#include <cstdio>
#include <cmath>
namespace cg = cooperative_groups;

#ifndef COOP
#define COOP 1
#endif
#ifndef PHMASK
#define PHMASK 0xffffffffu
#endif
#define EN(k) ((PHMASK >> (k)) & 1u)
#ifndef PROBE_ST
#define PROBE_ST (-1)
#endif
constexpr int NS_ = 15 + (PROBE_ST >= 0 ? 1 : 0), NPH_ = 2 + 2 * NS_;
#ifndef PROBE_SYNC
#define PROBE_SYNC 0
#endif

#define LAS __attribute__((address_space(3)))
#define DI __device__ __forceinline__
typedef unsigned short bf16_t;
typedef short bf16x8 __attribute__((ext_vector_type(8)));
typedef short s16x4 __attribute__((ext_vector_type(4)));
typedef float f32x4 __attribute__((ext_vector_type(4)));
typedef float f32x16 __attribute__((ext_vector_type(16)));
typedef unsigned u32x4 __attribute__((ext_vector_type(4)));
typedef unsigned u32x2 __attribute__((ext_vector_type(2)));

constexpr int T_ = 32768, S_ = 8192, NB_ = 4, D_ = 1024, FF_ = 2816;
constexpr int LDS_BYTES = 131072 + 64;
constexpr float EPS_ = 1e-6f;
constexpr size_t MiB = 1u << 20;
constexpr size_t WS_W = 0;
constexpr size_t W_GU = WS_W, W_D = WS_W + 11 * MiB;
constexpr size_t W_IN = WS_W, W_G = WS_W + 5632 * 1024, W_PA = WS_W + 9728 * 1024, W_PB = W_PA + MiB, W_OUT = W_PB + MiB,
                 W_UQ = W_OUT + 2 * MiB, W_UK = W_UQ + MiB, W_UV = W_UK + 256 * 1024;
constexpr size_t WS_H = 20 * MiB;
constexpr size_t WS_KT = 20 * MiB, WS_OF = 52 * MiB;
constexpr size_t WS_BIG = 84 * MiB;
constexpr size_t WS_GQKV = WS_BIG, WS_Z = WS_BIG + 96 * MiB, WS_REST = WS_BIG + 128 * MiB;
constexpr size_t WS_KN = 84 * MiB, WS_VT = 116 * MiB, WS_OB = 148 * MiB;
constexpr size_t WS_H2 = 84 * MiB;
constexpr size_t WS_AO = 212 * MiB;
constexpr size_t WS_X2 = 260 * MiB;
constexpr size_t WS_QH = 260 * MiB, WS_WF = 292 * MiB, WS_WB = 324 * MiB;
constexpr size_t WS_UF = 356 * MiB, WS_UB = 388 * MiB;
constexpr size_t WS_IF = 420 * MiB, WS_IB = 436 * MiB;
constexpr size_t WS_Q = 452 * MiB;
constexpr size_t WS_BETA = 500 * MiB, WS_G = 501 * MiB, WS_KR = 502 * MiB, WS_COS = 504 * MiB, WS_SIN = 506 * MiB,
                 WS_EG = 508 * MiB, WS_EK = 509 * MiB, WS_ETOT = 510 * MiB, WS_CTR = 510 * MiB + 512 * 1024;
constexpr size_t WS_AG = 420 * MiB;
constexpr size_t WS_YA = 260 * MiB, WS_YB = 324 * MiB, WS_Y = 388 * MiB;
constexpr size_t WS_BAR = 510 * MiB + 768 * 1024;
constexpr size_t WS_END = 511 * MiB;

typedef __bf16 bf16v2 __attribute__((ext_vector_type(2)));
typedef float f32x2 __attribute__((ext_vector_type(2)));
DI unsigned pk2(float lo, float hi) { return __builtin_bit_cast(unsigned, __builtin_convertvector((f32x2){lo, hi}, bf16v2)); }
DI unsigned cvt_pk_bf16(float lo, float hi) { unsigned r; asm volatile("v_cvt_pk_bf16_f32 %0, %1, %2" : "=v"(r) : "v"(lo), "v"(hi)); return r; }
DI float bf2f(bf16_t b) { return __uint_as_float(((unsigned)b) << 16); }
DI float bflo(unsigned w) { return __uint_as_float(w << 16); }
DI float bfhi(unsigned w) { return __uint_as_float(w & 0xffff0000u); }
DI float sigmoidf_(float x) { return __builtin_amdgcn_rcpf(1.0f + __expf(-x)); }
DI float siluf_(float x) { return x * sigmoidf_(x); }
DI int otid(int wv) { int z; asm volatile("s_mov_b32 %0, 0" : "=s"(z)); return wv * 64 + (int)__builtin_amdgcn_mbcnt_hi(~0u, __builtin_amdgcn_mbcnt_lo(~0u, (unsigned)z)); }
DI float lane_xor(float v, int lane, int o) { return __int_as_float(__builtin_amdgcn_ds_bpermute((lane ^ o) << 2, __float_as_int(v))); }
DI float wave_sum(float v, int lane) {
#pragma unroll
    for (int o = 32; o >= 1; o >>= 1) v += lane_xor(v, lane, o);
    return v; }

namespace pg8 {
constexpr int BM = 256, BK = 64, HALF = 128, HTB = HALF * BK * 2, NXCD = 8, WGM = 8;
DI int lds_byte(int r, int c) { const int st = (r >> 4) * 2 + (c >> 5), rr = r & 15, cc = c & 31, ob = rr * 64 + cc * 2; return st * 1024 + (ob ^ (((ob >> 9) & 1) << 5)); }
DI void stage_rc(int b, int& R, int& C) { const int st = b / 1024, sb = b % 1024, swz = sb ^ (((sb >> 9) & 1) << 5); R = (st >> 1) * 16 + swz / 64; C = (st & 1) * 32 + (swz % 64) / 2; }
DI int perm32(int rho) { const int n = rho >> 4, i = rho & 15; return 8 * (i >> 2) + 4 * n + (i & 3); }
struct Unit { int pm, pn; };
struct Gemm { const bf16_t* A; const bf16_t* Bt; int M, N, K, lda, ldb; };
struct StaticOrder {
    int nM, nN, nwg, G, c;
    DI void init(int M, int N, int G_, int c_) { nM = M / BM; nN = N / BM; nwg = nM * nN; G = G_; c = c_; }
    DI bool next(int i, Unit& u) const {
        const long L = (long)i * G + c; if (L >= nwg) return false;
        int wgid = (int)L; { const int q = nwg / NXCD, r = nwg % NXCD, xcd = wgid % NXCD, off = wgid / NXCD; wgid = (xcd < r ? xcd * (q + 1) : r * (q + 1) + (xcd - r) * q) + off; }
        const int nig = WGM * nN, gid = wgid / nig, fm = gid * WGM, gsz = (nM - fm) < WGM ? (nM - fm) : WGM;
        u.pm = fm + ((wgid % nig) % gsz); u.pn = (wgid % nig) / gsz; return true;
    }
};
template <class Epi>
DI void gemm_phase(LAS unsigned char* lds, const Gemm g, const StaticOrder& S, const Epi& E, const int wv) {
    const int tid = otid(wv), wid = __builtin_amdgcn_readfirstlane(tid >> 6), lane = tid & 63, wr = wid >> 2, wc = wid & 3, fr = lane & 15, fq = lane >> 4;
    const int K = g.K, nt = K / BK;
    unsigned voffA[2], voffB[2];
#pragma unroll
    for (int i = 0; i < 2; ++i) { int R, C; stage_rc(tid * 16 + i * 8192, R, C); const int Rb = Epi::PERM ? ((R & ~31) + perm32(R & 31)) : R;
        voffA[i] = (unsigned)(R * g.lda + C) * 2u; voffB[i] = (unsigned)(Rb * g.ldb + C) * 2u; }
    const size_t kstep = (size_t)(BK * 2);
    const size_t hstepA = (size_t)HALF * g.lda * 2, hstepB = (size_t)HALF * g.ldb * 2;
    const size_t tstepA = 2 * hstepA, tstepB = 2 * hstepB;
    const unsigned ldsw = (unsigned)wid * 1024u;
    const int aoff = lds_byte(wr * 64 + fr, fq * 8), boff = lds_byte(wc * 32 + fr, fq * 8);
#define PG8_SA(b, h) (((b) * 2 + (h)) * HTB)
#define PG8_SB(b, h) ((4 + (b) * 2 + (h)) * HTB)
#define PG8_STAGE(bufoff, gbase, voff) do { _Pragma("unroll") for (int _i = 0; _i < 2; ++_i) \
        __builtin_amdgcn_global_load_lds((const unsigned*)((const char*)(gbase) + (voff)[_i]), (LAS unsigned*)(lds + (bufoff) + ldsw + _i * 8192), 16, 0, 0); } while (0)
#define PG8_LDA(dst, b, h) do { _Pragma("unroll") for (int m = 0; m < 4; ++m) _Pragma("unroll") for (int k = 0; k < 2; ++k) dst[m][k] = *(const LAS bf16x8*)(lds + PG8_SA(b, h) + aoff + m * 2048 + k * 1024); } while (0)
#define PG8_LDB(dst, b, h) do { _Pragma("unroll") for (int n = 0; n < 2; ++n) _Pragma("unroll") for (int k = 0; k < 2; ++k) dst[n][k] = *(const LAS bf16x8*)(lds + PG8_SB(b, h) + boff + n * 2048 + k * 1024); } while (0)
#define PG8_MMA(ai, bj, At, Bt) do { __builtin_amdgcn_s_setprio(1); _Pragma("unroll") for (int m = 0; m < 4; ++m) _Pragma("unroll") for (int n = 0; n < 2; ++n) _Pragma("unroll") for (int k = 0; k < 2; ++k) \
        acc[ai][bj][m][n] = __builtin_amdgcn_mfma_f32_16x16x32_bf16(Bt[n][k], At[m][k], acc[ai][bj][m][n], 0, 0, 0); __builtin_amdgcn_s_setprio(0); } while (0)
#define PG8_WAIT_V(n) asm volatile("s_waitcnt vmcnt(" #n ")" ::: "memory")
#define PG8_WAIT_L(n) asm volatile("s_waitcnt lgkmcnt(" #n ")" ::: "memory")
#define PG8_BAR __builtin_amdgcn_s_barrier()
#define PG8_SCHED __builtin_amdgcn_sched_barrier(0)
    Unit cur, nxt; int ui = 0;
    if (!S.next(0, cur)) return;
    f32x4 acc[2][2][4][2];
#pragma unroll
    for (int a = 0; a < 2; ++a)
#pragma unroll
        for (int b = 0; b < 2; ++b)
#pragma unroll
            for (int m = 0; m < 4; ++m)
#pragma unroll
                for (int n = 0; n < 2; ++n) acc[a][b][m][n] = (f32x4){0.f, 0.f, 0.f, 0.f};
    bf16x8 At[4][2], B0[2][2], B1[2][2];
    const char* cA = (const char*)g.A + (size_t)cur.pm * tstepA; const char* cB = (const char*)g.Bt + (size_t)cur.pn * tstepB;
    PG8_STAGE(PG8_SB(0, 0), cB, voffB); PG8_STAGE(PG8_SA(0, 0), cA, voffA); PG8_STAGE(PG8_SB(0, 1), cB + hstepB, voffB); PG8_STAGE(PG8_SA(0, 1), cA + hstepA, voffA);
    if (wr == 1) PG8_BAR;
    PG8_WAIT_V(4); PG8_BAR;
    PG8_STAGE(PG8_SB(1, 0), cB + kstep, voffB); PG8_STAGE(PG8_SA(1, 0), cA + kstep, voffA); PG8_STAGE(PG8_SB(1, 1), cB + hstepB + kstep, voffB);
    PG8_WAIT_V(6); PG8_BAR;
    for (;;) {
        const bool has_next = S.next(ui + 1, nxt);
        const char* nA = has_next ? (const char*)g.A + (size_t)nxt.pm * tstepA : cA; const char* nB = has_next ? (const char*)g.Bt + (size_t)nxt.pn * tstepB : cB;
        for (int t = 0; t < nt; t += 2) {
            const bool last = (t == nt - 2);
            const char* a1 = cA + (size_t)(t + 1) * kstep;
            const char* a2 = last ? nA : cA + (size_t)(t + 2) * kstep; const char* b2 = last ? nB : cB + (size_t)(t + 2) * kstep;
            const char* a3 = a2 + kstep; const char* b3 = b2 + kstep;
            PG8_LDB(B0, 0, 0); PG8_SCHED; PG8_LDA(At, 0, 0); PG8_STAGE(PG8_SA(1, 1), a1 + hstepA, voffA);
            PG8_WAIT_L(8); PG8_BAR; PG8_WAIT_L(0); PG8_MMA(0, 0, At, B0); PG8_BAR; PG8_SCHED;
            PG8_LDB(B1, 0, 1); PG8_STAGE(PG8_SB(0, 0), b2, voffB);
            PG8_BAR; PG8_WAIT_L(0); PG8_MMA(0, 1, At, B1); PG8_BAR;
            PG8_LDA(At, 0, 1); PG8_STAGE(PG8_SA(0, 0), a2, voffA);
            PG8_BAR; PG8_WAIT_L(0); PG8_MMA(1, 0, At, B0); PG8_BAR; PG8_SCHED;
            PG8_STAGE(PG8_SB(0, 1), b2 + hstepB, voffB);
            PG8_WAIT_V(6); PG8_BAR; PG8_MMA(1, 1, At, B1); PG8_BAR;
            PG8_LDB(B0, 1, 0); PG8_SCHED; PG8_LDA(At, 1, 0); PG8_STAGE(PG8_SA(0, 1), a2 + hstepA, voffA);
            PG8_WAIT_L(8); PG8_BAR; PG8_WAIT_L(0); PG8_MMA(0, 0, At, B0); PG8_BAR; PG8_SCHED;
            PG8_LDB(B1, 1, 1); PG8_STAGE(PG8_SB(1, 0), b3, voffB);
            PG8_BAR; PG8_WAIT_L(0); PG8_MMA(0, 1, At, B1); PG8_BAR;
            PG8_LDA(At, 1, 1); PG8_STAGE(PG8_SA(1, 0), a3, voffA);
            PG8_BAR; PG8_WAIT_L(0); PG8_MMA(1, 0, At, B0); PG8_BAR; PG8_SCHED;
            PG8_STAGE(PG8_SB(1, 1), b3 + hstepB, voffB);
            PG8_WAIT_V(6); PG8_BAR; PG8_MMA(1, 1, At, B1); PG8_BAR;
        }
        E(acc, cur, wr, wc, fr, fq);
        if (!has_next) break;
#pragma unroll
        for (int a = 0; a < 2; ++a)
#pragma unroll
            for (int b = 0; b < 2; ++b)
#pragma unroll
                for (int m = 0; m < 4; ++m)
#pragma unroll
                    for (int n = 0; n < 2; ++n) acc[a][b][m][n] = (f32x4){0.f, 0.f, 0.f, 0.f};
        cur = nxt; cA = nA; cB = nB; ++ui;
    }
    PG8_WAIT_V(0);
    if (wr == 0) PG8_BAR;
    PG8_BAR;
#undef PG8_SA
#undef PG8_SB
#undef PG8_STAGE
#undef PG8_LDA
#undef PG8_LDB
#undef PG8_MMA
#undef PG8_WAIT_V
#undef PG8_WAIT_L
#undef PG8_BAR
#undef PG8_SCHED
}
typedef f32x4 Acc[2][2][4][2];

struct EpiSwiglu {
    static constexpr bool PERM = true; bf16_t* O; int ldc;
    DI void operator()(const Acc& acc, const Unit& u, int wr, int wc, int fr, int fq) const {
        const int row0 = u.pm * BM + wr * 64 + fr, col0 = u.pn * 128 + wc * 32 + 8 * fq;
#pragma unroll
        for (int ai = 0; ai < 2; ++ai)
#pragma unroll
            for (int m = 0; m < 4; ++m) {
                bf16_t* rowp = O + (size_t)(row0 + ai * HALF + m * 16) * ldc + col0; float r[8];
#pragma unroll
                for (int n = 0; n < 2; ++n)
#pragma unroll
                    for (int j = 0; j < 4; j += 2) {
                        const f32x2 g2 = {acc[ai][0][m][n][j], acc[ai][0][m][n][j + 1]}, u2 = {acc[ai][1][m][n][j], acc[ai][1][m][n][j + 1]};
                        const f32x2 e2 = g2 * -1.4426950408889634f; f32x2 t; t.x = __builtin_amdgcn_exp2f(e2.x); t.y = __builtin_amdgcn_exp2f(e2.y); t = t + 1.0f;
                        f32x2 rc; rc.x = __builtin_amdgcn_rcpf(t.x); rc.y = __builtin_amdgcn_rcpf(t.y); const f32x2 o = (g2 * u2) * rc;
                        r[n * 4 + j] = o.x; r[n * 4 + j + 1] = o.y; }
                u32x4 w; w.x = cvt_pk_bf16(r[0], r[1]); w.y = cvt_pk_bf16(r[2], r[3]); w.z = cvt_pk_bf16(r[4], r[5]); w.w = cvt_pk_bf16(r[6], r[7]);
                *(u32x4*)rowp = w; }
    }
};
struct EpiResid {
    static constexpr bool PERM = false; const float* X; float* Y; float alpha;
    DI void operator()(const Acc& acc, const Unit& u, int wr, int wc, int fr, int fq) const {
        const int row0 = u.pm * BM + wr * 64 + fr, col0 = u.pn * BM + wc * 32 + 4 * fq;
#pragma unroll
        for (int ai = 0; ai < 2; ++ai)
#pragma unroll
            for (int m = 0; m < 4; ++m) { const size_t off = (size_t)(row0 + ai * HALF + m * 16) * D_ + col0;
#pragma unroll
                for (int bj = 0; bj < 2; ++bj)
#pragma unroll
                    for (int n = 0; n < 2; ++n) { const f32x4 xv = *(const f32x4*)(X + off + bj * HALF + n * 16); *(f32x4*)(Y + off + bj * HALF + n * 16) = xv + alpha * acc[ai][bj][m][n]; }
                asm volatile("" ::: "memory"); }
    }
};
struct EpiBf16 {
    static constexpr bool PERM = true;
    bf16_t* O0; int ld0; int t1; bf16_t* O1; int ld1; int t2; bf16_t* O2; int ld2; float scale;
    DI void operator()(const Acc& acc, const Unit& u, int wr, int wc, int fr, int fq) const {
        bf16_t* base = O0; int ld = ld0, colt = u.pn * BM;
        if (u.pn >= t2) { base = O2; ld = ld2; colt = (u.pn - t2) * BM; } else if (u.pn >= t1) { base = O1; ld = ld1; colt = (u.pn - t1) * BM; }
        const int row0 = u.pm * BM + wr * 64 + fr, col0 = colt + wc * 32 + 8 * fq;
#pragma unroll
        for (int ai = 0; ai < 2; ++ai)
#pragma unroll
            for (int m = 0; m < 4; ++m) { const int row = row0 + ai * HALF + m * 16; bf16_t* rowp = base + (size_t)row * ld + col0;
#pragma unroll
                for (int bj = 0; bj < 2; ++bj) { const f32x4 v0 = acc[ai][bj][m][0] * scale, v1 = acc[ai][bj][m][1] * scale;
                    u32x4 w; w.x = cvt_pk_bf16(v0[0], v0[1]); w.y = cvt_pk_bf16(v0[2], v0[3]); w.z = cvt_pk_bf16(v1[0], v1[1]); w.w = cvt_pk_bf16(v1[2], v1[3]);
                    *(u32x4*)(rowp + bj * HALF) = w; } }
    }
};
struct EpiGate {
    static constexpr bool PERM = true; const bf16_t* YA; const bf16_t* YB; bf16_t* Y;
    DI void operator()(const Acc& acc, const Unit& u, int wr, int wc, int fr, int fq) const {
        const int row0 = u.pm * BM + wr * 64 + fr, col0 = u.pn * 128 + wc * 32 + 8 * fq;
#pragma unroll
        for (int ai = 0; ai < 2; ++ai)
#pragma unroll
            for (int m = 0; m < 4; ++m) { const size_t off = (size_t)(row0 + ai * HALF + m * 16) * D_ + col0;
                const u32x4 a = *(const u32x4*)(YA + off), b = *(const u32x4*)(YB + off); float r[8];
#pragma unroll
                for (int n = 0; n < 2; ++n)
#pragma unroll
                    for (int jj = 0; jj < 2; ++jj) { const unsigned aw = a[n * 2 + jj], bw = b[n * 2 + jj];
                        r[n * 4 + jj * 2] = sigmoidf_(acc[ai][0][m][n][jj * 2]) * bflo(aw) + sigmoidf_(acc[ai][1][m][n][jj * 2]) * bflo(bw);
                        r[n * 4 + jj * 2 + 1] = sigmoidf_(acc[ai][0][m][n][jj * 2 + 1]) * bfhi(aw) + sigmoidf_(acc[ai][1][m][n][jj * 2 + 1]) * bfhi(bw); }
                u32x4 w; w.x = cvt_pk_bf16(r[0], r[1]); w.y = cvt_pk_bf16(r[2], r[3]); w.z = cvt_pk_bf16(r[4], r[5]); w.w = cvt_pk_bf16(r[6], r[7]);
                *(u32x4*)(Y + off) = w;
                asm volatile("" ::: "memory"); }
    }
};
}

struct Params { const float* in[24]; float* out; unsigned char* ws; double invf_rev[16]; int ph_lo, ph_hi; };

DI int conv_col(int n, int mode, bool& second) {
    second = false; int col = n;
    if (mode == 1) { const int t = n >> 8, r = n & 255; col = t * 128 + (r & 127); second = r >= 128; }
    else if (mode == 2) { if (n < 2048) col = n; else if (n < 2720) col = 2064 + (n - 2048); else if (n < 2736) col = 2048 + (n - 2720); else col = -1; }
    else if (mode == 3) { const int t = n >> 8, r = n & 255; col = 2736 + ((r >= 128) ? 1024 : 0) + t * 128 + (r & 127); }
    else if (mode == 4) { col = (n >> 6) * 128 + (n & 63); }
    else if (mode == 5) { col = (n >> 6) * 128 + 64 + (n & 63); }
    return col;
}
DI void conv_w(const float* src0, const float* src1, int ldsrc, bf16_t* dst, int N, int K, int mode, const float* kscale, int gtid, int gstride) {
    const int total = N * (K / 8);
    for (int idx = gtid; idx < total; idx += 2 * gstride) {
        const int idx2 = idx + gstride; const bool has2 = idx2 < total;
        const int nA = idx % N, kA = idx / N, nB = has2 ? idx2 % N : nA, kB = has2 ? idx2 / N : kA;
        bool sA, sB; const int cA = conv_col(nA, mode, sA), cB = conv_col(nB, mode, sB);
        const float* pA = sA ? src1 : src0; const float* pB = sB ? src1 : src0;
        float vA[8], vB[8];
#pragma unroll
        for (int j = 0; j < 8; ++j) { vA[j] = (cA >= 0) ? pA[(size_t)(kA * 8 + j) * ldsrc + cA] : 0.f; vB[j] = (cB >= 0) ? pB[(size_t)(kB * 8 + j) * ldsrc + cB] : 0.f; }
        if (kscale) {
#pragma unroll
            for (int j = 0; j < 8; ++j) { vA[j] *= kscale[kA * 8 + j]; vB[j] *= kscale[kB * 8 + j]; } }
        u32x4 w; w.x = cvt_pk_bf16(vA[0], vA[1]); w.y = cvt_pk_bf16(vA[2], vA[3]); w.z = cvt_pk_bf16(vA[4], vA[5]); w.w = cvt_pk_bf16(vA[6], vA[7]);
        *(u32x4*)(dst + (size_t)nA * K + kA * 8) = w;
        if (has2) { u32x4 w2; w2.x = cvt_pk_bf16(vB[0], vB[1]); w2.y = cvt_pk_bf16(vB[2], vB[3]); w2.z = cvt_pk_bf16(vB[4], vB[5]); w2.w = cvt_pk_bf16(vB[6], vB[7]);
            *(u32x4*)(dst + (size_t)nB * K + kB * 8) = w2; }
    }
}

template <bool F32OUT>
DI void rms_rows(const float* x, const float* w, void* out, const int wv) {
    const int tid_ = otid(wv); const int lane = tid_ & 63, wid = tid_ >> 6;
    f32x4 wv4[4];
#pragma unroll
    for (int i = 0; i < 4; ++i) wv4[i] = *(const f32x4*)(w + i * 256 + lane * 4);
    for (int row = (blockIdx.x * 8 + wid) * 4; row < T_; row += gridDim.x * 32) {
        f32x4 v[4][4]; float ss[4] = {0.f, 0.f, 0.f, 0.f};
#pragma unroll
        for (int rr = 0; rr < 4; ++rr)
#pragma unroll
            for (int i = 0; i < 4; ++i) v[rr][i] = *(const f32x4*)(x + (size_t)(row + rr) * D_ + i * 256 + lane * 4);
#pragma unroll
        for (int rr = 0; rr < 4; ++rr)
#pragma unroll
            for (int i = 0; i < 4; ++i) ss[rr] += v[rr][i][0] * v[rr][i][0] + v[rr][i][1] * v[rr][i][1] + v[rr][i][2] * v[rr][i][2] + v[rr][i][3] * v[rr][i][3];
#pragma unroll
        for (int o = 32; o >= 1; o >>= 1) { ss[0] += lane_xor(ss[0], lane, o); ss[1] += lane_xor(ss[1], lane, o); ss[2] += lane_xor(ss[2], lane, o); ss[3] += lane_xor(ss[3], lane, o); }
#pragma unroll
        for (int rr = 0; rr < 4; ++rr) { const float rstd = rsqrtf(ss[rr] * (1.0f / D_) + EPS_);
#pragma unroll
            for (int i = 0; i < 4; ++i) { const f32x4 y = v[rr][i] * rstd * wv4[i];
                if (F32OUT) *(f32x4*)((float*)out + (size_t)(row + rr) * D_ + i * 256 + lane * 4) = y;
                else { u32x2 pk; pk.x = cvt_pk_bf16(y[0], y[1]); pk.y = cvt_pk_bf16(y[2], y[3]); *(u32x2*)((bf16_t*)out + (size_t)(row + rr) * D_ + i * 256 + lane * 4) = pk; } } }
    }
}

DI void mla_latent_pass(const Params& p, unsigned char* ws, int l, const int wv) {
    const int tid_ = otid(wv); const int lane = tid_ & 63, wid = tid_ >> 6;
    bf16_t* restw = (bf16_t*)(ws + WS_REST); bf16_t* kr = (bf16_t*)(ws + WS_KR); const float* qnw = p.in[13] + l * 384; const float* kvnw = p.in[15] + l * 256;
    const float* cosT = (const float*)(ws + WS_COS); const float* sinT = (const float*)(ws + WS_SIN);
    for (int t0 = (blockIdx.x * 8 + wid) * 2; t0 < T_; t0 += gridDim.x * 16) {
        float cq[2][6], ck[2][4], s1[2] = {0.f, 0.f}, s2[2] = {0.f, 0.f};
#pragma unroll
        for (int rr = 0; rr < 2; ++rr) { const bf16_t* r = restw + (size_t)(t0 + rr) * 768;
#pragma unroll
            for (int i = 0; i < 6; ++i) cq[rr][i] = bf2f(r[i * 64 + lane]);
#pragma unroll
            for (int i = 0; i < 4; ++i) ck[rr][i] = bf2f(r[384 + i * 64 + lane]); }
#pragma unroll
        for (int rr = 0; rr < 2; ++rr) {
#pragma unroll
            for (int i = 0; i < 6; ++i) s1[rr] += cq[rr][i] * cq[rr][i];
#pragma unroll
            for (int i = 0; i < 4; ++i) s2[rr] += ck[rr][i] * ck[rr][i]; }
#pragma unroll
        for (int o = 32; o >= 1; o >>= 1) { s1[0] += lane_xor(s1[0], lane, o); s1[1] += lane_xor(s1[1], lane, o); s2[0] += lane_xor(s2[0], lane, o); s2[1] += lane_xor(s2[1], lane, o); }
#pragma unroll
        for (int rr = 0; rr < 2; ++rr) { const int t = t0 + rr; bf16_t* r = restw + (size_t)t * 768;
            const float r1 = rsqrtf(s1[rr] * (1.0f / 384.f) + EPS_), r2 = rsqrtf(s2[rr] * (1.0f / 256.f) + EPS_);
#pragma unroll
            for (int i = 0; i < 6; ++i) r[i * 64 + lane] = (bf16_t)(cvt_pk_bf16(cq[rr][i] * r1 * qnw[i * 64 + lane], 0.f) & 0xffff);
#pragma unroll
            for (int i = 0; i < 4; ++i) r[384 + i * 64 + lane] = (bf16_t)(cvt_pk_bf16(ck[rr][i] * r2 * kvnw[i * 64 + lane], 0.f) & 0xffff);
            if (lane < 16) { const float x1 = bf2f(r[640 + lane]), x2 = bf2f(r[656 + lane]), c = cosT[(size_t)t * 16 + lane], sn = sinT[(size_t)t * 16 + lane];
                const unsigned w = cvt_pk_bf16(x1 * c - x2 * sn, x2 * c + x1 * sn); kr[(size_t)t * 32 + lane] = (bf16_t)(w & 0xffff); kr[(size_t)t * 32 + 16 + lane] = (bf16_t)(w >> 16); } }
    }
}

constexpr int CP_QS = 0, CP_KS = 17408, CP_KT = 34816, CP_VT = CP_KT + 18432, CP_T = CP_VT + 18432, CP_SM = CP_T + 36864;
DI bf16x8 pack8n(const f32x16& x, int s) {
    u32x4 pk;
    if (s == 0) { pk.x = pk2(x[0], x[1]); pk.y = pk2(x[2], x[3]); pk.z = pk2(x[4], x[5]); pk.w = pk2(x[6], x[7]); }
    else { pk.x = pk2(x[8], x[9]); pk.y = pk2(x[10], x[11]); pk.z = pk2(x[12], x[13]); pk.w = pk2(x[14], x[15]); }
    return __builtin_bit_cast(bf16x8, pk);
}
DI void tri_solve(const LAS float* L, LAS bf16_t* Tu, LAS bf16_t* Tw, int c, const LAS float* bet, const LAS float* gc, bool rev) {
    float Tc[64];
#pragma unroll
    for (int i = 0; i < 64; ++i) {
        float a = (i == c) ? 1.f : 0.f, a1 = 0.f, a2 = 0.f, a3 = 0.f;
#pragma unroll
        for (int j4 = 0; j4 < (i + 3) / 4; ++j4) { const f32x4 lv = *(const LAS f32x4*)(L + i * 64 + j4 * 4);
            if (j4 * 4 + 0 < i) a -= lv[0] * Tc[j4 * 4 + 0];
            if (j4 * 4 + 1 < i) a1 -= lv[1] * Tc[j4 * 4 + 1];
            if (j4 * 4 + 2 < i) a2 -= lv[2] * Tc[j4 * 4 + 2];
            if (j4 * 4 + 3 < i) a3 -= lv[3] * Tc[j4 * 4 + 3]; }
        a = (a + a1) + (a2 + a3);
        asm volatile("" : "+v"(a));
        Tc[i] = a;
    }
    const int col = rev ? 63 - c : c; const float su = bet[col], sw = su * __expf(gc[col]);
#pragma unroll
    for (int i = 0; i < 64; ++i) { const int row = rev ? 63 - i : i; const unsigned w = pk2(Tc[i] * su, Tc[i] * sw);
        Tu[row * 72 + col] = (bf16_t)(w & 0xffff); Tw[row * 72 + col] = (bf16_t)(w >> 16); }
}
DI void gdn_chunk_pre(LAS unsigned char* lds, unsigned char* ws, const float* cw, const float* Alog, const float* dtb, int unit, const int wv) {
    const int b = unit >> 9, n = (unit >> 2) & 127, hh = unit & 3; const size_t t0 = (size_t)b * S_ + (size_t)n * 64;
    const bf16_t* gqkv = (const bf16_t*)(ws + WS_GQKV); const bf16_t* rest = (const bf16_t*)(ws + WS_REST); bf16_t* qh = (bf16_t*)(ws + WS_QH);
    const int tid = otid(wv), wid = tid >> 6, lane = tid & 63, r = lane & 31, h = lane >> 5;
    LAS bf16_t* kT = (LAS bf16_t*)(lds + CP_KT); LAS bf16_t* vT = (LAS bf16_t*)(lds + CP_VT);
    LAS float* sm = (LAS float*)(lds + CP_SM); LAS float* betf = sm; LAS float* betb = sm + 64; LAS float* gcf = sm + 128; LAS float* gcb = sm + 192;
    {
        const int pc = tid & 15, ig = tid >> 4, sp0 = n * 64 + 2 * ig - 2;
#pragma unroll
        for (int part = 0; part < 3; ++part) {
            const int col = part * 512 + hh * 128 + pc * 8;
            f32x4 wt[5][2];
#pragma unroll
            for (int j = 0; j < 5; ++j) { wt[j][0] = *(const f32x4*)(cw + j * 1536 + col); wt[j][1] = *(const f32x4*)(cw + j * 1536 + col + 4); }
            u32x4 rows[6];
#pragma unroll
            for (int rr = 0; rr < 6; ++rr) { const int sp = sp0 + rr; rows[rr] = (sp >= 0 && sp < S_) ? *(const u32x4*)(gqkv + ((size_t)b * S_ + sp) * 1536 + col) : (u32x4){0u, 0u, 0u, 0u}; }
#pragma unroll
            for (int tk = 0; tk < 2; ++tk) {
                float y[8];
#pragma unroll
                for (int e = 0; e < 8; ++e) y[e] = 0.f;
#pragma unroll
                for (int j = 0; j < 5; ++j)
#pragma unroll
                    for (int e = 0; e < 4; ++e) { const unsigned w = rows[tk + j][e]; y[2 * e] += bflo(w) * wt[j][(2 * e) >> 2][(2 * e) & 3]; y[2 * e + 1] += bfhi(w) * wt[j][(2 * e + 1) >> 2][(2 * e + 1) & 3]; }
                float ss = 0.f;
#pragma unroll
                for (int e = 0; e < 8; ++e) { y[e] = siluf_(y[e]); ss += y[e] * y[e]; }
                float sc = 1.f;
                if (part < 2) { ss += lane_xor(ss, lane, 1); ss += lane_xor(ss, lane, 2); ss += lane_xor(ss, lane, 4); ss += lane_xor(ss, lane, 8);
                    sc = rsqrtf(ss + EPS_) * (part == 0 ? 0.08838834764831845f : 1.f); }
                u32x4 o; o.x = pk2(y[0] * sc, y[1] * sc); o.y = pk2(y[2] * sc, y[3] * sc); o.z = pk2(y[4] * sc, y[5] * sc); o.w = pk2(y[6] * sc, y[7] * sc);
                const int i = 2 * ig + tk;
                if (part == 0) { *(LAS u32x4*)(lds + CP_QS + i * 272 + pc * 16) = o; *(u32x4*)(qh + (t0 + i) * 512 + hh * 128 + pc * 8) = o; }
                else { if (part == 1) *(LAS u32x4*)(lds + CP_KS + i * 272 + pc * 16) = o;
                    LAS bf16_t* dstT = (part == 1) ? kT : vT;
#pragma unroll
                    for (int e = 0; e < 4; ++e) { dstT[(pc * 8 + 2 * e) * 72 + i] = (bf16_t)(o[e] & 0xffff); dstT[(pc * 8 + 2 * e + 1) * 72 + i] = (bf16_t)(o[e] >> 16); } }
            }
        }
        if (tid < 128) { const int i = tid & 63, dir = tid >> 6, di = dir * 4 + hh;
            const float bb = bf2f(rest[(t0 + i) * 768 + 672 + di]), aa = bf2f(rest[(t0 + i) * 768 + 680 + di]);
            const float xx = aa + dtb[di]; const float ey = __expf(-fabsf(xx)); const float sp = fmaxf(xx, 0.f) + (ey < 0.01f ? ey * (1.f - ey * (0.5f - ey * 0.33333333f)) : __logf(1.f + ey));
            (dir ? betb : betf)[i] = sigmoidf_(bb); (dir ? gcb : gcf)[i] = -__expf(Alog[di]) * sp; }
    }
    __syncthreads();
    if (wv < 2) {
        LAS float* gp = wv ? gcb : gcf; const int idx = wv ? 63 - lane : lane; float v = gp[idx];
#pragma unroll
        for (int o = 1; o < 64; o <<= 1) { const float t = __int_as_float(__builtin_amdgcn_ds_bpermute((lane - o) << 2, __float_as_int(v))); if (lane >= o) v += t; }
        gp[idx] = v; }
    const int mat = wid >> 2, bi = (wid >> 1) & 1, bj = wid & 1;
    f32x16 acc;
#pragma unroll
    for (int i = 0; i < 16; ++i) acc[i] = 0.f;
#pragma unroll
    for (int ks = 0; ks < 8; ++ks) { const bf16x8 a = *(const LAS bf16x8*)(lds + (mat ? CP_QS : CP_KS) + (32 * bi + r) * 272 + (ks * 16 + 8 * h) * 2);
        const bf16x8 bb = *(const LAS bf16x8*)(lds + CP_KS + (32 * bj + r) * 272 + (ks * 16 + 8 * h) * 2);
        acc = __builtin_amdgcn_mfma_f32_32x32x16_bf16(a, bb, acc, 0, 0, 0); }
    __syncthreads();
    LAS float* Lf = (LAS float*)(lds + CP_QS); LAS float* Lb = Lf + 4096;
    { const int j = 32 * bj + r; const float gfj = gcf[j], gbj = gcb[j];
        bf16_t* inf = (bf16_t*)(ws + WS_IF); bf16_t* inb = (bf16_t*)(ws + WS_IB);
#pragma unroll
        for (int x = 0; x < 16; ++x) { const int i = 32 * bi + (x & 3) + 8 * (x >> 2) + 4 * h; const float v = acc[x];
            const float df = __expf(fminf(gcf[i] - gfj, 0.f)), db = __expf(fminf(gcb[i] - gbj, 0.f));
            if (mat == 0) { Lf[i * 64 + j] = (j < i) ? betf[i] * v * df : 0.f; Lb[(63 - i) * 64 + (63 - j)] = (j > i) ? betb[i] * v * db : 0.f; }
            else { const size_t o = ((t0 + i) * 4 + hh) * 64 + j; inf[o] = (bf16_t)(pk2((j <= i) ? v * df : 0.f, 0.f) & 0xffff); inb[o] = (bf16_t)(pk2((j >= i) ? v * db : 0.f, 0.f) & 0xffff); } } }
    __syncthreads();
    if (wv == 0) tri_solve(Lf, (LAS bf16_t*)(lds + CP_T), (LAS bf16_t*)(lds + CP_T + 9216), lane, betf, gcf, false);
    else if (wv == 1) tri_solve(Lb, (LAS bf16_t*)(lds + CP_T + 18432), (LAS bf16_t*)(lds + CP_T + 27648), lane, betb, gcb, true);
    else if (wv == 2) {
        float* eg = (float*)(ws + WS_EG); float* ek = (float*)(ws + WS_EK); float* etot = (float*)(ws + WS_ETOT);
        const float gtf = gcf[63], gtb = gcb[0];
        eg[(t0 + lane) * 8 + hh] = __expf(gcf[lane]); ek[(t0 + lane) * 8 + hh] = __expf(gtf - gcf[lane]);
        eg[(t0 + lane) * 8 + 4 + hh] = __expf(gcb[lane]); ek[(t0 + lane) * 8 + 4 + hh] = __expf(gtb - gcb[lane]);
        if (lane == 0) { etot[((size_t)b * 128 + n) * 8 + hh] = __expf(gtf); etot[((size_t)b * 128 + n) * 8 + 4 + hh] = __expf(gtb); }
    } else if (wv >= 4) {
        bf16_t* kTg = (bf16_t*)(ws + WS_KT);
        for (int ch = tid - 256; ch < 1024; ch += 256) { const int dk = ch >> 3, pc = ch & 7;
            *(u32x4*)(kTg + ((size_t)(b * 4 + hh) * 128 + dk) * S_ + (size_t)n * 64 + pc * 8) = *(const LAS u32x4*)(lds + CP_KT + dk * 144 + pc * 16); }
    }
    __syncthreads();
    { const int dir = wid >> 2, wq = wid & 3; const LAS unsigned char* Tu = lds + CP_T + dir * 18432; const LAS unsigned char* Tw = Tu + 9216;
        if (wq < 2) { const int tb = wq; bf16_t* uT = (bf16_t*)(ws + (dir ? WS_UB : WS_UF));
#pragma unroll
            for (int nb = 0; nb < 4; ++nb) { f32x16 c;
#pragma unroll
                for (int i = 0; i < 16; ++i) c[i] = 0.f;
#pragma unroll
                for (int s = 0; s < 4; ++s) { const bf16x8 a = *(const LAS bf16x8*)(Tu + (32 * tb + r) * 144 + (16 * s + 8 * h) * 2);
                    const bf16x8 bb = *(const LAS bf16x8*)(lds + CP_VT + (32 * nb + r) * 144 + (16 * s + 8 * h) * 2);
                    c = __builtin_amdgcn_mfma_f32_32x32x16_bf16(a, bb, c, 0, 0, 0); }
                bf16_t* dst = uT + ((size_t)(b * 4 + hh) * 128 + 32 * nb + r) * S_ + (size_t)n * 64 + 32 * tb + 4 * h;
#pragma unroll
                for (int g4 = 0; g4 < 4; ++g4) { u32x2 w; w.x = pk2(c[4 * g4], c[4 * g4 + 1]); w.y = pk2(c[4 * g4 + 2], c[4 * g4 + 3]); *(u32x2*)(dst + 8 * g4) = w; } }
        } else { const int ib = wq - 2; bf16_t* wd = (bf16_t*)(ws + (dir ? WS_WB : WS_WF));
#pragma unroll
            for (int kb = 0; kb < 4; ++kb) { f32x16 c;
#pragma unroll
                for (int i = 0; i < 16; ++i) c[i] = 0.f;
#pragma unroll
                for (int s = 0; s < 4; ++s) { const bf16x8 a = *(const LAS bf16x8*)(lds + CP_KT + (32 * kb + r) * 144 + (16 * s + 8 * h) * 2);
                    const bf16x8 bb = *(const LAS bf16x8*)(Tw + (32 * ib + r) * 144 + (16 * s + 8 * h) * 2);
                    c = __builtin_amdgcn_mfma_f32_32x32x16_bf16(a, bb, c, 0, 0, 0); }
                bf16_t* dst = wd + (t0 + 32 * ib + r) * 512 + hh * 128 + 32 * kb + 4 * h;
#pragma unroll
                for (int g4 = 0; g4 < 4; ++g4) { u32x2 w; w.x = pk2(c[4 * g4], c[4 * g4 + 1]); w.y = pk2(c[4 * g4 + 2], c[4 * g4 + 3]); *(u32x2*)(dst + 8 * g4) = w; } }
        } }
    __syncthreads();
}

constexpr int SC_W = 0, SC_Q = 16896, SC_KT = 33792, SC_IN = SC_KT + 17408, SC_EG = SC_IN + 8704, SC_BUF = SC_EG + 528;
DI void gdn_scan(LAS unsigned char* lds, unsigned char* ws, int chain, const int wv) {
    const int b = chain >> 3, hh = (chain >> 1) & 3, dir = chain & 1;
    const bf16_t* wg = (const bf16_t*)(ws + (dir ? WS_WB : WS_WF)); const bf16_t* qg = (const bf16_t*)(ws + WS_QH); const bf16_t* kTg = (const bf16_t*)(ws + WS_KT);
    const bf16_t* ing = (const bf16_t*)(ws + (dir ? WS_IB : WS_IF)); const bf16_t* uTg = (const bf16_t*)(ws + (dir ? WS_UB : WS_UF));
    const float* egg = (const float*)(ws + WS_EG); const float* ekg = (const float*)(ws + WS_EK); const float* etg = (const float*)(ws + WS_ETOT);
    bf16_t* out = (bf16_t*)(ws + (dir ? WS_OB : WS_OF));
    const int tid = otid(wv), wid = tid >> 6, lane = tid & 63, r = lane & 31, h = lane >> 5;
    const int di = dir * 4 + hh;
    if (wv >= 4) {
        const int lt = tid - 256;
        for (int c = -1; c < 127; ++c) {
            const int n = dir ? 127 - (c + 1) : (c + 1); const size_t t0 = (size_t)b * S_ + (size_t)n * 64;
            LAS unsigned char* buf = lds + ((c + 1) & 1) * SC_BUF;
            u32x4 rw[4], rq[4], rk[4], ri[2];
#pragma unroll
            for (int k = 0; k < 4; ++k) { const int ch = lt + k * 256, i = ch >> 4, pc = ch & 15; const size_t src = (t0 + i) * 512 + hh * 128 + pc * 8; rw[k] = *(const u32x4*)(wg + src); rq[k] = *(const u32x4*)(qg + src); }
#pragma unroll
            for (int k = 0; k < 4; ++k) { const int ch = lt + k * 256, dk = ch >> 3, pc = ch & 7; rk[k] = *(const u32x4*)(kTg + ((size_t)(b * 4 + hh) * 128 + dk) * S_ + (size_t)n * 64 + pc * 8); }
#pragma unroll
            for (int k = 0; k < 2; ++k) { const int ch = lt + k * 256, i = ch >> 3, pc = ch & 7; ri[k] = *(const u32x4*)(ing + ((t0 + i) * 4 + hh) * 64 + pc * 8); }
            float ev = 0.f;
            if (lt < 64) ev = egg[(t0 + lt) * 8 + di]; else if (lt < 128) ev = ekg[(t0 + lt - 64) * 8 + di]; else if (lt == 128) ev = etg[((size_t)b * 128 + n) * 8 + di];
#pragma unroll
            for (int k = 0; k < 4; ++k) { const int ch = lt + k * 256, i = ch >> 4, pc = ch & 15;
                *(LAS u32x2*)(buf + SC_W + i * 264 + pc * 16) = (u32x2){rw[k].x, rw[k].y}; *(LAS u32x2*)(buf + SC_W + i * 264 + pc * 16 + 8) = (u32x2){rw[k].z, rw[k].w};
                *(LAS u32x2*)(buf + SC_Q + i * 264 + pc * 16) = (u32x2){rq[k].x, rq[k].y}; *(LAS u32x2*)(buf + SC_Q + i * 264 + pc * 16 + 8) = (u32x2){rq[k].z, rq[k].w}; }
#pragma unroll
            for (int k = 0; k < 4; ++k) { const int ch = lt + k * 256, dk = ch >> 3, pc = ch & 7;
                *(LAS u32x2*)(buf + SC_KT + dk * 136 + pc * 16) = (u32x2){rk[k].x, rk[k].y}; *(LAS u32x2*)(buf + SC_KT + dk * 136 + pc * 16 + 8) = (u32x2){rk[k].z, rk[k].w}; }
#pragma unroll
            for (int k = 0; k < 2; ++k) { const int ch = lt + k * 256, i = ch >> 3, pc = ch & 7;
                *(LAS u32x2*)(buf + SC_IN + i * 136 + pc * 16) = (u32x2){ri[k].x, ri[k].y}; *(LAS u32x2*)(buf + SC_IN + i * 136 + pc * 16 + 8) = (u32x2){ri[k].z, ri[k].w}; }
            if (lt <= 128) *(LAS float*)(buf + SC_EG + lt * 4) = ev;
            __syncthreads();
        }
        __syncthreads();
    } else {
        const int nb = wid;
        f32x16 Sa[4];
#pragma unroll
        for (int kb = 0; kb < 4; ++kb)
#pragma unroll
            for (int i = 0; i < 16; ++i) Sa[kb][i] = 0.f;
        __syncthreads();
        for (int c = 0; c < 128; ++c) {
            const int n = dir ? 127 - c : c; const size_t t0 = (size_t)b * S_ + (size_t)n * 64;
            const LAS unsigned char* buf = lds + (c & 1) * SC_BUF;
            u32x2 ur[2][4];
            { const bf16_t* up = uTg + ((size_t)(b * 4 + hh) * 128 + 32 * nb + r) * S_ + (size_t)n * 64 + 4 * h;
#pragma unroll
                for (int tb = 0; tb < 2; ++tb)
#pragma unroll
                    for (int g4 = 0; g4 < 4; ++g4) ur[tb][g4] = *(const u32x2*)(up + 32 * tb + 8 * g4); }
            bf16x8 Sb[4][2];
#pragma unroll
            for (int kb = 0; kb < 4; ++kb) { Sb[kb][0] = pack8n(Sa[kb], 0); Sb[kb][1] = pack8n(Sa[kb], 1); }
            f32x16 X[2], Y[2];
#pragma unroll
            for (int i = 0; i < 16; ++i) { X[0][i] = 0.f; X[1][i] = 0.f; Y[0][i] = 0.f; Y[1][i] = 0.f; }
#pragma unroll
            for (int kb = 0; kb < 4; ++kb)
#pragma unroll
                for (int s = 0; s < 2; ++s)
#pragma unroll
                    for (int tb = 0; tb < 2; ++tb) { const int off = (32 * tb + r) * 264 + (32 * kb + 16 * s + 4 * h) * 2;
                        const s16x4 w0 = *(const LAS s16x4*)(buf + SC_W + off), w1 = *(const LAS s16x4*)(buf + SC_W + off + 16);
                        const s16x4 q0 = *(const LAS s16x4*)(buf + SC_Q + off), q1 = *(const LAS s16x4*)(buf + SC_Q + off + 16);
                        X[tb] = __builtin_amdgcn_mfma_f32_32x32x16_bf16(__builtin_shufflevector(w0, w1, 0, 1, 2, 3, 4, 5, 6, 7), Sb[kb][s], X[tb], 0, 0, 0);
                        Y[tb] = __builtin_amdgcn_mfma_f32_32x32x16_bf16(__builtin_shufflevector(q0, q1, 0, 1, 2, 3, 4, 5, 6, 7), Sb[kb][s], Y[tb], 0, 0, 0); }
            f32x16 vn[2];
#pragma unroll
            for (int tb = 0; tb < 2; ++tb)
#pragma unroll
                for (int g4 = 0; g4 < 4; ++g4) { const u32x2 uu = ur[tb][g4];
                    vn[tb][4 * g4] = bflo(uu.x) - X[tb][4 * g4]; vn[tb][4 * g4 + 1] = bfhi(uu.x) - X[tb][4 * g4 + 1];
                    vn[tb][4 * g4 + 2] = bflo(uu.y) - X[tb][4 * g4 + 2]; vn[tb][4 * g4 + 3] = bfhi(uu.y) - X[tb][4 * g4 + 3]; }
            bf16x8 vb[2][2];
#pragma unroll
            for (int tb = 0; tb < 2; ++tb) { vb[tb][0] = pack8n(vn[tb], 0); vb[tb][1] = pack8n(vn[tb], 1); }
#pragma unroll
            for (int tb = 0; tb < 2; ++tb)
#pragma unroll
                for (int g4 = 0; g4 < 4; ++g4) { const f32x4 e4 = *(const LAS f32x4*)(buf + SC_EG + (32 * tb + 8 * g4 + 4 * h) * 4);
#pragma unroll
                    for (int e = 0; e < 4; ++e) Y[tb][4 * g4 + e] *= e4[e]; }
#pragma unroll
            for (int tb = 0; tb < 2; ++tb)
#pragma unroll
                for (int t2 = 0; t2 < 2; ++t2)
#pragma unroll
                    for (int s = 0; s < 2; ++s) { const int off = (32 * tb + r) * 136 + (32 * t2 + 16 * s + 4 * h) * 2;
                        const s16x4 a0 = *(const LAS s16x4*)(buf + SC_IN + off), a1 = *(const LAS s16x4*)(buf + SC_IN + off + 16);
                        Y[tb] = __builtin_amdgcn_mfma_f32_32x32x16_bf16(__builtin_shufflevector(a0, a1, 0, 1, 2, 3, 4, 5, 6, 7), vb[t2][s], Y[tb], 0, 0, 0); }
#pragma unroll
            for (int tb = 0; tb < 2; ++tb)
#pragma unroll
                for (int g4 = 0; g4 < 4; ++g4) { const f32x4 e4 = *(const LAS f32x4*)(buf + SC_EG + 256 + (32 * tb + 8 * g4 + 4 * h) * 4);
#pragma unroll
                    for (int e = 0; e < 4; ++e) vn[tb][4 * g4 + e] *= e4[e]; }
#pragma unroll
            for (int tb = 0; tb < 2; ++tb) { vb[tb][0] = pack8n(vn[tb], 0); vb[tb][1] = pack8n(vn[tb], 1); }
            const float et = *(const LAS float*)(buf + SC_EG + 512);
#pragma unroll
            for (int kb = 0; kb < 4; ++kb) {
#pragma unroll
                for (int i = 0; i < 16; ++i) Sa[kb][i] *= et;
#pragma unroll
                for (int tb = 0; tb < 2; ++tb)
#pragma unroll
                    for (int s = 0; s < 2; ++s) { const int off = (32 * kb + r) * 136 + (32 * tb + 16 * s + 4 * h) * 2;
                        const s16x4 a0 = *(const LAS s16x4*)(buf + SC_KT + off), a1 = *(const LAS s16x4*)(buf + SC_KT + off + 16);
                        Sa[kb] = __builtin_amdgcn_mfma_f32_32x32x16_bf16(__builtin_shufflevector(a0, a1, 0, 1, 2, 3, 4, 5, 6, 7), vb[tb][s], Sa[kb], 0, 0, 0); } }
#pragma unroll
            for (int tb = 0; tb < 2; ++tb)
#pragma unroll
                for (int x = 0; x < 16; ++x) { const int i = 32 * tb + (x & 3) + 8 * (x >> 2) + 4 * h;
                    out[(t0 + i) * 512 + hh * 128 + 32 * nb + r] = (bf16_t)(pk2(Y[tb][x], 0.f) & 0xffff); }
            __syncthreads();
        }
    }
}

DI bf16x8 pack8(const f32x16& x, int s) {
    u32x4 pk;
    if (s == 0) asm volatile("v_cvt_pk_bf16_f32 %0, %4, %5\n\tv_cvt_pk_bf16_f32 %1, %6, %7\n\tv_cvt_pk_bf16_f32 %2, %8, %9\n\tv_cvt_pk_bf16_f32 %3, %10, %11\n\ts_nop 1"
               : "=&v"(pk[0]), "=&v"(pk[1]), "=&v"(pk[2]), "=&v"(pk[3]) : "v"(x[0]), "v"(x[1]), "v"(x[2]), "v"(x[3]), "v"(x[4]), "v"(x[5]), "v"(x[6]), "v"(x[7]));
    else asm volatile("v_cvt_pk_bf16_f32 %0, %4, %5\n\tv_cvt_pk_bf16_f32 %1, %6, %7\n\tv_cvt_pk_bf16_f32 %2, %8, %9\n\tv_cvt_pk_bf16_f32 %3, %10, %11\n\ts_nop 1"
               : "=&v"(pk[0]), "=&v"(pk[1]), "=&v"(pk[2]), "=&v"(pk[3]) : "v"(x[8]), "v"(x[9]), "v"(x[10]), "v"(x[11]), "v"(x[12]), "v"(x[13]), "v"(x[14]), "v"(x[15]));
    return __builtin_bit_cast(bf16x8, pk);
}
constexpr int AT_KROW = 208, AT_VROW = 136, AT_KBYTES = 64 * AT_KROW, AT_BUF = AT_KBYTES + 64 * AT_VROW;
DI void attn_tile(const LAS unsigned char* kcur, const LAS unsigned char* vcur, const bf16x8 (&bq)[2][6], f32x16 (&oT)[2][2],
                  float (&mrun)[2], float (&lrun)[2], int lane, int r, int hf, int kh) {
    f32x16 sT[2];
#pragma unroll
    for (int i = 0; i < 16; ++i) { sT[0][i] = 0.f; sT[1][i] = 0.f; }
#pragma unroll
    for (int ks = 0; ks < 6; ++ks) { const bf16x8 a = *(const LAS bf16x8*)(kcur + (kh * 32 + r) * AT_KROW + (ks * 16 + 8 * hf) * 2);
        sT[0] = __builtin_amdgcn_mfma_f32_32x32x16_bf16(a, bq[0][ks], sT[0], 0, 0, 0);
        sT[1] = __builtin_amdgcn_mfma_f32_32x32x16_bf16(a, bq[1][ks], sT[1], 0, 0, 0); }
#pragma unroll
    for (int qb = 0; qb < 2; ++qb) {
        float mx = sT[qb][0];
#pragma unroll
        for (int i = 1; i < 16; ++i) mx = fmaxf(mx, sT[qb][i]);
        mx = fmaxf(mx, lane_xor(mx, lane, 32));
        if (__builtin_amdgcn_ballot_w64(mx > mrun[qb] + 8.0f) != 0ull) {
            const float mnew = fmaxf(mrun[qb], mx), alpha = __builtin_amdgcn_exp2f(mrun[qb] - mnew); mrun[qb] = mnew; lrun[qb] *= alpha;
#pragma unroll
            for (int i = 0; i < 16; ++i) { oT[qb][0][i] *= alpha; oT[qb][1][i] *= alpha; }
        }
        float rs = 0.f;
#pragma unroll
        for (int i = 0; i < 16; ++i) { sT[qb][i] = __builtin_amdgcn_exp2f(sT[qb][i] - mrun[qb]); rs += sT[qb][i]; }
        lrun[qb] += rs;
    }
#pragma unroll
    for (int s = 0; s < 2; ++s) { const bf16x8 bp0 = pack8n(sT[0], s), bp1 = pack8n(sT[1], s);
#pragma unroll
        for (int dvb = 0; dvb < 2; ++dvb) { const LAS unsigned char* va = vcur + (dvb * 32 + r) * AT_VROW + (kh * 32 + 16 * s + 4 * hf) * 2;
            const s16x4 lo = *(const LAS s16x4*)va, hi = *(const LAS s16x4*)(va + 16); const bf16x8 a = __builtin_shufflevector(lo, hi, 0, 1, 2, 3, 4, 5, 6, 7);
            oT[0][dvb] = __builtin_amdgcn_mfma_f32_32x32x16_bf16(a, bp0, oT[0][dvb], 0, 0, 0);
            oT[1][dvb] = __builtin_amdgcn_mfma_f32_32x32x16_bf16(a, bp1, oT[1][dvb], 0, 0, 0); } }
}
constexpr int AT_XCH = 45056;
DI void attn_unit(LAS unsigned char* lds, const bf16_t* Q, const bf16_t* Kn, const bf16_t* Kr, const bf16_t* Vt, bf16_t* O, const float* cosT, const float* sinT, int b, int hh, int qblk, const int wv) {
    const int tid = otid(wv), wid = tid >> 6, lane = tid & 63, r = lane & 31, hf = lane >> 5, g = wv & 3, kh = wv >> 2;
    const size_t q0 = (size_t)b * S_ + (size_t)qblk * 256 + g * 64;
    const int kc0 = tid, kc1 = tid + 512; const bool has1 = tid < 256;
    const int key0 = kc0 / 12, part0 = kc0 % 12, key1 = has1 ? kc1 / 12 : 0, part1 = has1 ? kc1 % 12 : 0;
    const bf16_t* ks0 = (part0 < 8) ? Kn + ((size_t)b * S_ + key0) * 512 + hh * 64 + part0 * 8 : Kr + ((size_t)b * S_ + key0) * 32 + (part0 - 8) * 8;
    const bf16_t* ks1 = (part1 < 8) ? Kn + ((size_t)b * S_ + key1) * 512 + hh * 64 + part1 * 8 : Kr + ((size_t)b * S_ + key1) * 32 + (part1 - 8) * 8;
    const size_t kst0 = (part0 < 8) ? 512 : 32, kst1 = (part1 < 8) ? 512 : 32;
    const int kd0 = key0 * AT_KROW + part0 * 16, kd1 = key1 * AT_KROW + part1 * 16;
    const int vdv = tid >> 3, vpart = tid & 7;
    const bf16_t* vsrc = Vt + (size_t)(hh * 64 + vdv) * T_ + (size_t)b * S_ + vpart * 8;
    const int vd = AT_KBYTES + vdv * AT_VROW + vpart * 16;
    u32x4 kr0, kr1 = (u32x4){0, 0, 0, 0}, vr;
    kr0 = *(const u32x4*)ks0; if (has1) kr1 = *(const u32x4*)ks1; vr = *(const u32x4*)vsrc;
    bf16x8 bq[2][6];
#pragma unroll
    for (int qb = 0; qb < 2; ++qb) {
#pragma unroll
        for (int ks = 0; ks < 6; ++ks) bq[qb][ks] = *(const bf16x8*)(Q + (q0 + qb * 32 + r) * 768 + hh * 96 + ks * 16 + 8 * hf);
        const float* cp = cosT + (q0 + qb * 32 + r) * 16 + 8 * hf; const float* sp = sinT + (q0 + qb * 32 + r) * 16 + 8 * hf;
        const f32x4 c0 = *(const f32x4*)cp, c1 = *(const f32x4*)(cp + 4), s0 = *(const f32x4*)sp, s1 = *(const f32x4*)(sp + 4);
        const u32x4 x1 = __builtin_bit_cast(u32x4, bq[qb][4]), x2 = __builtin_bit_cast(u32x4, bq[qb][5]); u32x4 y1, y2;
#pragma unroll
        for (int e = 0; e < 4; ++e) { const float a0 = bflo(x1[e]), a1 = bfhi(x1[e]), b0 = bflo(x2[e]), b1 = bfhi(x2[e]);
            const float cc0 = e < 2 ? c0[2 * e] : c1[2 * e - 4], cc1 = e < 2 ? c0[2 * e + 1] : c1[2 * e - 3], ss0 = e < 2 ? s0[2 * e] : s1[2 * e - 4], ss1 = e < 2 ? s0[2 * e + 1] : s1[2 * e - 3];
            y1[e] = pk2(a0 * cc0 - b0 * ss0, a1 * cc1 - b1 * ss1); y2[e] = pk2(b0 * cc0 + a0 * ss0, b1 * cc1 + a1 * ss1); }
        bq[qb][4] = __builtin_bit_cast(bf16x8, y1); bq[qb][5] = __builtin_bit_cast(bf16x8, y2); }
    f32x16 oT[2][2];
#pragma unroll
    for (int i = 0; i < 16; ++i) { oT[0][0][i] = 0.f; oT[0][1][i] = 0.f; oT[1][0][i] = 0.f; oT[1][1][i] = 0.f; }
    float mrun[2] = {-1e30f, -1e30f}, lrun[2] = {0.f, 0.f};
    *(LAS u32x4*)(lds + kd0) = kr0; if (has1) *(LAS u32x4*)(lds + kd1) = kr1;
    *(LAS u32x2*)(lds + vd) = (u32x2){vr.x, vr.y}; *(LAS u32x2*)(lds + vd + 8) = (u32x2){vr.z, vr.w};
    __syncthreads();
    for (int t = 0; t < 128; ++t) {
        const LAS unsigned char* kb_ = lds + (t & 1) * AT_BUF;
        if (t + 1 < 128) { const size_t ko = (size_t)(t + 1) * 64; kr0 = *(const u32x4*)(ks0 + ko * kst0); if (has1) kr1 = *(const u32x4*)(ks1 + ko * kst1); vr = *(const u32x4*)(vsrc + ko); }
        attn_tile(kb_, kb_ + AT_KBYTES, bq, oT, mrun, lrun, lane, r, hf, kh);
        if (t + 1 < 128) { LAS unsigned char* nb = lds + ((t + 1) & 1) * AT_BUF;
            *(LAS u32x4*)(nb + kd0) = kr0; if (has1) *(LAS u32x4*)(nb + kd1) = kr1;
            *(LAS u32x2*)(nb + vd) = (u32x2){vr.x, vr.y}; *(LAS u32x2*)(nb + vd + 8) = (u32x2){vr.z, vr.w}; }
        __syncthreads();
    }
    LAS float* xw = (LAS float*)(lds + AT_XCH) + g * (68 * 64) + lane;
    if (kh == 1) {
#pragma unroll
        for (int qb = 0; qb < 2; ++qb) { xw[(64 + qb) * 64] = mrun[qb]; xw[(64 + 2 + qb) * 64 - 128 + 128] = lrun[qb];
#pragma unroll
            for (int dvb = 0; dvb < 2; ++dvb)
#pragma unroll
                for (int i = 0; i < 16; ++i) xw[((qb * 2 + dvb) * 16 + i) * 64] = oT[qb][dvb][i]; }
    }
    __syncthreads();
    if (kh == 0) {
#pragma unroll
        for (int qb = 0; qb < 2; ++qb) { const float m1 = xw[(64 + qb) * 64], l1 = xw[(66 + qb) * 64 - 128 + 128];
            const float m = fmaxf(mrun[qb], m1), a0 = __builtin_amdgcn_exp2f(mrun[qb] - m), a1 = __builtin_amdgcn_exp2f(m1 - m);
            float l = lrun[qb] * a0 + l1 * a1; l += lane_xor(l, lane, 32); const float inv = 1.0f / l, f0 = a0 * inv, f1 = a1 * inv;
#pragma unroll
            for (int dvb = 0; dvb < 2; ++dvb)
#pragma unroll
                for (int g4 = 0; g4 < 4; ++g4) { float o[4];
#pragma unroll
                    for (int e = 0; e < 4; ++e) o[e] = oT[qb][dvb][4 * g4 + e] * f0 + xw[((qb * 2 + dvb) * 16 + 4 * g4 + e) * 64] * f1;
                    u32x2 w; w.x = pk2(o[0], o[1]); w.y = pk2(o[2], o[3]);
                    *(u32x2*)(O + (q0 + qb * 32 + r) * 512 + hh * 64 + dvb * 32 + 8 * g4 + 4 * hf) = w; } }
    }
}

DI void gdn_gate_norm(const Params& p, unsigned char* ws, int l, const int wv) {
    const bf16_t* of = (const bf16_t*)(ws + WS_OF); const bf16_t* ob = (const bf16_t*)(ws + WS_OB); const bf16_t* z = (const bf16_t*)(ws + WS_Z);
    bf16_t* ag = (bf16_t*)(ws + WS_AG); const float* nw = p.in[11] + l * 128;
    const int tid_ = otid(wv); const int lane = tid_ & 63, wid = tid_ >> 6;
    const f32x4 n0 = *(const f32x4*)(nw + (lane & 15) * 8), n1 = *(const f32x4*)(nw + (lane & 15) * 8 + 4);
    for (int t = (blockIdx.x * 8 + wid) * 2; t < T_; t += gridDim.x * 16) {
        u32x4 a[2], b[2], zz[2];
#pragma unroll
        for (int rr = 0; rr < 2; ++rr) { const size_t o = (size_t)(t + rr) * 512 + lane * 8; a[rr] = *(const u32x4*)(of + o); b[rr] = *(const u32x4*)(ob + o); zz[rr] = *(const u32x4*)(z + o); }
#pragma unroll
        for (int rr = 0; rr < 2; ++rr) { float v[8]; float ss = 0.f;
#pragma unroll
            for (int e = 0; e < 4; ++e) { v[2 * e] = bflo(a[rr][e]) + bflo(b[rr][e]); v[2 * e + 1] = bfhi(a[rr][e]) + bfhi(b[rr][e]); ss += v[2 * e] * v[2 * e] + v[2 * e + 1] * v[2 * e + 1]; }
            ss += lane_xor(ss, lane, 1); ss += lane_xor(ss, lane, 2); ss += lane_xor(ss, lane, 4); ss += lane_xor(ss, lane, 8);
            const float rstd = rsqrtf(ss * (1.0f / 128.f) + EPS_); u32x4 w;
#pragma unroll
            for (int e = 0; e < 4; ++e) { const float w0 = (2 * e < 4) ? n0[2 * e] : n1[2 * e - 4], w1 = (2 * e + 1 < 4) ? n0[2 * e + 1] : n1[2 * e - 3];
                w[e] = pk2(v[2 * e] * rstd * w0 * siluf_(bflo(zz[rr][e])), v[2 * e + 1] * rstd * w1 * siluf_(bfhi(zz[rr][e]))); }
            *(u32x4*)(ag + (size_t)(t + rr) * 512 + lane * 8) = w; }
    }
}

#define XB_TMO      128
#define XB_XCNT(j)  (256  + 64 * (j))
#define XB_XSUB(j)  (1280 + 64 * (j))
#define XB_XGEN(j)  (2304 + 64 * (j))
#define XB_TOP      3328
#define XB_TOPGEN   3392
#define XCD_BAR_WORDS 3456
#define XB_SPIN_CAP (1u << 18)
DI unsigned xb_ld(unsigned* p)              { return __hip_atomic_load(p, __ATOMIC_RELAXED, __HIP_MEMORY_SCOPE_AGENT); }
DI unsigned xb_add(unsigned* p, unsigned v) { return __hip_atomic_fetch_add(p, v, __ATOMIC_RELAXED, __HIP_MEMORY_SCOPE_AGENT); }
DI unsigned xb_xcc_id() { return (unsigned)__builtin_amdgcn_s_getreg((3 << 11) | 20) & 0xFu; }
#define XB_SPIN(cond, bar) do { unsigned _sp = 0; while (cond) { __builtin_amdgcn_s_sleep(1); \
    if ((++_sp & 255u) == 0u) { if (xb_ld(&(bar)[XB_TMO])) break; if (_sp > XB_SPIN_CAP) { atomicAdd(&(bar)[XB_TMO], 1u); break; } } } } while (0)
DI void xcd_barrier_complete(unsigned* bar, unsigned x, unsigned G, unsigned& nloc, unsigned& nx) {
    unsigned sum, cnt, mine, sp = 0u;
    for (;;) {
        sum = 0u; cnt = 0u; mine = 0u;
#pragma unroll
        for (unsigned j = 0; j < 16; ++j) { const unsigned c = xb_ld(&bar[XB_XCNT(j)]); sum += c; cnt += (c > 0u) ? 1u : 0u; mine = (j == x) ? c : mine; }
        if (sum == G) break;
        __builtin_amdgcn_s_sleep(1);
        if ((++sp & 255u) == 0u) { if (xb_ld(&bar[XB_TMO])) break; if (sp > XB_SPIN_CAP) { atomicAdd(&bar[XB_TMO], 1u); break; } }
    }
    nloc = mine > 0u ? mine : 1u; nx = cnt > 0u ? cnt : 1u;
}
DI void xcd_barrier(unsigned* bar, volatile LAS unsigned* st, unsigned G, const int wv) {
    asm volatile("s_waitcnt vmcnt(0)" ::: "memory");
    __syncthreads();
    if (otid(wv) == 0) {
        const unsigned x = xb_xcc_id();
        __builtin_amdgcn_s_waitcnt(0);
        unsigned nloc = st[0], nx = st[1];
        if (nloc == 0u) { xcd_barrier_complete(bar, x, G, nloc, nx); st[0] = nloc; st[1] = nx; }
        const unsigned old = xb_add(&bar[XB_XSUB(x)], 1u);
        const unsigned gen = old / nloc;
        if (old + 1u == (gen + 1u) * nloc) {
            __builtin_amdgcn_fence(__ATOMIC_RELEASE, "agent");
            asm volatile("s_waitcnt vmcnt(0)" ::: "memory");
            const unsigned og = xb_add(&bar[XB_TOP], 1u);
            const unsigned tg = og / nx;
            if (og + 1u == (tg + 1u) * nx) xb_add(&bar[XB_TOPGEN], 1u);
            else XB_SPIN(xb_ld(&bar[XB_TOPGEN]) == tg, bar);
            __builtin_amdgcn_fence(__ATOMIC_ACQUIRE, "agent");
            xb_add(&bar[XB_XGEN(x)], 1u);
            asm volatile("s_waitcnt vmcnt(0)" ::: "memory");
        } else {
            XB_SPIN(xb_ld(&bar[XB_XGEN(x)]) == gen, bar);
            __builtin_amdgcn_fence(__ATOMIC_ACQUIRE, "agent");
            asm volatile("s_waitcnt vmcnt(0)" ::: "memory");
        }
    }
    __syncthreads();
}

__global__ void __launch_bounds__(512, 2) mega(Params p) {
    extern __shared__ __attribute__((aligned(16))) unsigned char shm[];
    LAS unsigned char* lds = (LAS unsigned char*)shm;
    const int wv = __builtin_amdgcn_readfirstlane(threadIdx.x >> 6);
    volatile LAS unsigned* xst = (volatile LAS unsigned*)(lds + 131072);
    if (threadIdx.x < 2) xst[threadIdx.x] = 0u;
    __syncthreads();
    if (threadIdx.x == 0) (void)xb_add((unsigned*)(p.ws + WS_BAR) + XB_XCNT(xb_xcc_id()), 1u);
    const int ph_lo = __builtin_amdgcn_readfirstlane(p.ph_lo), ph_hi = __builtin_amdgcn_readfirstlane(p.ph_hi);
    for (int ph = ph_lo; ph < ph_hi; ++ph) {
        size_t zoff = 0; int G = gridDim.x, bid = blockIdx.x;
        asm volatile("" : "+s"(zoff), "+s"(G), "+s"(bid));
        unsigned char* ws = p.ws + zoff;
        const int gstride = G * 512;
        if (ph == 0) {
            const int gtid = bid * 512 + otid(wv);
            if (bid == 0 && gtid < 16) *((unsigned*)(ws + WS_CTR) + gtid * 64) = 0u;
            const int* pos = (const int*)p.in[1]; float* cosT = (float*)(ws + WS_COS); float* sinT = (float*)(ws + WS_SIN);
            for (int idx = gtid; idx < T_ * 16; idx += gstride) { const int t = idx >> 4, i = idx & 15;
                const double rev = (double)pos[t] * p.invf_rev[i]; const float fr = (float)(rev - rint(rev));
                cosT[idx] = __builtin_amdgcn_cosf(fr); sinT[idx] = __builtin_amdgcn_sinf(fr); }
        } else if (ph == NPH_ - 1) {
            rms_rows<true>(p.out, p.in[23], p.out, wv);
        } else {
            const int l = (ph - 1) / NS_, sl = (ph - 1) % NS_, st = (PROBE_ST >= 0 && sl > PROBE_ST) ? sl - 1 : sl;
            const bool ffn2 = st >= 12; const int fs = ffn2 ? st - 12 : st;
            const float* xin = (l == 0 && st < 3) ? p.in[0] : p.out;
            if ((st < 3 || ffn2)) {
                const int ig = ffn2 ? 20 : 3, iu = ffn2 ? 21 : 4, idn = ffn2 ? 22 : 5, inw = ffn2 ? 19 : 2;
                if (fs == 0 && EN(0)) {
                    const int gtid = bid * 512 + otid(wv);
                    rms_rows<false>(xin, p.in[inw] + (size_t)l * D_, ws + WS_H, wv);
                    conv_w(p.in[ig] + (size_t)l * D_ * FF_, p.in[iu] + (size_t)l * D_ * FF_, FF_, (bf16_t*)(ws + W_GU), 5632, 1024, 1, nullptr, gtid, gstride);
                    conv_w(p.in[idn] + (size_t)l * D_ * FF_, nullptr, D_, (bf16_t*)(ws + W_D), 1024, FF_, 0, nullptr, gtid, gstride);
                } else if (fs == 1 && EN(1)) {
                    pg8::Gemm g{(const bf16_t*)(ws + WS_H), (const bf16_t*)(ws + W_GU), T_, 5632, 1024, 1024, 1024}; pg8::StaticOrder S; S.init(T_, 5632, G, bid);
                    pg8::EpiSwiglu E{(bf16_t*)(ws + WS_BIG), FF_}; pg8::gemm_phase(lds, g, S, E, wv);
                } else if (EN(2)) {
                    pg8::Gemm g{(const bf16_t*)(ws + WS_BIG), (const bf16_t*)(ws + W_D), T_, 1024, FF_, FF_, FF_}; pg8::StaticOrder S; S.init(T_, 1024, G, bid);
                    pg8::EpiResid E{xin, p.out, 0.5f}; pg8::gemm_phase(lds, g, S, E, wv);
                }
            } else if (st == 3 && EN(3)) {
                const int gtid = bid * 512 + otid(wv);
                rms_rows<false>(p.out, p.in[6] + (size_t)l * D_, ws + WS_H, wv);
                const float* win = p.in[7] + (size_t)l * D_ * 4784;
                conv_w(win, nullptr, 4784, (bf16_t*)(ws + W_IN), 2816, 1024, 2, nullptr, gtid, gstride);
                conv_w(win, nullptr, 4784, (bf16_t*)(ws + W_G), 2048, 1024, 3, nullptr, gtid, gstride);
                conv_w(p.in[12] + (size_t)l * 512 * 1024, nullptr, 1024, (bf16_t*)(ws + W_PA), 1024, 512, 0, nullptr, gtid, gstride);
                conv_w(p.in[17] + (size_t)l * 512 * 1024, nullptr, 1024, (bf16_t*)(ws + W_PB), 1024, 512, 0, nullptr, gtid, gstride);
                conv_w(p.in[18] + (size_t)l * 1024 * 1024, nullptr, 1024, (bf16_t*)(ws + W_OUT), 1024, 1024, 0, nullptr, gtid, gstride);
                conv_w(p.in[14] + (size_t)l * 384 * 768, nullptr, 768, (bf16_t*)(ws + W_UQ), 768, 384, 0, nullptr, gtid, gstride);
                conv_w(p.in[16] + (size_t)l * 256 * 1024, nullptr, 1024, (bf16_t*)(ws + W_UK), 512, 256, 4, nullptr, gtid, gstride);
                conv_w(p.in[16] + (size_t)l * 256 * 1024, nullptr, 1024, (bf16_t*)(ws + W_UV), 512, 256, 5, nullptr, gtid, gstride);
            } else if (st == 4 && EN(4)) {
                pg8::Gemm g{(const bf16_t*)(ws + WS_H), (const bf16_t*)(ws + W_IN), T_, 2816, 1024, 1024, 1024}; pg8::StaticOrder S; S.init(T_, 2816, G, bid);
                pg8::EpiBf16 E{(bf16_t*)(ws + WS_GQKV), 1536, 6, (bf16_t*)(ws + WS_Z), 512, 8, (bf16_t*)(ws + WS_REST), 768, 1.0f};
                pg8::gemm_phase(lds, g, S, E, wv);
            } else if (st == 5 && EN(5)) {
                const float* cw = p.in[8] + (size_t)l * 5 * 1536;
                for (int u = bid; u < 2048; u += G) gdn_chunk_pre(lds, ws, cw, p.in[9] + l * 8, p.in[10] + l * 8, u, wv);
                mla_latent_pass(p, ws, l, wv);
            } else if (st == 6 && EN(6)) {
                const bf16_t* rest = (const bf16_t*)(ws + WS_REST);
                if (EN(16)) { pg8::Gemm g{rest, (const bf16_t*)(ws + W_UQ), T_, 768, 384, 768, 384}; pg8::StaticOrder S; S.init(T_, 768, G, bid);
                  pg8::EpiBf16 E{(bf16_t*)(ws + WS_Q), 768, 1000, nullptr, 0, 1000, nullptr, 0, 0.10206207261596575f * 1.4426950408889634f};
                  pg8::gemm_phase(lds, g, S, E, wv); }
                if (EN(17)) { pg8::Gemm g{rest + 384, (const bf16_t*)(ws + W_UK), T_, 512, 256, 768, 256}; pg8::StaticOrder S; S.init(T_, 512, G, bid);
                  pg8::EpiBf16 E{(bf16_t*)(ws + WS_KN), 512, 1000, nullptr, 0, 1000, nullptr, 0, 1.0f};
                  pg8::gemm_phase(lds, g, S, E, wv); }
                if (EN(18)) { pg8::Gemm g{(const bf16_t*)(ws + W_UV), rest + 384, 512, T_, 256, 256, 768}; pg8::StaticOrder S; S.init(512, T_, G, bid);
                  pg8::EpiBf16 E{(bf16_t*)(ws + WS_VT), T_, 1000, nullptr, 0, 1000, nullptr, 0, 1.0f};
                  pg8::gemm_phase(lds, g, S, E, wv); }
            } else if (st == 7 && EN(7)) {
                if (bid < 32) gdn_scan(lds, ws, bid, wv);
                const bf16_t* Q = (const bf16_t*)(ws + WS_Q); const bf16_t* Kn = (const bf16_t*)(ws + WS_KN); const bf16_t* Kr = (const bf16_t*)(ws + WS_KR);
                const bf16_t* Vt = (const bf16_t*)(ws + WS_VT); bf16_t* AO = (bf16_t*)(ws + WS_AO);
                if (G == 256) { const int xcd = bid & 7; unsigned* ctr = (unsigned*)(ws + WS_CTR) + (l * 8 + xcd) * 64;
                    const bool t0 = otid(wv) == 0; unsigned nxt = 0u; if (t0) nxt = atomicAdd(ctr, 1u);
                    for (;;) { __syncthreads(); if (t0) *(LAS unsigned*)(lds + 131072 + 32) = nxt; __syncthreads();
                        const unsigned u = *(const LAS unsigned*)(lds + 131072 + 32); if (u >= 128u) break;
                        if (t0) nxt = atomicAdd(ctr, 1u);
                        const int pair = (int)(u >> 5) * 8 + xcd; attn_unit(lds, Q, Kn, Kr, Vt, AO, (const float*)(ws + WS_COS), (const float*)(ws + WS_SIN), pair >> 3, pair & 7, (int)(u & 31), wv); } }
                else for (int u = bid; u < 1024; u += G) { const int pair = u >> 5; attn_unit(lds, Q, Kn, Kr, Vt, AO, (const float*)(ws + WS_COS), (const float*)(ws + WS_SIN), pair >> 3, pair & 7, u & 31, wv); }
            } else if (st == 8 && EN(8)) {
                gdn_gate_norm(p, ws, l, wv);
                rms_rows<false>(p.out, p.in[6] + (size_t)l * D_, ws + WS_H2, wv);
            } else if (st == 9 && EN(9)) {
                { pg8::Gemm g{(const bf16_t*)(ws + WS_AG), (const bf16_t*)(ws + W_PA), T_, 1024, 512, 512, 512}; pg8::StaticOrder S; S.init(T_, 1024, G, bid);
                  pg8::EpiBf16 E{(bf16_t*)(ws + WS_YA), 1024, 1000, nullptr, 0, 1000, nullptr, 0, 1.0f}; pg8::gemm_phase(lds, g, S, E, wv); }
                { pg8::Gemm g{(const bf16_t*)(ws + WS_AO), (const bf16_t*)(ws + W_PB), T_, 1024, 512, 512, 512}; pg8::StaticOrder S; S.init(T_, 1024, G, bid);
                  pg8::EpiBf16 E{(bf16_t*)(ws + WS_YB), 1024, 1000, nullptr, 0, 1000, nullptr, 0, 1.0f}; pg8::gemm_phase(lds, g, S, E, wv); }
            } else if (st == 10 && EN(10)) {
                pg8::Gemm g{(const bf16_t*)(ws + WS_H2), (const bf16_t*)(ws + W_G), T_, 2048, 1024, 1024, 1024}; pg8::StaticOrder S; S.init(T_, 2048, G, bid);
                pg8::EpiGate E{(const bf16_t*)(ws + WS_YA), (const bf16_t*)(ws + WS_YB), (bf16_t*)(ws + WS_Y)}; pg8::gemm_phase(lds, g, S, E, wv);
            } else if (st == 11 && EN(11)) {
                pg8::Gemm g{(const bf16_t*)(ws + WS_Y), (const bf16_t*)(ws + W_OUT), T_, 1024, 1024, 1024, 1024}; pg8::StaticOrder S; S.init(T_, 1024, G, bid);
                pg8::EpiResid E{p.out, p.out, 1.0f}; pg8::gemm_phase(lds, g, S, E, wv);
            }
        }
        if (ph + 1 < ph_hi) {
            if (ph == ph_lo) cg::this_grid().sync(); else xcd_barrier((unsigned*)(ws + WS_BAR), xst, (unsigned)G, wv);
            for (int e = 0; e < PROBE_SYNC; ++e) xcd_barrier((unsigned*)(ws + WS_BAR), xst, (unsigned)G, wv); }
    }
}

extern "C" void kernel_launch(void* const* d_in, const int* in_sizes, int n_in, void* d_out, int out_size, void* d_ws, size_t ws_size, hipStream_t stream) {
    static int grid = 0;
    if (grid == 0) {
        if (ws_size < WS_END) { fprintf(stderr, "kernel_launch: workspace too small: %zu < %zu\n", ws_size, (size_t)WS_END); grid = -1; return; }
        int dev = 0, cus = 0;
        hipGetDevice(&dev); hipDeviceGetAttribute(&cus, hipDeviceAttributeMultiprocessorCount, dev);
        if (hipFuncSetAttribute((const void*)mega, hipFuncAttributeMaxDynamicSharedMemorySize, LDS_BYTES) != hipSuccess) { fprintf(stderr, "hipFuncSetAttribute failed\n"); grid = -1; return; }
        int per_cu = 0;
        if (hipOccupancyMaxActiveBlocksPerMultiprocessor(&per_cu, (const void*)mega, 512, LDS_BYTES) != hipSuccess || per_cu < 1) { fprintf(stderr, "occupancy query: %d\n", per_cu); per_cu = 1; }
        (void)hipGetLastError();
        grid = cus;
    }
    if (grid < 0) return;
    Params p{};
    for (int i = 0; i < 24; ++i) p.in[i] = (const float*)d_in[i];
    p.out = (float*)d_out; p.ws = (unsigned char*)d_ws;
    for (int i = 0; i < 16; ++i) p.invf_rev[i] = pow(10000.0, -(double)i / 16.0) / 6.283185307179586476925286766559;
#if COOP
    (void)hipMemsetAsync((unsigned char*)d_ws + WS_BAR, 0, 3456 * 4, stream);
    p.ph_lo = 0; p.ph_hi = NPH_;
    void* args[] = {&p};
    hipError_t e = hipLaunchCooperativeKernel((const void*)mega, dim3(grid), dim3(512), args, LDS_BYTES, stream);
    if (e != hipSuccess) fprintf(stderr, "cooperative launch failed: %s\n", hipGetErrorString(e));
#else
    for (int ph = 0; ph < NPH_; ++ph) { p.ph_lo = ph; p.ph_hi = ph + 1; hipLaunchKernelGGL(mega, dim3(grid), dim3(512), LDS_BYTES, stream, p); }
#endif
}
```

```cpp
#include <hip/hip_runtime.h>
#include <hip/hip_cooperative_groups.h>
#include <cstdio>
#include <cmath>
namespace cg = cooperative_groups;

#ifndef COOP
#define COOP 1
#endif
#ifndef PHMASK
#define PHMASK 0xffffffffu
#endif
#define EN(k) ((PHMASK >> (k)) & 1u)
#ifndef PROBE_ST
#define PROBE_ST (-1)
#endif
constexpr int NS_ = 15 + (PROBE_ST >= 0 ? 1 : 0), NPH_ = 2 + 2 * NS_;
#ifndef PROBE_SYNC
#define PROBE_SYNC 0
#endif

#define LAS __attribute__((address_space(3)))
#define DI __device__ __forceinline__
typedef unsigned short bf16_t;
typedef short bf16x8 __attribute__((ext_vector_type(8)));
typedef short s16x4 __attribute__((ext_vector_type(4)));
typedef float f32x4 __attribute__((ext_vector_type(4)));
typedef float f32x16 __attribute__((ext_vector_type(16)));
typedef unsigned u32x4 __attribute__((ext_vector_type(4)));
typedef unsigned u32x2 __attribute__((ext_vector_type(2)));

constexpr int T_ = 32768, S_ = 8192, NB_ = 4, D_ = 1024, FF_ = 2816;
constexpr int LDS_BYTES = 131072 + 64;
constexpr float EPS_ = 1e-6f;
constexpr size_t MiB = 1u << 20;
constexpr size_t WS_W = 0;
constexpr size_t W_GU = WS_W, W_D = WS_W + 11 * MiB;
constexpr size_t W_IN = WS_W, W_G = WS_W + 5632 * 1024, W_PA = WS_W + 9728 * 1024, W_PB = W_PA + MiB, W_OUT = W_PB + MiB,
                 W_UQ = W_OUT + 2 * MiB, W_UK = W_UQ + MiB, W_UV = W_UK + 256 * 1024;
constexpr size_t WS_H = 20 * MiB;
constexpr size_t WS_KT = 20 * MiB, WS_OF = 52 * MiB;
constexpr size_t WS_BIG = 84 * MiB;
constexpr size_t WS_GQKV = WS_BIG, WS_Z = WS_BIG + 96 * MiB, WS_REST = WS_BIG + 128 * MiB;
constexpr size_t WS_KN = 84 * MiB, WS_VT = 116 * MiB, WS_OB = 148 * MiB;
constexpr size_t WS_H2 = 84 * MiB;
constexpr size_t WS_AO = 212 * MiB;
constexpr size_t WS_X2 = 260 * MiB;
constexpr size_t WS_QH = 260 * MiB, WS_WF = 292 * MiB, WS_WB = 324 * MiB;
constexpr size_t WS_UF = 356 * MiB, WS_UB = 388 * MiB;
constexpr size_t WS_IF = 420 * MiB, WS_IB = 436 * MiB;
constexpr size_t WS_Q = 452 * MiB;
constexpr size_t WS_BETA = 500 * MiB, WS_G = 501 * MiB, WS_KR = 502 * MiB, WS_COS = 504 * MiB, WS_SIN = 506 * MiB,
                 WS_EG = 508 * MiB, WS_EK = 509 * MiB, WS_ETOT = 510 * MiB, WS_CTR = 510 * MiB + 512 * 1024;
constexpr size_t WS_AG = 420 * MiB;
constexpr size_t WS_YA = 260 * MiB, WS_YB = 324 * MiB, WS_Y = 388 * MiB;
constexpr size_t WS_BAR = 510 * MiB + 768 * 1024;
constexpr size_t WS_END = 511 * MiB;

typedef __bf16 bf16v2 __attribute__((ext_vector_type(2)));
typedef float f32x2 __attribute__((ext_vector_type(2)));
DI unsigned pk2(float lo, float hi) { return __builtin_bit_cast(unsigned, __builtin_convertvector((f32x2){lo, hi}, bf16v2)); }
DI unsigned cvt_pk_bf16(float lo, float hi) { unsigned r; asm volatile("v_cvt_pk_bf16_f32 %0, %1, %2" : "=v"(r) : "v"(lo), "v"(hi)); return r; }
DI float bf2f(bf16_t b) { return __uint_as_float(((unsigned)b) << 16); }
DI float bflo(unsigned w) { return __uint_as_float(w << 16); }
DI float bfhi(unsigned w) { return __uint_as_float(w & 0xffff0000u); }
DI float sigmoidf_(float x) { return __builtin_amdgcn_rcpf(1.0f + __expf(-x)); }
DI float siluf_(float x) { return x * sigmoidf_(x); }
DI int otid(int wv) { int z; asm volatile("s_mov_b32 %0, 0" : "=s"(z)); return wv * 64 + (int)__builtin_amdgcn_mbcnt_hi(~0u, __builtin_amdgcn_mbcnt_lo(~0u, (unsigned)z)); }
DI float lane_xor(float v, int lane, int o) { return __int_as_float(__builtin_amdgcn_ds_bpermute((lane ^ o) << 2, __float_as_int(v))); }
DI float wave_sum(float v, int lane) {
#pragma unroll
    for (int o = 32; o >= 1; o >>= 1) v += lane_xor(v, lane, o);
    return v; }

namespace pg8 {
constexpr int BM = 256, BK = 64, HALF = 128, HTB = HALF * BK * 2, NXCD = 8, WGM = 8;
DI int lds_byte(int r, int c) { const int st = (r >> 4) * 2 + (c >> 5), rr = r & 15, cc = c & 31, ob = rr * 64 + cc * 2; return st * 1024 + (ob ^ (((ob >> 9) & 1) << 5)); }
DI void stage_rc(int b, int& R, int& C) { const int st = b / 1024, sb = b % 1024, swz = sb ^ (((sb >> 9) & 1) << 5); R = (st >> 1) * 16 + swz / 64; C = (st & 1) * 32 + (swz % 64) / 2; }
DI int perm32(int rho) { const int n = rho >> 4, i = rho & 15; return 8 * (i >> 2) + 4 * n + (i & 3); }
struct Unit { int pm, pn; };
struct Gemm { const bf16_t* A; const bf16_t* Bt; int M, N, K, lda, ldb; };
struct StaticOrder {
    int nM, nN, nwg, G, c;
    DI void init(int M, int N, int G_, int c_) { nM = M / BM; nN = N / BM; nwg = nM * nN; G = G_; c = c_; }
    DI bool next(int i, Unit& u) const {
        const long L = (long)i * G + c; if (L >= nwg) return false;
        int wgid = (int)L; { const int q = nwg / NXCD, r = nwg % NXCD, xcd = wgid % NXCD, off = wgid / NXCD; wgid = (xcd < r ? xcd * (q + 1) : r * (q + 1) + (xcd - r) * q) + off; }
        const int nig = WGM * nN, gid = wgid / nig, fm = gid * WGM, gsz = (nM - fm) < WGM ? (nM - fm) : WGM;
        u.pm = fm + ((wgid % nig) % gsz); u.pn = (wgid % nig) / gsz; return true;
    }
};
template <class Epi>
DI void gemm_phase(LAS unsigned char* lds, const Gemm g, const StaticOrder& S, const Epi& E, const int wv) {
    const int tid = otid(wv), wid = __builtin_amdgcn_readfirstlane(tid >> 6), lane = tid & 63, wr = wid >> 2, wc = wid & 3, fr = lane & 15, fq = lane >> 4;
    const int K = g.K, nt = K / BK;
    unsigned voffA[2], voffB[2];
#pragma unroll
    for (int i = 0; i < 2; ++i) { int R, C; stage_rc(tid * 16 + i * 8192, R, C); const int Rb = Epi::PERM ? ((R & ~31) + perm32(R & 31)) : R;
        voffA[i] = (unsigned)(R * g.lda + C) * 2u; voffB[i] = (unsigned)(Rb * g.ldb + C) * 2u; }
    const size_t kstep = (size_t)(BK * 2);
    const size_t hstepA = (size_t)HALF * g.lda * 2, hstepB = (size_t)HALF * g.ldb * 2;
    const size_t tstepA = 2 * hstepA, tstepB = 2 * hstepB;
    const unsigned ldsw = (unsigned)wid * 1024u;
    const int aoff = lds_byte(wr * 64 + fr, fq * 8), boff = lds_byte(wc * 32 + fr, fq * 8);
#define PG8_SA(b, h) (((b) * 2 + (h)) * HTB)
#define PG8_SB(b, h) ((4 + (b) * 2 + (h)) * HTB)
#define PG8_STAGE(bufoff, gbase, voff) do { _Pragma("unroll") for (int _i = 0; _i < 2; ++_i) \
        __builtin_amdgcn_global_load_lds((const unsigned*)((const char*)(gbase) + (voff)[_i]), (LAS unsigned*)(lds + (bufoff) + ldsw + _i * 8192), 16, 0, 0); } while (0)
#define PG8_LDA(dst, b, h) do { _Pragma("unroll") for (int m = 0; m < 4; ++m) _Pragma("unroll") for (int k = 0; k < 2; ++k) dst[m][k] = *(const LAS bf16x8*)(lds + PG8_SA(b, h) + aoff + m * 2048 + k * 1024); } while (0)
#define PG8_LDB(dst, b, h) do { _Pragma("unroll") for (int n = 0; n < 2; ++n) _Pragma("unroll") for (int k = 0; k < 2; ++k) dst[n][k] = *(const LAS bf16x8*)(lds + PG8_SB(b, h) + boff + n * 2048 + k * 1024); } while (0)
#define PG8_MMA(ai, bj, At, Bt) do { __builtin_amdgcn_s_setprio(1); _Pragma("unroll") for (int m = 0; m < 4; ++m) _Pragma("unroll") for (int n = 0; n < 2; ++n) _Pragma("unroll") for (int k = 0; k < 2; ++k) \
        acc[ai][bj][m][n] = __builtin_amdgcn_mfma_f32_16x16x32_bf16(Bt[n][k], At[m][k], acc[ai][bj][m][n], 0, 0, 0); __builtin_amdgcn_s_setprio(0); } while (0)
#define PG8_WAIT_V(n) asm volatile("s_waitcnt vmcnt(" #n ")" ::: "memory")
#define PG8_WAIT_L(n) asm volatile("s_waitcnt lgkmcnt(" #n ")" ::: "memory")
#define PG8_BAR __builtin_amdgcn_s_barrier()
#define PG8_SCHED __builtin_amdgcn_sched_barrier(0)
    Unit cur, nxt; int ui = 0;
    if (!S.next(0, cur)) return;
    f32x4 acc[2][2][4][2];
#pragma unroll
    for (int a = 0; a < 2; ++a)
#pragma unroll
        for (int b = 0; b < 2; ++b)
#pragma unroll
            for (int m = 0; m < 4; ++m)
#pragma unroll
                for (int n = 0; n < 2; ++n) acc[a][b][m][n] = (f32x4){0.f, 0.f, 0.f, 0.f};
    bf16x8 At[4][2], B0[2][2], B1[2][2];
    const char* cA = (const char*)g.A + (size_t)cur.pm * tstepA; const char* cB = (const char*)g.Bt + (size_t)cur.pn * tstepB;
    PG8_STAGE(PG8_SB(0, 0), cB, voffB); PG8_STAGE(PG8_SA(0, 0), cA, voffA); PG8_STAGE(PG8_SB(0, 1), cB + hstepB, voffB); PG8_STAGE(PG8_SA(0, 1), cA + hstepA, voffA);
    if (wr == 1) PG8_BAR;
    PG8_WAIT_V(4); PG8_BAR;
    PG8_STAGE(PG8_SB(1, 0), cB + kstep, voffB); PG8_STAGE(PG8_SA(1, 0), cA + kstep, voffA); PG8_STAGE(PG8_SB(1, 1), cB + hstepB + kstep, voffB);
    PG8_WAIT_V(6); PG8_BAR;
    for (;;) {
        const bool has_next = S.next(ui + 1, nxt);
        const char* nA = has_next ? (const char*)g.A + (size_t)nxt.pm * tstepA : cA; const char* nB = has_next ? (const char*)g.Bt + (size_t)nxt.pn * tstepB : cB;
        for (int t = 0; t < nt; t += 2) {
            const bool last = (t == nt - 2);
            const char* a1 = cA + (size_t)(t + 1) * kstep;
            const char* a2 = last ? nA : cA + (size_t)(t + 2) * kstep; const char* b2 = last ? nB : cB + (size_t)(t + 2) * kstep;
            const char* a3 = a2 + kstep; const char* b3 = b2 + kstep;
            PG8_LDB(B0, 0, 0); PG8_SCHED; PG8_LDA(At, 0, 0); PG8_STAGE(PG8_SA(1, 1), a1 + hstepA, voffA);
            PG8_WAIT_L(8); PG8_BAR; PG8_WAIT_L(0); PG8_MMA(0, 0, At, B0); PG8_BAR; PG8_SCHED;
            PG8_LDB(B1, 0, 1); PG8_STAGE(PG8_SB(0, 0), b2, voffB);
            PG8_BAR; PG8_WAIT_L(0); PG8_MMA(0, 1, At, B1); PG8_BAR;
            PG8_LDA(At, 0, 1); PG8_STAGE(PG8_SA(0, 0), a2, voffA);
            PG8_BAR; PG8_WAIT_L(0); PG8_MMA(1, 0, At, B0); PG8_BAR; PG8_SCHED;
            PG8_STAGE(PG8_SB(0, 1), b2 + hstepB, voffB);
            PG8_WAIT_V(6); PG8_BAR; PG8_MMA(1, 1, At, B1); PG8_BAR;
            PG8_LDB(B0, 1, 0); PG8_SCHED; PG8_LDA(At, 1, 0); PG8_STAGE(PG8_SA(0, 1), a2 + hstepA, voffA);
            PG8_WAIT_L(8); PG8_BAR; PG8_WAIT_L(0); PG8_MMA(0, 0, At, B0); PG8_BAR; PG8_SCHED;
            PG8_LDB(B1, 1, 1); PG8_STAGE(PG8_SB(1, 0), b3, voffB);
            PG8_BAR; PG8_WAIT_L(0); PG8_MMA(0, 1, At, B1); PG8_BAR;
            PG8_LDA(At, 1, 1); PG8_STAGE(PG8_SA(1, 0), a3, voffA);
            PG8_BAR; PG8_WAIT_L(0); PG8_MMA(1, 0, At, B0); PG8_BAR; PG8_SCHED;
            PG8_STAGE(PG8_SB(1, 1), b3 + hstepB, voffB);
            PG8_WAIT_V(6); PG8_BAR; PG8_MMA(1, 1, At, B1); PG8_BAR;
        }
        E(acc, cur, wr, wc, fr, fq);
        if (!has_next) break;
#pragma unroll
        for (int a = 0; a < 2; ++a)
#pragma unroll
            for (int b = 0; b < 2; ++b)
#pragma unroll
                for (int m = 0; m < 4; ++m)
#pragma unroll
                    for (int n = 0; n < 2; ++n) acc[a][b][m][n] = (f32x4){0.f, 0.f, 0.f, 0.f};
        cur = nxt; cA = nA; cB = nB; ++ui;
    }
    PG8_WAIT_V(0);
    if (wr == 0) PG8_BAR;
    PG8_BAR;
#undef PG8_SA
#undef PG8_SB
#undef PG8_STAGE
#undef PG8_LDA
#undef PG8_LDB
#undef PG8_MMA
#undef PG8_WAIT_V
#undef PG8_WAIT_L
#undef PG8_BAR
#undef PG8_SCHED
}
typedef f32x4 Acc[2][2][4][2];

struct EpiSwiglu {
    static constexpr bool PERM = true; bf16_t* O; int ldc;
    DI void operator()(const Acc& acc, const Unit& u, int wr, int wc, int fr, int fq) const {
        const int row0 = u.pm * BM + wr * 64 + fr, col0 = u.pn * 128 + wc * 32 + 8 * fq;
#pragma unroll
        for (int ai = 0; ai < 2; ++ai)
#pragma unroll
            for (int m = 0; m < 4; ++m) {
                bf16_t* rowp = O + (size_t)(row0 + ai * HALF + m * 16) * ldc + col0; float r[8];
#pragma unroll
                for (int n = 0; n < 2; ++n)
#pragma unroll
                    for (int j = 0; j < 4; j += 2) {
                        const f32x2 g2 = {acc[ai][0][m][n][j], acc[ai][0][m][n][j + 1]}, u2 = {acc[ai][1][m][n][j], acc[ai][1][m][n][j + 1]};
                        const f32x2 e2 = g2 * -1.4426950408889634f; f32x2 t; t.x = __builtin_amdgcn_exp2f(e2.x); t.y = __builtin_amdgcn_exp2f(e2.y); t = t + 1.0f;
                        f32x2 rc; rc.x = __builtin_amdgcn_rcpf(t.x); rc.y = __builtin_amdgcn_rcpf(t.y); const f32x2 o = (g2 * u2) * rc;
                        r[n * 4 + j] = o.x; r[n * 4 + j + 1] = o.y; }
                u32x4 w; w.x = cvt_pk_bf16(r[0], r[1]); w.y = cvt_pk_bf16(r[2], r[3]); w.z = cvt_pk_bf16(r[4], r[5]); w.w = cvt_pk_bf16(r[6], r[7]);
                *(u32x4*)rowp = w; }
    }
};
struct EpiResid {
    static constexpr bool PERM = false; const float* X; float* Y; float alpha;
    DI void operator()(const Acc& acc, const Unit& u, int wr, int wc, int fr, int fq) const {
        const int row0 = u.pm * BM + wr * 64 + fr, col0 = u.pn * BM + wc * 32 + 4 * fq;
#pragma unroll
        for (int ai = 0; ai < 2; ++ai)
#pragma unroll
            for (int m = 0; m < 4; ++m) { const size_t off = (size_t)(row0 + ai * HALF + m * 16) * D_ + col0;
#pragma unroll
                for (int bj = 0; bj < 2; ++bj)
#pragma unroll
                    for (int n = 0; n < 2; ++n) { const f32x4 xv = *(const f32x4*)(X + off + bj * HALF + n * 16); *(f32x4*)(Y + off + bj * HALF + n * 16) = xv + alpha * acc[ai][bj][m][n]; }
                asm volatile("" ::: "memory"); }
    }
};
struct EpiBf16 {
    static constexpr bool PERM = true;
    bf16_t* O0; int ld0; int t1; bf16_t* O1; int ld1; int t2; bf16_t* O2; int ld2; float scale;
    DI void operator()(const Acc& acc, const Unit& u, int wr, int wc, int fr, int fq) const {
        bf16_t* base = O0; int ld = ld0, colt = u.pn * BM;
        if (u.pn >= t2) { base = O2; ld = ld2; colt = (u.pn - t2) * BM; } else if (u.pn >= t1) { base = O1; ld = ld1; colt = (u.pn - t1) * BM; }
        const int row0 = u.pm * BM + wr * 64 + fr, col0 = colt + wc * 32 + 8 * fq;
#pragma unroll
        for (int ai = 0; ai < 2; ++ai)
#pragma unroll
            for (int m = 0; m < 4; ++m) { const int row = row0 + ai * HALF + m * 16; bf16_t* rowp = base + (size_t)row * ld + col0;
#pragma unroll
                for (int bj = 0; bj < 2; ++bj) { const f32x4 v0 = acc[ai][bj][m][0] * scale, v1 = acc[ai][bj][m][1] * scale;
                    u32x4 w; w.x = cvt_pk_bf16(v0[0], v0[1]); w.y = cvt_pk_bf16(v0[2], v0[3]); w.z = cvt_pk_bf16(v1[0], v1[1]); w.w = cvt_pk_bf16(v1[2], v1[3]);
                    *(u32x4*)(rowp + bj * HALF) = w; } }
    }
};
struct EpiGate {
    static constexpr bool PERM = true; const bf16_t* YA; const bf16_t* YB; bf16_t* Y;
    DI void operator()(const Acc& acc, const Unit& u, int wr, int wc, int fr, int fq) const {
        const int row0 = u.pm * BM + wr * 64 + fr, col0 = u.pn * 128 + wc * 32 + 8 * fq;
#pragma unroll
        for (int ai = 0; ai < 2; ++ai)
#pragma unroll
            for (int m = 0; m < 4; ++m) { const size_t off = (size_t)(row0 + ai * HALF + m * 16) * D_ + col0;
                const u32x4 a = *(const u32x4*)(YA + off), b = *(const u32x4*)(YB + off); float r[8];
#pragma unroll
                for (int n = 0; n < 2; ++n)
#pragma unroll
                    for (int jj = 0; jj < 2; ++jj) { const unsigned aw = a[n * 2 + jj], bw = b[n * 2 + jj];
                        const f32x2 ga = {acc[ai][0][m][n][jj * 2], acc[ai][0][m][n][jj * 2 + 1]}, gb = {acc[ai][1][m][n][jj * 2], acc[ai][1][m][n][jj * 2 + 1]};
                        const f32x2 ea = ga * -1.4426950408889634f, eb = gb * -1.4426950408889634f; f32x2 ta, tb;
                        ta.x = __builtin_amdgcn_exp2f(ea.x); ta.y = __builtin_amdgcn_exp2f(ea.y); tb.x = __builtin_amdgcn_exp2f(eb.x); tb.y = __builtin_amdgcn_exp2f(eb.y);
                        ta = ta + 1.0f; tb = tb + 1.0f; f32x2 ra, rb; ra.x = __builtin_amdgcn_rcpf(ta.x); ra.y = __builtin_amdgcn_rcpf(ta.y); rb.x = __builtin_amdgcn_rcpf(tb.x); rb.y = __builtin_amdgcn_rcpf(tb.y);
                        const f32x2 ya = {bflo(aw), bfhi(aw)}, yb = {bflo(bw), bfhi(bw)}; const f32x2 o = ra * ya + rb * yb;
                        r[n * 4 + jj * 2] = o.x; r[n * 4 + jj * 2 + 1] = o.y; }
                u32x4 w; w.x = cvt_pk_bf16(r[0], r[1]); w.y = cvt_pk_bf16(r[2], r[3]); w.z = cvt_pk_bf16(r[4], r[5]); w.w = cvt_pk_bf16(r[6], r[7]);
                *(u32x4*)(Y + off) = w;
                asm volatile("" ::: "memory"); }
    }
};
}

struct Params { const float* in[24]; float* out; unsigned char* ws; double invf_rev[16]; int ph_lo, ph_hi; };

DI int conv_col(int n, int mode, bool& second) {
    second = false; int col = n;
    if (mode == 1) { const int t = n >> 8, r = n & 255; col = t * 128 + (r & 127); second = r >= 128; }
    else if (mode == 2) { if (n < 2048) col = n; else if (n < 2720) col = 2064 + (n - 2048); else if (n < 2736) col = 2048 + (n - 2720); else col = -1; }
    else if (mode == 3) { const int t = n >> 8, r = n & 255; col = 2736 + ((r >= 128) ? 1024 : 0) + t * 128 + (r & 127); }
    else if (mode == 4) { col = (n >> 6) * 128 + (n & 63); }
    else if (mode == 5) { col = (n >> 6) * 128 + 64 + (n & 63); }
    return col;
}
DI void conv_w(const float* src0, const float* src1, int ldsrc, bf16_t* dst, int N, int K, int mode, const float* kscale, int gtid, int gstride) {
    const int total = N * (K / 8);
    for (int idx = gtid; idx < total; idx += 2 * gstride) {
        const int idx2 = idx + gstride; const bool has2 = idx2 < total;
        const int nA = idx % N, kA = idx / N, nB = has2 ? idx2 % N : nA, kB = has2 ? idx2 / N : kA;
        bool sA, sB; const int cA = conv_col(nA, mode, sA), cB = conv_col(nB, mode, sB);
        const float* pA = sA ? src1 : src0; const float* pB = sB ? src1 : src0;
        float vA[8], vB[8];
#pragma unroll
        for (int j = 0; j < 8; ++j) { vA[j] = (cA >= 0) ? pA[(size_t)(kA * 8 + j) * ldsrc + cA] : 0.f; vB[j] = (cB >= 0) ? pB[(size_t)(kB * 8 + j) * ldsrc + cB] : 0.f; }
        if (kscale) {
#pragma unroll
            for (int j = 0; j < 8; ++j) { vA[j] *= kscale[kA * 8 + j]; vB[j] *= kscale[kB * 8 + j]; } }
        u32x4 w; w.x = cvt_pk_bf16(vA[0], vA[1]); w.y = cvt_pk_bf16(vA[2], vA[3]); w.z = cvt_pk_bf16(vA[4], vA[5]); w.w = cvt_pk_bf16(vA[6], vA[7]);
        *(u32x4*)(dst + (size_t)nA * K + kA * 8) = w;
        if (has2) { u32x4 w2; w2.x = cvt_pk_bf16(vB[0], vB[1]); w2.y = cvt_pk_bf16(vB[2], vB[3]); w2.z = cvt_pk_bf16(vB[4], vB[5]); w2.w = cvt_pk_bf16(vB[6], vB[7]);
            *(u32x4*)(dst + (size_t)nB * K + kB * 8) = w2; }
    }
}

template <bool F32OUT>
DI void rms_rows(const float* x, const float* w, void* out, const int wv) {
    const int tid_ = otid(wv); const int lane = tid_ & 63, wid = tid_ >> 6;
    f32x4 wv4[4];
#pragma unroll
    for (int i = 0; i < 4; ++i) wv4[i] = *(const f32x4*)(w + i * 256 + lane * 4);
    for (int row = (blockIdx.x * 8 + wid) * 4; row < T_; row += gridDim.x * 32) {
        f32x4 v[4][4]; float ss[4] = {0.f, 0.f, 0.f, 0.f};
#pragma unroll
        for (int rr = 0; rr < 4; ++rr)
#pragma unroll
            for (int i = 0; i < 4; ++i) v[rr][i] = *(const f32x4*)(x + (size_t)(row + rr) * D_ + i * 256 + lane * 4);
#pragma unroll
        for (int rr = 0; rr < 4; ++rr)
#pragma unroll
            for (int i = 0; i < 4; ++i) ss[rr] += v[rr][i][0] * v[rr][i][0] + v[rr][i][1] * v[rr][i][1] + v[rr][i][2] * v[rr][i][2] + v[rr][i][3] * v[rr][i][3];
#pragma unroll
        for (int o = 32; o >= 1; o >>= 1) { ss[0] += lane_xor(ss[0], lane, o); ss[1] += lane_xor(ss[1], lane, o); ss[2] += lane_xor(ss[2], lane, o); ss[3] += lane_xor(ss[3], lane, o); }
#pragma unroll
        for (int rr = 0; rr < 4; ++rr) { const float rstd = rsqrtf(ss[rr] * (1.0f / D_) + EPS_);
#pragma unroll
            for (int i = 0; i < 4; ++i) { const f32x4 y = v[rr][i] * rstd * wv4[i];
                if (F32OUT) *(f32x4*)((float*)out + (size_t)(row + rr) * D_ + i * 256 + lane * 4) = y;
                else { u32x2 pk; pk.x = cvt_pk_bf16(y[0], y[1]); pk.y = cvt_pk_bf16(y[2], y[3]); *(u32x2*)((bf16_t*)out + (size_t)(row + rr) * D_ + i * 256 + lane * 4) = pk; } } }
    }
}

DI void mla_latent_pass(const Params& p, unsigned char* ws, int l, const int wv) {
    const int tid_ = otid(wv); const int lane = tid_ & 63, wid = tid_ >> 6;
    bf16_t* restw = (bf16_t*)(ws + WS_REST); bf16_t* kr = (bf16_t*)(ws + WS_KR); const float* qnw = p.in[13] + l * 384; const float* kvnw = p.in[15] + l * 256;
    const float* cosT = (const float*)(ws + WS_COS); const float* sinT = (const float*)(ws + WS_SIN);
    for (int t0 = (blockIdx.x * 8 + wid) * 2; t0 < T_; t0 += gridDim.x * 16) {
        float cq[2][6], ck[2][4], s1[2] = {0.f, 0.f}, s2[2] = {0.f, 0.f};
#pragma unroll
        for (int rr = 0; rr < 2; ++rr) { const bf16_t* r = restw + (size_t)(t0 + rr) * 768;
#pragma unroll
            for (int i = 0; i < 6; ++i) cq[rr][i] = bf2f(r[i * 64 + lane]);
#pragma unroll
            for (int i = 0; i < 4; ++i) ck[rr][i] = bf2f(r[384 + i * 64 + lane]); }
#pragma unroll
        for (int rr = 0; rr < 2; ++rr) {
#pragma unroll
            for (int i = 0; i < 6; ++i) s1[rr] += cq[rr][i] * cq[rr][i];
#pragma unroll
            for (int i = 0; i < 4; ++i) s2[rr] += ck[rr][i] * ck[rr][i]; }
#pragma unroll
        for (int o = 32; o >= 1; o >>= 1) { s1[0] += lane_xor(s1[0], lane, o); s1[1] += lane_xor(s1[1], lane, o); s2[0] += lane_xor(s2[0], lane, o); s2[1] += lane_xor(s2[1], lane, o); }
#pragma unroll
        for (int rr = 0; rr < 2; ++rr) { const int t = t0 + rr; bf16_t* r = restw + (size_t)t * 768;
            const float r1 = rsqrtf(s1[rr] * (1.0f / 384.f) + EPS_), r2 = rsqrtf(s2[rr] * (1.0f / 256.f) + EPS_);
#pragma unroll
            for (int i = 0; i < 6; ++i) r[i * 64 + lane] = (bf16_t)(cvt_pk_bf16(cq[rr][i] * r1 * qnw[i * 64 + lane], 0.f) & 0xffff);
#pragma unroll
            for (int i = 0; i < 4; ++i) r[384 + i * 64 + lane] = (bf16_t)(cvt_pk_bf16(ck[rr][i] * r2 * kvnw[i * 64 + lane], 0.f) & 0xffff);
            if (lane < 16) { const float x1 = bf2f(r[640 + lane]), x2 = bf2f(r[656 + lane]), c = cosT[(size_t)t * 16 + lane], sn = sinT[(size_t)t * 16 + lane];
                const unsigned w = cvt_pk_bf16(x1 * c - x2 * sn, x2 * c + x1 * sn); kr[(size_t)t * 32 + lane] = (bf16_t)(w & 0xffff); kr[(size_t)t * 32 + 16 + lane] = (bf16_t)(w >> 16); } }
    }
}

constexpr int CP_QS = 0, CP_KS = 17408, CP_KT = 34816, CP_VT = CP_KT + 18432, CP_T = CP_VT + 18432, CP_SM = CP_T + 36864;
DI bf16x8 pack8n(const f32x16& x, int s) {
    u32x4 pk;
    if (s == 0) { pk.x = pk2(x[0], x[1]); pk.y = pk2(x[2], x[3]); pk.z = pk2(x[4], x[5]); pk.w = pk2(x[6], x[7]); }
    else { pk.x = pk2(x[8], x[9]); pk.y = pk2(x[10], x[11]); pk.z = pk2(x[12], x[13]); pk.w = pk2(x[14], x[15]); }
    return __builtin_bit_cast(bf16x8, pk);
}
DI void tri_solve(const LAS float* L, LAS bf16_t* Tu, LAS bf16_t* Tw, int c, const LAS float* bet, const LAS float* gc, bool rev) {
    float Tc[64];
#pragma unroll
    for (int i = 0; i < 64; ++i) {
        float a = (i == c) ? 1.f : 0.f, a1 = 0.f, a2 = 0.f, a3 = 0.f;
#pragma unroll
        for (int j4 = 0; j4 < (i + 3) / 4; ++j4) { const f32x4 lv = *(const LAS f32x4*)(L + i * 64 + j4 * 4);
            if (j4 * 4 + 0 < i) a -= lv[0] * Tc[j4 * 4 + 0];
            if (j4 * 4 + 1 < i) a1 -= lv[1] * Tc[j4 * 4 + 1];
            if (j4 * 4 + 2 < i) a2 -= lv[2] * Tc[j4 * 4 + 2];
            if (j4 * 4 + 3 < i) a3 -= lv[3] * Tc[j4 * 4 + 3]; }
        a = (a + a1) + (a2 + a3);
        asm volatile("" : "+v"(a));
        Tc[i] = a;
    }
    const int col = rev ? 63 - c : c; const float su = bet[col], sw = su * __expf(gc[col]);
#pragma unroll
    for (int i = 0; i < 64; ++i) { const int row = rev ? 63 - i : i; const unsigned w = pk2(Tc[i] * su, Tc[i] * sw);
        Tu[row * 72 + col] = (bf16_t)(w & 0xffff); Tw[row * 72 + col] = (bf16_t)(w >> 16); }
}
DI void gdn_chunk_pre(LAS unsigned char* lds, unsigned char* ws, const float* cw, const float* Alog, const float* dtb, int unit, const int wv) {
    const int b = unit >> 9, n = (unit >> 2) & 127, hh = unit & 3; const size_t t0 = (size_t)b * S_ + (size_t)n * 64;
    const bf16_t* gqkv = (const bf16_t*)(ws + WS_GQKV); const bf16_t* rest = (const bf16_t*)(ws + WS_REST); bf16_t* qh = (bf16_t*)(ws + WS_QH);
    const int tid = otid(wv), wid = tid >> 6, lane = tid & 63, r = lane & 31, h = lane >> 5;
    LAS bf16_t* kT = (LAS bf16_t*)(lds + CP_KT); LAS bf16_t* vT = (LAS bf16_t*)(lds + CP_VT);
    LAS float* sm = (LAS float*)(lds + CP_SM); LAS float* betf = sm; LAS float* betb = sm + 64; LAS float* gcf = sm + 128; LAS float* gcb = sm + 192;
    {
        const int pc = tid & 15, ig = tid >> 4, sp0 = n * 64 + 2 * ig - 2;
#pragma unroll
        for (int part = 0; part < 3; ++part) {
            const int col = part * 512 + hh * 128 + pc * 8;
            f32x4 wt[5][2];
#pragma unroll
            for (int j = 0; j < 5; ++j) { wt[j][0] = *(const f32x4*)(cw + j * 1536 + col); wt[j][1] = *(const f32x4*)(cw + j * 1536 + col + 4); }
            u32x4 rows[6];
#pragma unroll
            for (int rr = 0; rr < 6; ++rr) { const int sp = sp0 + rr; rows[rr] = (sp >= 0 && sp < S_) ? *(const u32x4*)(gqkv + ((size_t)b * S_ + sp) * 1536 + col) : (u32x4){0u, 0u, 0u, 0u}; }
#pragma unroll
            for (int tk = 0; tk < 2; ++tk) {
                float y[8];
#pragma unroll
                for (int e = 0; e < 8; ++e) y[e] = 0.f;
#pragma unroll
                for (int j = 0; j < 5; ++j)
#pragma unroll
                    for (int e = 0; e < 4; ++e) { const unsigned w = rows[tk + j][e]; y[2 * e] += bflo(w) * wt[j][(2 * e) >> 2][(2 * e) & 3]; y[2 * e + 1] += bfhi(w) * wt[j][(2 * e + 1) >> 2][(2 * e + 1) & 3]; }
                float ss = 0.f;
#pragma unroll
                for (int e = 0; e < 8; ++e) { y[e] = siluf_(y[e]); ss += y[e] * y[e]; }
                float sc = 1.f;
                if (part < 2) { ss += lane_xor(ss, lane, 1); ss += lane_xor(ss, lane, 2); ss += lane_xor(ss, lane, 4); ss += lane_xor(ss, lane, 8);
                    sc = rsqrtf(ss + EPS_) * (part == 0 ? 0.08838834764831845f : 1.f); }
                u32x4 o; o.x = pk2(y[0] * sc, y[1] * sc); o.y = pk2(y[2] * sc, y[3] * sc); o.z = pk2(y[4] * sc, y[5] * sc); o.w = pk2(y[6] * sc, y[7] * sc);
                const int i = 2 * ig + tk;
                if (part == 0) { *(LAS u32x4*)(lds + CP_QS + i * 272 + pc * 16) = o; *(u32x4*)(qh + (t0 + i) * 512 + hh * 128 + pc * 8) = o; }
                else { if (part == 1) *(LAS u32x4*)(lds + CP_KS + i * 272 + pc * 16) = o;
                    LAS bf16_t* dstT = (part == 1) ? kT : vT;
#pragma unroll
                    for (int e = 0; e < 4; ++e) { dstT[(pc * 8 + 2 * e) * 72 + i] = (bf16_t)(o[e] & 0xffff); dstT[(pc * 8 + 2 * e + 1) * 72 + i] = (bf16_t)(o[e] >> 16); } }
            }
        }
        if (tid < 128) { const int i = tid & 63, dir = tid >> 6, di = dir * 4 + hh;
            const float bb = bf2f(rest[(t0 + i) * 768 + 672 + di]), aa = bf2f(rest[(t0 + i) * 768 + 680 + di]);
            const float xx = aa + dtb[di]; const float ey = __expf(-fabsf(xx)); const float sp = fmaxf(xx, 0.f) + (ey < 0.01f ? ey * (1.f - ey * (0.5f - ey * 0.33333333f)) : __logf(1.f + ey));
            (dir ? betb : betf)[i] = sigmoidf_(bb); (dir ? gcb : gcf)[i] = -__expf(Alog[di]) * sp; }
    }
    __syncthreads();
    if (wv < 2) {
        LAS float* gp = wv ? gcb : gcf; const int idx = wv ? 63 - lane : lane; float v = gp[idx];
#pragma unroll
        for (int o = 1; o < 64; o <<= 1) { const float t = __int_as_float(__builtin_amdgcn_ds_bpermute((lane - o) << 2, __float_as_int(v))); if (lane >= o) v += t; }
        gp[idx] = v; }
    const int mat = wid >> 2, bi = (wid >> 1) & 1, bj = wid & 1;
    f32x16 acc;
#pragma unroll
    for (int i = 0; i < 16; ++i) acc[i] = 0.f;
#pragma unroll
    for (int ks = 0; ks < 8; ++ks) { const bf16x8 a = *(const LAS bf16x8*)(lds + (mat ? CP_QS : CP_KS) + (32 * bi + r) * 272 + (ks * 16 + 8 * h) * 2);
        const bf16x8 bb = *(const LAS bf16x8*)(lds + CP_KS + (32 * bj + r) * 272 + (ks * 16 + 8 * h) * 2);
        acc = __builtin_amdgcn_mfma_f32_32x32x16_bf16(a, bb, acc, 0, 0, 0); }
    __syncthreads();
    LAS float* Lf = (LAS float*)(lds + CP_QS); LAS float* Lb = Lf + 4096;
    { const int j = 32 * bj + r; const float gfj = gcf[j], gbj = gcb[j];
        bf16_t* inf = (bf16_t*)(ws + WS_IF); bf16_t* inb = (bf16_t*)(ws + WS_IB);
#pragma unroll
        for (int x = 0; x < 16; ++x) { const int i = 32 * bi + (x & 3) + 8 * (x >> 2) + 4 * h; const float v = acc[x];
            const float df = __expf(fminf(gcf[i] - gfj, 0.f)), db = __expf(fminf(gcb[i] - gbj, 0.f));
            if (mat == 0) { Lf[i * 64 + j] = (j < i) ? betf[i] * v * df : 0.f; Lb[(63 - i) * 64 + (63 - j)] = (j > i) ? betb[i] * v * db : 0.f; }
            else { const size_t o = ((t0 + i) * 4 + hh) * 64 + j; inf[o] = (bf16_t)(pk2((j <= i) ? v * df : 0.f, 0.f) & 0xffff); inb[o] = (bf16_t)(pk2((j >= i) ? v * db : 0.f, 0.f) & 0xffff); } } }
    __syncthreads();
    if (wv == 0) tri_solve(Lf, (LAS bf16_t*)(lds + CP_T), (LAS bf16_t*)(lds + CP_T + 9216), lane, betf, gcf, false);
    else if (wv == 1) tri_solve(Lb, (LAS bf16_t*)(lds + CP_T + 18432), (LAS bf16_t*)(lds + CP_T + 27648), lane, betb, gcb, true);
    else if (wv == 2) {
        float* eg = (float*)(ws + WS_EG); float* ek = (float*)(ws + WS_EK); float* etot = (float*)(ws + WS_ETOT);
        const float gtf = gcf[63], gtb = gcb[0];
        eg[(t0 + lane) * 8 + hh] = __expf(gcf[lane]); ek[(t0 + lane) * 8 + hh] = __expf(gtf - gcf[lane]);
        eg[(t0 + lane) * 8 + 4 + hh] = __expf(gcb[lane]); ek[(t0 + lane) * 8 + 4 + hh] = __expf(gtb - gcb[lane]);
        if (lane == 0) { etot[((size_t)b * 128 + n) * 8 + hh] = __expf(gtf); etot[((size_t)b * 128 + n) * 8 + 4 + hh] = __expf(gtb); }
    } else if (wv >= 4) {
        bf16_t* kTg = (bf16_t*)(ws + WS_KT);
        for (int ch = tid - 256; ch < 1024; ch += 256) { const int dk = ch >> 3, pc = ch & 7;
            *(u32x4*)(kTg + ((size_t)(b * 4 + hh) * 128 + dk) * S_ + (size_t)n * 64 + pc * 8) = *(const LAS u32x4*)(lds + CP_KT + dk * 144 + pc * 16); }
    }
    __syncthreads();
    { const int dir = wid >> 2, wq = wid & 3; const LAS unsigned char* Tu = lds + CP_T + dir * 18432; const LAS unsigned char* Tw = Tu + 9216;
        if (wq < 2) { const int tb = wq; bf16_t* uT = (bf16_t*)(ws + (dir ? WS_UB : WS_UF));
#pragma unroll
            for (int nb = 0; nb < 4; ++nb) { f32x16 c;
#pragma unroll
                for (int i = 0; i < 16; ++i) c[i] = 0.f;
#pragma unroll
                for (int s = 0; s < 4; ++s) { const bf16x8 a = *(const LAS bf16x8*)(Tu + (32 * tb + r) * 144 + (16 * s + 8 * h) * 2);
                    const bf16x8 bb = *(const LAS bf16x8*)(lds + CP_VT + (32 * nb + r) * 144 + (16 * s + 8 * h) * 2);
                    c = __builtin_amdgcn_mfma_f32_32x32x16_bf16(a, bb, c, 0, 0, 0); }
                bf16_t* dst = uT + ((size_t)(b * 4 + hh) * 128 + 32 * nb + r) * S_ + (size_t)n * 64 + 32 * tb + 4 * h;
#pragma unroll
                for (int g4 = 0; g4 < 4; ++g4) { u32x2 w; w.x = pk2(c[4 * g4], c[4 * g4 + 1]); w.y = pk2(c[4 * g4 + 2], c[4 * g4 + 3]); *(u32x2*)(dst + 8 * g4) = w; } }
        } else { const int ib = wq - 2; bf16_t* wd = (bf16_t*)(ws + (dir ? WS_WB : WS_WF));
#pragma unroll
            for (int kb = 0; kb < 4; ++kb) { f32x16 c;
#pragma unroll
                for (int i = 0; i < 16; ++i) c[i] = 0.f;
#pragma unroll
                for (int s = 0; s < 4; ++s) { const bf16x8 a = *(const LAS bf16x8*)(lds + CP_KT + (32 * kb + r) * 144 + (16 * s + 8 * h) * 2);
                    const bf16x8 bb = *(const LAS bf16x8*)(Tw + (32 * ib + r) * 144 + (16 * s + 8 * h) * 2);
                    c = __builtin_amdgcn_mfma_f32_32x32x16_bf16(a, bb, c, 0, 0, 0); }
                bf16_t* dst = wd + (t0 + 32 * ib + r) * 512 + hh * 128 + 32 * kb + 4 * h;
#pragma unroll
                for (int g4 = 0; g4 < 4; ++g4) { u32x2 w; w.x = pk2(c[4 * g4], c[4 * g4 + 1]); w.y = pk2(c[4 * g4 + 2], c[4 * g4 + 3]); *(u32x2*)(dst + 8 * g4) = w; } }
        } }
    __syncthreads();
}

constexpr int SC_W = 0, SC_Q = 16896, SC_KT = 33792, SC_IN = SC_KT + 17408, SC_EG = SC_IN + 8704, SC_BUF = SC_EG + 528;
DI void gdn_scan(LAS unsigned char* lds, unsigned char* ws, int chain, const int wv) {
    const int b = chain >> 3, hh = (chain >> 1) & 3, dir = chain & 1;
    const bf16_t* wg = (const bf16_t*)(ws + (dir ? WS_WB : WS_WF)); const bf16_t* qg = (const bf16_t*)(ws + WS_QH); const bf16_t* kTg = (const bf16_t*)(ws + WS_KT);
    const bf16_t* ing = (const bf16_t*)(ws + (dir ? WS_IB : WS_IF)); const bf16_t* uTg = (const bf16_t*)(ws + (dir ? WS_UB : WS_UF));
    const float* egg = (const float*)(ws + WS_EG); const float* ekg = (const float*)(ws + WS_EK); const float* etg = (const float*)(ws + WS_ETOT);
    bf16_t* out = (bf16_t*)(ws + (dir ? WS_OB : WS_OF));
    const int tid = otid(wv), wid = tid >> 6, lane = tid & 63, r = lane & 31, h = lane >> 5;
    const int di = dir * 4 + hh;
    if (wv >= 4) {
        const int lt = tid - 256;
        for (int c = -1; c < 127; ++c) {
            const int n = dir ? 127 - (c + 1) : (c + 1); const size_t t0 = (size_t)b * S_ + (size_t)n * 64;
            LAS unsigned char* buf = lds + ((c + 1) & 1) * SC_BUF;
            u32x4 rw[4], rq[4], rk[4], ri[2];
#pragma unroll
            for (int k = 0; k < 4; ++k) { const int ch = lt + k * 256, i = ch >> 4, pc = ch & 15; const size_t src = (t0 + i) * 512 + hh * 128 + pc * 8; rw[k] = *(const u32x4*)(wg + src); rq[k] = *(const u32x4*)(qg + src); }
#pragma unroll
            for (int k = 0; k < 4; ++k) { const int ch = lt + k * 256, dk = ch >> 3, pc = ch & 7; rk[k] = *(const u32x4*)(kTg + ((size_t)(b * 4 + hh) * 128 + dk) * S_ + (size_t)n * 64 + pc * 8); }
#pragma unroll
            for (int k = 0; k < 2; ++k) { const int ch = lt + k * 256, i = ch >> 3, pc = ch & 7; ri[k] = *(const u32x4*)(ing + ((t0 + i) * 4 + hh) * 64 + pc * 8); }
            float ev = 0.f;
            if (lt < 64) ev = egg[(t0 + lt) * 8 + di]; else if (lt < 128) ev = ekg[(t0 + lt - 64) * 8 + di]; else if (lt == 128) ev = etg[((size_t)b * 128 + n) * 8 + di];
#pragma unroll
            for (int k = 0; k < 4; ++k) { const int ch = lt + k * 256, i = ch >> 4, pc = ch & 15;
                *(LAS u32x2*)(buf + SC_W + i * 264 + pc * 16) = (u32x2){rw[k].x, rw[k].y}; *(LAS u32x2*)(buf + SC_W + i * 264 + pc * 16 + 8) = (u32x2){rw[k].z, rw[k].w};
                *(LAS u32x2*)(buf + SC_Q + i * 264 + pc * 16) = (u32x2){rq[k].x, rq[k].y}; *(LAS u32x2*)(buf + SC_Q + i * 264 + pc * 16 + 8) = (u32x2){rq[k].z, rq[k].w}; }
#pragma unroll
            for (int k = 0; k < 4; ++k) { const int ch = lt + k * 256, dk = ch >> 3, pc = ch & 7;
                *(LAS u32x2*)(buf + SC_KT + dk * 136 + pc * 16) = (u32x2){rk[k].x, rk[k].y}; *(LAS u32x2*)(buf + SC_KT + dk * 136 + pc * 16 + 8) = (u32x2){rk[k].z, rk[k].w}; }
#pragma unroll
            for (int k = 0; k < 2; ++k) { const int ch = lt + k * 256, i = ch >> 3, pc = ch & 7;
                *(LAS u32x2*)(buf + SC_IN + i * 136 + pc * 16) = (u32x2){ri[k].x, ri[k].y}; *(LAS u32x2*)(buf + SC_IN + i * 136 + pc * 16 + 8) = (u32x2){ri[k].z, ri[k].w}; }
            if (lt <= 128) *(LAS float*)(buf + SC_EG + lt * 4) = ev;
            __syncthreads();
        }
        __syncthreads();
    } else {
        const int nb = wid;
        f32x16 Sa[4];
#pragma unroll
        for (int kb = 0; kb < 4; ++kb)
#pragma unroll
            for (int i = 0; i < 16; ++i) Sa[kb][i] = 0.f;
        __syncthreads();
        for (int c = 0; c < 128; ++c) {
            const int n = dir ? 127 - c : c; const size_t t0 = (size_t)b * S_ + (size_t)n * 64;
            const LAS unsigned char* buf = lds + (c & 1) * SC_BUF;
            u32x2 ur[2][4];
            { const bf16_t* up = uTg + ((size_t)(b * 4 + hh) * 128 + 32 * nb + r) * S_ + (size_t)n * 64 + 4 * h;
#pragma unroll
                for (int tb = 0; tb < 2; ++tb)
#pragma unroll
                    for (int g4 = 0; g4 < 4; ++g4) ur[tb][g4] = *(const u32x2*)(up + 32 * tb + 8 * g4); }
            bf16x8 Sb[4][2];
#pragma unroll
            for (int kb = 0; kb < 4; ++kb) { Sb[kb][0] = pack8n(Sa[kb], 0); Sb[kb][1] = pack8n(Sa[kb], 1); }
            f32x16 X[2], Y[2];
#pragma unroll
            for (int i = 0; i < 16; ++i) { X[0][i] = 0.f; X[1][i] = 0.f; Y[0][i] = 0.f; Y[1][i] = 0.f; }
#pragma unroll
            for (int kb = 0; kb < 4; ++kb)
#pragma unroll
                for (int s = 0; s < 2; ++s)
#pragma unroll
                    for (int tb = 0; tb < 2; ++tb) { const int off = (32 * tb + r) * 264 + (32 * kb + 16 * s + 4 * h) * 2;
                        const s16x4 w0 = *(const LAS s16x4*)(buf + SC_W + off), w1 = *(const LAS s16x4*)(buf + SC_W + off + 16);
                        const s16x4 q0 = *(const LAS s16x4*)(buf + SC_Q + off), q1 = *(const LAS s16x4*)(buf + SC_Q + off + 16);
                        X[tb] = __builtin_amdgcn_mfma_f32_32x32x16_bf16(__builtin_shufflevector(w0, w1, 0, 1, 2, 3, 4, 5, 6, 7), Sb[kb][s], X[tb], 0, 0, 0);
                        Y[tb] = __builtin_amdgcn_mfma_f32_32x32x16_bf16(__builtin_shufflevector(q0, q1, 0, 1, 2, 3, 4, 5, 6, 7), Sb[kb][s], Y[tb], 0, 0, 0); }
            f32x16 vn[2];
#pragma unroll
            for (int tb = 0; tb < 2; ++tb)
#pragma unroll
                for (int g4 = 0; g4 < 4; ++g4) { const u32x2 uu = ur[tb][g4];
                    vn[tb][4 * g4] = bflo(uu.x) - X[tb][4 * g4]; vn[tb][4 * g4 + 1] = bfhi(uu.x) - X[tb][4 * g4 + 1];
                    vn[tb][4 * g4 + 2] = bflo(uu.y) - X[tb][4 * g4 + 2]; vn[tb][4 * g4 + 3] = bfhi(uu.y) - X[tb][4 * g4 + 3]; }
            bf16x8 vb[2][2];
#pragma unroll
            for (int tb = 0; tb < 2; ++tb) { vb[tb][0] = pack8n(vn[tb], 0); vb[tb][1] = pack8n(vn[tb], 1); }
#pragma unroll
            for (int tb = 0; tb < 2; ++tb)
#pragma unroll
                for (int g4 = 0; g4 < 4; ++g4) { const f32x4 e4 = *(const LAS f32x4*)(buf + SC_EG + (32 * tb + 8 * g4 + 4 * h) * 4);
#pragma unroll
                    for (int e = 0; e < 4; ++e) Y[tb][4 * g4 + e] *= e4[e]; }
#pragma unroll
            for (int tb = 0; tb < 2; ++tb)
#pragma unroll
                for (int t2 = 0; t2 < 2; ++t2)
#pragma unroll
                    for (int s = 0; s < 2; ++s) { const int off = (32 * tb + r) * 136 + (32 * t2 + 16 * s + 4 * h) * 2;
                        const s16x4 a0 = *(const LAS s16x4*)(buf + SC_IN + off), a1 = *(const LAS s16x4*)(buf + SC_IN + off + 16);
                        Y[tb] = __builtin_amdgcn_mfma_f32_32x32x16_bf16(__builtin_shufflevector(a0, a1, 0, 1, 2, 3, 4, 5, 6, 7), vb[t2][s], Y[tb], 0, 0, 0); }
#pragma unroll
            for (int tb = 0; tb < 2; ++tb)
#pragma unroll
                for (int g4 = 0; g4 < 4; ++g4) { const f32x4 e4 = *(const LAS f32x4*)(buf + SC_EG + 256 + (32 * tb + 8 * g4 + 4 * h) * 4);
#pragma unroll
                    for (int e = 0; e < 4; ++e) vn[tb][4 * g4 + e] *= e4[e]; }
#pragma unroll
            for (int tb = 0; tb < 2; ++tb) { vb[tb][0] = pack8n(vn[tb], 0); vb[tb][1] = pack8n(vn[tb], 1); }
            const float et = *(const LAS float*)(buf + SC_EG + 512);
#pragma unroll
            for (int kb = 0; kb < 4; ++kb) {
#pragma unroll
                for (int i = 0; i < 16; ++i) Sa[kb][i] *= et;
#pragma unroll
                for (int tb = 0; tb < 2; ++tb)
#pragma unroll
                    for (int s = 0; s < 2; ++s) { const int off = (32 * kb + r) * 136 + (32 * tb + 16 * s + 4 * h) * 2;
                        const s16x4 a0 = *(const LAS s16x4*)(buf + SC_KT + off), a1 = *(const LAS s16x4*)(buf + SC_KT + off + 16);
                        Sa[kb] = __builtin_amdgcn_mfma_f32_32x32x16_bf16(__builtin_shufflevector(a0, a1, 0, 1, 2, 3, 4, 5, 6, 7), vb[tb][s], Sa[kb], 0, 0, 0); } }
#pragma unroll
            for (int tb = 0; tb < 2; ++tb)
#pragma unroll
                for (int x = 0; x < 16; ++x) { const int i = 32 * tb + (x & 3) + 8 * (x >> 2) + 4 * h;
                    out[(t0 + i) * 512 + hh * 128 + 32 * nb + r] = (bf16_t)(pk2(Y[tb][x], 0.f) & 0xffff); }
            __syncthreads();
        }
    }
}

DI bf16x8 pack8(const f32x16& x, int s) {
    u32x4 pk;
    if (s == 0) asm volatile("v_cvt_pk_bf16_f32 %0, %4, %5\n\tv_cvt_pk_bf16_f32 %1, %6, %7\n\tv_cvt_pk_bf16_f32 %2, %8, %9\n\tv_cvt_pk_bf16_f32 %3, %10, %11\n\ts_nop 1"
               : "=&v"(pk[0]), "=&v"(pk[1]), "=&v"(pk[2]), "=&v"(pk[3]) : "v"(x[0]), "v"(x[1]), "v"(x[2]), "v"(x[3]), "v"(x[4]), "v"(x[5]), "v"(x[6]), "v"(x[7]));
    else asm volatile("v_cvt_pk_bf16_f32 %0, %4, %5\n\tv_cvt_pk_bf16_f32 %1, %6, %7\n\tv_cvt_pk_bf16_f32 %2, %8, %9\n\tv_cvt_pk_bf16_f32 %3, %10, %11\n\ts_nop 1"
               : "=&v"(pk[0]), "=&v"(pk[1]), "=&v"(pk[2]), "=&v"(pk[3]) : "v"(x[8]), "v"(x[9]), "v"(x[10]), "v"(x[11]), "v"(x[12]), "v"(x[13]), "v"(x[14]), "v"(x[15]));
    return __builtin_bit_cast(bf16x8, pk);
}
constexpr int AT_KROW = 208, AT_VROW = 136, AT_KBYTES = 64 * AT_KROW, AT_BUF = AT_KBYTES + 64 * AT_VROW;
DI void attn_tile(const LAS unsigned char* kcur, const LAS unsigned char* vcur, const bf16x8 (&bq)[2][6], f32x16 (&oT)[2][2],
                  float (&mrun)[2], float (&lrun)[2], int lane, int r, int hf, int kh) {
    f32x16 sT[2];
#pragma unroll
    for (int i = 0; i < 16; ++i) { sT[0][i] = 0.f; sT[1][i] = 0.f; }
#pragma unroll
    for (int ks = 0; ks < 6; ++ks) { const bf16x8 a = *(const LAS bf16x8*)(kcur + (kh * 32 + r) * AT_KROW + (ks * 16 + 8 * hf) * 2);
        sT[0] = __builtin_amdgcn_mfma_f32_32x32x16_bf16(a, bq[0][ks], sT[0], 0, 0, 0);
        sT[1] = __builtin_amdgcn_mfma_f32_32x32x16_bf16(a, bq[1][ks], sT[1], 0, 0, 0); }
#pragma unroll
    for (int qb = 0; qb < 2; ++qb) {
        float mx = sT[qb][0];
#pragma unroll
        for (int i = 1; i < 16; ++i) mx = fmaxf(mx, sT[qb][i]);
        mx = fmaxf(mx, lane_xor(mx, lane, 32));
        if (__builtin_amdgcn_ballot_w64(mx > mrun[qb] + 8.0f) != 0ull) {
            const float mnew = fmaxf(mrun[qb], mx), alpha = __builtin_amdgcn_exp2f(mrun[qb] - mnew); mrun[qb] = mnew; lrun[qb] *= alpha;
#pragma unroll
            for (int i = 0; i < 16; ++i) { oT[qb][0][i] *= alpha; oT[qb][1][i] *= alpha; }
        }
        float rs = 0.f;
#pragma unroll
        for (int i = 0; i < 16; ++i) { sT[qb][i] = __builtin_amdgcn_exp2f(sT[qb][i] - mrun[qb]); rs += sT[qb][i]; }
        lrun[qb] += rs;
    }
#pragma unroll
    for (int s = 0; s < 2; ++s) { const bf16x8 bp0 = pack8n(sT[0], s), bp1 = pack8n(sT[1], s);
#pragma unroll
        for (int dvb = 0; dvb < 2; ++dvb) { const LAS unsigned char* va = vcur + (dvb * 32 + r) * AT_VROW + (kh * 32 + 16 * s + 4 * hf) * 2;
            const s16x4 lo = *(const LAS s16x4*)va, hi = *(const LAS s16x4*)(va + 16); const bf16x8 a = __builtin_shufflevector(lo, hi, 0, 1, 2, 3, 4, 5, 6, 7);
            oT[0][dvb] = __builtin_amdgcn_mfma_f32_32x32x16_bf16(a, bp0, oT[0][dvb], 0, 0, 0);
            oT[1][dvb] = __builtin_amdgcn_mfma_f32_32x32x16_bf16(a, bp1, oT[1][dvb], 0, 0, 0); } }
}
constexpr int AT_XCH = 45056;
DI void attn_unit(LAS unsigned char* lds, const bf16_t* Q, const bf16_t* Kn, const bf16_t* Kr, const bf16_t* Vt, bf16_t* O, const float* cosT, const float* sinT, int b, int hh, int qblk, const int wv) {
    const int tid = otid(wv), wid = tid >> 6, lane = tid & 63, r = lane & 31, hf = lane >> 5, g = wv & 3, kh = wv >> 2;
    const size_t q0 = (size_t)b * S_ + (size_t)qblk * 256 + g * 64;
    const int kc0 = tid, kc1 = tid + 512; const bool has1 = tid < 256;
    const int key0 = kc0 / 12, part0 = kc0 % 12, key1 = has1 ? kc1 / 12 : 0, part1 = has1 ? kc1 % 12 : 0;
    const bf16_t* ks0 = (part0 < 8) ? Kn + ((size_t)b * S_ + key0) * 512 + hh * 64 + part0 * 8 : Kr + ((size_t)b * S_ + key0) * 32 + (part0 - 8) * 8;
    const bf16_t* ks1 = (part1 < 8) ? Kn + ((size_t)b * S_ + key1) * 512 + hh * 64 + part1 * 8 : Kr + ((size_t)b * S_ + key1) * 32 + (part1 - 8) * 8;
    const size_t kst0 = (part0 < 8) ? 512 : 32, kst1 = (part1 < 8) ? 512 : 32;
    const int kd0 = key0 * AT_KROW + part0 * 16, kd1 = key1 * AT_KROW + part1 * 16;
    const int vdv = tid >> 3, vpart = tid & 7;
    const bf16_t* vsrc = Vt + (size_t)(hh * 64 + vdv) * T_ + (size_t)b * S_ + vpart * 8;
    const int vd = AT_KBYTES + vdv * AT_VROW + vpart * 16;
    u32x4 kr0, kr1 = (u32x4){0, 0, 0, 0}, vr;
    kr0 = *(const u32x4*)ks0; if (has1) kr1 = *(const u32x4*)ks1; vr = *(const u32x4*)vsrc;
    bf16x8 bq[2][6];
#pragma unroll
    for (int qb = 0; qb < 2; ++qb) {
#pragma unroll
        for (int ks = 0; ks < 6; ++ks) bq[qb][ks] = *(const bf16x8*)(Q + (q0 + qb * 32 + r) * 768 + hh * 96 + ks * 16 + 8 * hf);
        const float* cp = cosT + (q0 + qb * 32 + r) * 16 + 8 * hf; const float* sp = sinT + (q0 + qb * 32 + r) * 16 + 8 * hf;
        const f32x4 c0 = *(const f32x4*)cp, c1 = *(const f32x4*)(cp + 4), s0 = *(const f32x4*)sp, s1 = *(const f32x4*)(sp + 4);
        const u32x4 x1 = __builtin_bit_cast(u32x4, bq[qb][4]), x2 = __builtin_bit_cast(u32x4, bq[qb][5]); u32x4 y1, y2;
#pragma unroll
        for (int e = 0; e < 4; ++e) { const float a0 = bflo(x1[e]), a1 = bfhi(x1[e]), b0 = bflo(x2[e]), b1 = bfhi(x2[e]);
            const float cc0 = e < 2 ? c0[2 * e] : c1[2 * e - 4], cc1 = e < 2 ? c0[2 * e + 1] : c1[2 * e - 3], ss0 = e < 2 ? s0[2 * e] : s1[2 * e - 4], ss1 = e < 2 ? s0[2 * e + 1] : s1[2 * e - 3];
            y1[e] = pk2(a0 * cc0 - b0 * ss0, a1 * cc1 - b1 * ss1); y2[e] = pk2(b0 * cc0 + a0 * ss0, b1 * cc1 + a1 * ss1); }
        bq[qb][4] = __builtin_bit_cast(bf16x8, y1); bq[qb][5] = __builtin_bit_cast(bf16x8, y2); }
    f32x16 oT[2][2];
#pragma unroll
    for (int i = 0; i < 16; ++i) { oT[0][0][i] = 0.f; oT[0][1][i] = 0.f; oT[1][0][i] = 0.f; oT[1][1][i] = 0.f; }
    float mrun[2] = {-1e30f, -1e30f}, lrun[2] = {0.f, 0.f};
    *(LAS u32x4*)(lds + kd0) = kr0; if (has1) *(LAS u32x4*)(lds + kd1) = kr1;
    *(LAS u32x2*)(lds + vd) = (u32x2){vr.x, vr.y}; *(LAS u32x2*)(lds + vd + 8) = (u32x2){vr.z, vr.w};
    __syncthreads();
    for (int t = 0; t < 128; ++t) {
        const LAS unsigned char* kb_ = lds + (t & 1) * AT_BUF;
        if (t + 1 < 128) { const size_t ko = (size_t)(t + 1) * 64; kr0 = *(const u32x4*)(ks0 + ko * kst0); if (has1) kr1 = *(const u32x4*)(ks1 + ko * kst1); vr = *(const u32x4*)(vsrc + ko); }
        attn_tile(kb_, kb_ + AT_KBYTES, bq, oT, mrun, lrun, lane, r, hf, kh);
        if (t + 1 < 128) { LAS unsigned char* nb = lds + ((t + 1) & 1) * AT_BUF;
            *(LAS u32x4*)(nb + kd0) = kr0; if (has1) *(LAS u32x4*)(nb + kd1) = kr1;
            *(LAS u32x2*)(nb + vd) = (u32x2){vr.x, vr.y}; *(LAS u32x2*)(nb + vd + 8) = (u32x2){vr.z, vr.w}; }
        __syncthreads();
    }
    LAS float* xw = (LAS float*)(lds + AT_XCH) + g * (68 * 64) + lane;
    if (kh == 1) {
#pragma unroll
        for (int qb = 0; qb < 2; ++qb) { xw[(64 + qb) * 64] = mrun[qb]; xw[(64 + 2 + qb) * 64 - 128 + 128] = lrun[qb];
#pragma unroll
            for (int dvb = 0; dvb < 2; ++dvb)
#pragma unroll
                for (int i = 0; i < 16; ++i) xw[((qb * 2 + dvb) * 16 + i) * 64] = oT[qb][dvb][i]; }
    }
    __syncthreads();
    if (kh == 0) {
#pragma unroll
        for (int qb = 0; qb < 2; ++qb) { const float m1 = xw[(64 + qb) * 64], l1 = xw[(66 + qb) * 64 - 128 + 128];
            const float m = fmaxf(mrun[qb], m1), a0 = __builtin_amdgcn_exp2f(mrun[qb] - m), a1 = __builtin_amdgcn_exp2f(m1 - m);
            float l = lrun[qb] * a0 + l1 * a1; l += lane_xor(l, lane, 32); const float inv = 1.0f / l, f0 = a0 * inv, f1 = a1 * inv;
#pragma unroll
            for (int dvb = 0; dvb < 2; ++dvb)
#pragma unroll
                for (int g4 = 0; g4 < 4; ++g4) { float o[4];
#pragma unroll
                    for (int e = 0; e < 4; ++e) o[e] = oT[qb][dvb][4 * g4 + e] * f0 + xw[((qb * 2 + dvb) * 16 + 4 * g4 + e) * 64] * f1;
                    u32x2 w; w.x = pk2(o[0], o[1]); w.y = pk2(o[2], o[3]);
                    *(u32x2*)(O + (q0 + qb * 32 + r) * 512 + hh * 64 + dvb * 32 + 8 * g4 + 4 * hf) = w; } }
    }
}

DI void gdn_gate_norm(const Params& p, unsigned char* ws, int l, const int wv) {
    const bf16_t* of = (const bf16_t*)(ws + WS_OF); const bf16_t* ob = (const bf16_t*)(ws + WS_OB); const bf16_t* z = (const bf16_t*)(ws + WS_Z);
    bf16_t* ag = (bf16_t*)(ws + WS_AG); const float* nw = p.in[11] + l * 128;
    const int tid_ = otid(wv); const int lane = tid_ & 63, wid = tid_ >> 6;
    const f32x4 n0 = *(const f32x4*)(nw + (lane & 15) * 8), n1 = *(const f32x4*)(nw + (lane & 15) * 8 + 4);
    for (int t = (blockIdx.x * 8 + wid) * 2; t < T_; t += gridDim.x * 16) {
        u32x4 a[2], b[2], zz[2];
#pragma unroll
        for (int rr = 0; rr < 2; ++rr) { const size_t o = (size_t)(t + rr) * 512 + lane * 8; a[rr] = *(const u32x4*)(of + o); b[rr] = *(const u32x4*)(ob + o); zz[rr] = *(const u32x4*)(z + o); }
#pragma unroll
        for (int rr = 0; rr < 2; ++rr) { float v[8]; float ss = 0.f;
#pragma unroll
            for (int e = 0; e < 4; ++e) { v[2 * e] = bflo(a[rr][e]) + bflo(b[rr][e]); v[2 * e + 1] = bfhi(a[rr][e]) + bfhi(b[rr][e]); ss += v[2 * e] * v[2 * e] + v[2 * e + 1] * v[2 * e + 1]; }
            ss += lane_xor(ss, lane, 1); ss += lane_xor(ss, lane, 2); ss += lane_xor(ss, lane, 4); ss += lane_xor(ss, lane, 8);
            const float rstd = rsqrtf(ss * (1.0f / 128.f) + EPS_); u32x4 w;
#pragma unroll
            for (int e = 0; e < 4; ++e) { const float w0 = (2 * e < 4) ? n0[2 * e] : n1[2 * e - 4], w1 = (2 * e + 1 < 4) ? n0[2 * e + 1] : n1[2 * e - 3];
                w[e] = pk2(v[2 * e] * rstd * w0 * siluf_(bflo(zz[rr][e])), v[2 * e + 1] * rstd * w1 * siluf_(bfhi(zz[rr][e]))); }
            *(u32x4*)(ag + (size_t)(t + rr) * 512 + lane * 8) = w; }
    }
}

#define XB_TMO      128
#define XB_XCNT(j)  (256  + 64 * (j))
#define XB_XSUB(j)  (1280 + 64 * (j))
#define XB_XGEN(j)  (2304 + 64 * (j))
#define XB_TOP      3328
#define XB_TOPGEN   3392
#define XCD_BAR_WORDS 3456
#define XB_SPIN_CAP (1u << 18)
DI unsigned xb_ld(unsigned* p)              { return __hip_atomic_load(p, __ATOMIC_RELAXED, __HIP_MEMORY_SCOPE_AGENT); }
DI unsigned xb_add(unsigned* p, unsigned v) { return __hip_atomic_fetch_add(p, v, __ATOMIC_RELAXED, __HIP_MEMORY_SCOPE_AGENT); }
DI unsigned xb_xcc_id() { return (unsigned)__builtin_amdgcn_s_getreg((3 << 11) | 20) & 0xFu; }
#define XB_SPIN(cond, bar) do { unsigned _sp = 0; while (cond) { __builtin_amdgcn_s_sleep(1); \
    if ((++_sp & 255u) == 0u) { if (xb_ld(&(bar)[XB_TMO])) break; if (_sp > XB_SPIN_CAP) { atomicAdd(&(bar)[XB_TMO], 1u); break; } } } } while (0)
DI void xcd_barrier_complete(unsigned* bar, unsigned x, unsigned G, unsigned& nloc, unsigned& nx) {
    unsigned sum, cnt, mine, sp = 0u;
    for (;;) {
        sum = 0u; cnt = 0u; mine = 0u;
#pragma unroll
        for (unsigned j = 0; j < 16; ++j) { const unsigned c = xb_ld(&bar[XB_XCNT(j)]); sum += c; cnt += (c > 0u) ? 1u : 0u; mine = (j == x) ? c : mine; }
        if (sum == G) break;
        __builtin_amdgcn_s_sleep(1);
        if ((++sp & 255u) == 0u) { if (xb_ld(&bar[XB_TMO])) break; if (sp > XB_SPIN_CAP) { atomicAdd(&bar[XB_TMO], 1u); break; } }
    }
    nloc = mine > 0u ? mine : 1u; nx = cnt > 0u ? cnt : 1u;
}
DI void xcd_barrier(unsigned* bar, volatile LAS unsigned* st, unsigned G, const int wv) {
    asm volatile("s_waitcnt vmcnt(0)" ::: "memory");
    __syncthreads();
    if (otid(wv) == 0) {
        const unsigned x = xb_xcc_id();
        __builtin_amdgcn_s_waitcnt(0);
        unsigned nloc = st[0], nx = st[1];
        if (nloc == 0u) { xcd_barrier_complete(bar, x, G, nloc, nx); st[0] = nloc; st[1] = nx; }
        const unsigned old = xb_add(&bar[XB_XSUB(x)], 1u);
        const unsigned gen = old / nloc;
        if (old + 1u == (gen + 1u) * nloc) {
            __builtin_amdgcn_fence(__ATOMIC_RELEASE, "agent");
            asm volatile("s_waitcnt vmcnt(0)" ::: "memory");
            const unsigned og = xb_add(&bar[XB_TOP], 1u);
            const unsigned tg = og / nx;
            if (og + 1u == (tg + 1u) * nx) xb_add(&bar[XB_TOPGEN], 1u);
            else XB_SPIN(xb_ld(&bar[XB_TOPGEN]) == tg, bar);
            __builtin_amdgcn_fence(__ATOMIC_ACQUIRE, "agent");
            xb_add(&bar[XB_XGEN(x)], 1u);
            asm volatile("s_waitcnt vmcnt(0)" ::: "memory");
        } else {
            XB_SPIN(xb_ld(&bar[XB_XGEN(x)]) == gen, bar);
            __builtin_amdgcn_fence(__ATOMIC_ACQUIRE, "agent");
            asm volatile("s_waitcnt vmcnt(0)" ::: "memory");
        }
    }
    __syncthreads();
}

__global__ void __launch_bounds__(512, 2) mega(Params p) {
    extern __shared__ __attribute__((aligned(16))) unsigned char shm[];
    LAS unsigned char* lds = (LAS unsigned char*)shm;
    const int wv = __builtin_amdgcn_readfirstlane(threadIdx.x >> 6);
    volatile LAS unsigned* xst = (volatile LAS unsigned*)(lds + 131072);
    if (threadIdx.x < 2) xst[threadIdx.x] = 0u;
    __syncthreads();
    if (threadIdx.x == 0) (void)xb_add((unsigned*)(p.ws + WS_BAR) + XB_XCNT(xb_xcc_id()), 1u);
    const int ph_lo = __builtin_amdgcn_readfirstlane(p.ph_lo), ph_hi = __builtin_amdgcn_readfirstlane(p.ph_hi);
    for (int ph = ph_lo; ph < ph_hi; ++ph) {
        size_t zoff = 0; int G = gridDim.x, bid = blockIdx.x;
        asm volatile("" : "+s"(zoff), "+s"(G), "+s"(bid));
        unsigned char* ws = p.ws + zoff;
        const int gstride = G * 512;
        if (ph == 0) {
            const int gtid = bid * 512 + otid(wv);
            if (bid == 0 && gtid < 16) *((unsigned*)(ws + WS_CTR) + gtid * 64) = 0u;
            const int* pos = (const int*)p.in[1]; float* cosT = (float*)(ws + WS_COS); float* sinT = (float*)(ws + WS_SIN);
            for (int idx = gtid; idx < T_ * 16; idx += gstride) { const int t = idx >> 4, i = idx & 15;
                const double rev = (double)pos[t] * p.invf_rev[i]; const float fr = (float)(rev - rint(rev));
                cosT[idx] = __builtin_amdgcn_cosf(fr); sinT[idx] = __builtin_amdgcn_sinf(fr); }
        } else if (ph == NPH_ - 1) {
            rms_rows<true>(p.out, p.in[23], p.out, wv);
        } else {
            const int l = (ph - 1) / NS_, sl = (ph - 1) % NS_, st = (PROBE_ST >= 0 && sl > PROBE_ST) ? sl - 1 : sl;
            const bool ffn2 = st >= 12; const int fs = ffn2 ? st - 12 : st;
            const float* xin = (l == 0 && st < 3) ? p.in[0] : p.out;
            if ((st < 3 || ffn2)) {
                const int ig = ffn2 ? 20 : 3, iu = ffn2 ? 21 : 4, idn = ffn2 ? 22 : 5, inw = ffn2 ? 19 : 2;
                if (fs == 0 && EN(0)) {
                    const int gtid = bid * 512 + otid(wv);
                    rms_rows<false>(xin, p.in[inw] + (size_t)l * D_, ws + WS_H, wv);
                    conv_w(p.in[ig] + (size_t)l * D_ * FF_, p.in[iu] + (size_t)l * D_ * FF_, FF_, (bf16_t*)(ws + W_GU), 5632, 1024, 1, nullptr, gtid, gstride);
                    conv_w(p.in[idn] + (size_t)l * D_ * FF_, nullptr, D_, (bf16_t*)(ws + W_D), 1024, FF_, 0, nullptr, gtid, gstride);
                } else if (fs == 1 && EN(1)) {
                    pg8::Gemm g{(const bf16_t*)(ws + WS_H), (const bf16_t*)(ws + W_GU), T_, 5632, 1024, 1024, 1024}; pg8::StaticOrder S; S.init(T_, 5632, G, bid);
                    pg8::EpiSwiglu E{(bf16_t*)(ws + WS_BIG), FF_}; pg8::gemm_phase(lds, g, S, E, wv);
                } else if (EN(2)) {
                    pg8::Gemm g{(const bf16_t*)(ws + WS_BIG), (const bf16_t*)(ws + W_D), T_, 1024, FF_, FF_, FF_}; pg8::StaticOrder S; S.init(T_, 1024, G, bid);
                    pg8::EpiResid E{xin, p.out, 0.5f}; pg8::gemm_phase(lds, g, S, E, wv);
                }
            } else if (st == 3 && EN(3)) {
                const int gtid = bid * 512 + otid(wv);
                rms_rows<false>(p.out, p.in[6] + (size_t)l * D_, ws + WS_H, wv);
                const float* win = p.in[7] + (size_t)l * D_ * 4784;
                conv_w(win, nullptr, 4784, (bf16_t*)(ws + W_IN), 2816, 1024, 2, nullptr, gtid, gstride);
                conv_w(win, nullptr, 4784, (bf16_t*)(ws + W_G), 2048, 1024, 3, nullptr, gtid, gstride);
                conv_w(p.in[12] + (size_t)l * 512 * 1024, nullptr, 1024, (bf16_t*)(ws + W_PA), 1024, 512, 0, nullptr, gtid, gstride);
                conv_w(p.in[17] + (size_t)l * 512 * 1024, nullptr, 1024, (bf16_t*)(ws + W_PB), 1024, 512, 0, nullptr, gtid, gstride);
                conv_w(p.in[18] + (size_t)l * 1024 * 1024, nullptr, 1024, (bf16_t*)(ws + W_OUT), 1024, 1024, 0, nullptr, gtid, gstride);
                conv_w(p.in[14] + (size_t)l * 384 * 768, nullptr, 768, (bf16_t*)(ws + W_UQ), 768, 384, 0, nullptr, gtid, gstride);
                conv_w(p.in[16] + (size_t)l * 256 * 1024, nullptr, 1024, (bf16_t*)(ws + W_UK), 512, 256, 4, nullptr, gtid, gstride);
                conv_w(p.in[16] + (size_t)l * 256 * 1024, nullptr, 1024, (bf16_t*)(ws + W_UV), 512, 256, 5, nullptr, gtid, gstride);
            } else if (st == 4 && EN(4)) {
                pg8::Gemm g{(const bf16_t*)(ws + WS_H), (const bf16_t*)(ws + W_IN), T_, 2816, 1024, 1024, 1024}; pg8::StaticOrder S; S.init(T_, 2816, G, bid);
                pg8::EpiBf16 E{(bf16_t*)(ws + WS_GQKV), 1536, 6, (bf16_t*)(ws + WS_Z), 512, 8, (bf16_t*)(ws + WS_REST), 768, 1.0f};
                pg8::gemm_phase(lds, g, S, E, wv);
            } else if (st == 5 && EN(5)) {
                const float* cw = p.in[8] + (size_t)l * 5 * 1536;
                for (int u = bid; u < 2048; u += G) gdn_chunk_pre(lds, ws, cw, p.in[9] + l * 8, p.in[10] + l * 8, u, wv);
                mla_latent_pass(p, ws, l, wv);
            } else if (st == 6 && EN(6)) {
                const bf16_t* rest = (const bf16_t*)(ws + WS_REST);
                if (EN(16)) { pg8::Gemm g{rest, (const bf16_t*)(ws + W_UQ), T_, 768, 384, 768, 384}; pg8::StaticOrder S; S.init(T_, 768, G, bid);
                  pg8::EpiBf16 E{(bf16_t*)(ws + WS_Q), 768, 1000, nullptr, 0, 1000, nullptr, 0, 0.10206207261596575f * 1.4426950408889634f};
                  pg8::gemm_phase(lds, g, S, E, wv); }
                if (EN(17)) { pg8::Gemm g{rest + 384, (const bf16_t*)(ws + W_UK), T_, 512, 256, 768, 256}; pg8::StaticOrder S; S.init(T_, 512, G, bid);
                  pg8::EpiBf16 E{(bf16_t*)(ws + WS_KN), 512, 1000, nullptr, 0, 1000, nullptr, 0, 1.0f};
                  pg8::gemm_phase(lds, g, S, E, wv); }
                if (EN(18)) { pg8::Gemm g{(const bf16_t*)(ws + W_UV), rest + 384, 512, T_, 256, 256, 768}; pg8::StaticOrder S; S.init(512, T_, G, bid);
                  pg8::EpiBf16 E{(bf16_t*)(ws + WS_VT), T_, 1000, nullptr, 0, 1000, nullptr, 0, 1.0f};
                  pg8::gemm_phase(lds, g, S, E, wv); }
            } else if (st == 7 && EN(7)) {
                if (bid < 32) gdn_scan(lds, ws, bid, wv);
                const bf16_t* Q = (const bf16_t*)(ws + WS_Q); const bf16_t* Kn = (const bf16_t*)(ws + WS_KN); const bf16_t* Kr = (const bf16_t*)(ws + WS_KR);
                const bf16_t* Vt = (const bf16_t*)(ws + WS_VT); bf16_t* AO = (bf16_t*)(ws + WS_AO);
                if (G == 256) { const int xcd = bid & 7; unsigned* ctr = (unsigned*)(ws + WS_CTR) + (l * 8 + xcd) * 64;
                    const bool t0 = otid(wv) == 0; unsigned nxt = 0u; if (t0) nxt = atomicAdd(ctr, 1u);
                    for (;;) { __syncthreads(); if (t0) *(LAS unsigned*)(lds + 131072 + 32) = nxt; __syncthreads();
                        const unsigned u = *(const LAS unsigned*)(lds + 131072 + 32); if (u >= 128u) break;
                        if (t0) nxt = atomicAdd(ctr, 1u);
                        const int pair = (int)(u >> 5) * 8 + xcd; attn_unit(lds, Q, Kn, Kr, Vt, AO, (const float*)(ws + WS_COS), (const float*)(ws + WS_SIN), pair >> 3, pair & 7, (int)(u & 31), wv); } }
                else for (int u = bid; u < 1024; u += G) { const int pair = u >> 5; attn_unit(lds, Q, Kn, Kr, Vt, AO, (const float*)(ws + WS_COS), (const float*)(ws + WS_SIN), pair >> 3, pair & 7, u & 31, wv); }
            } else if (st == 8 && EN(8)) {
                gdn_gate_norm(p, ws, l, wv);
                rms_rows<false>(p.out, p.in[6] + (size_t)l * D_, ws + WS_H2, wv);
            } else if (st == 9 && EN(9)) {
                { pg8::Gemm g{(const bf16_t*)(ws + WS_AG), (const bf16_t*)(ws + W_PA), T_, 1024, 512, 512, 512}; pg8::StaticOrder S; S.init(T_, 1024, G, bid);
                  pg8::EpiBf16 E{(bf16_t*)(ws + WS_YA), 1024, 1000, nullptr, 0, 1000, nullptr, 0, 1.0f}; pg8::gemm_phase(lds, g, S, E, wv); }
                { pg8::Gemm g{(const bf16_t*)(ws + WS_AO), (const bf16_t*)(ws + W_PB), T_, 1024, 512, 512, 512}; pg8::StaticOrder S; S.init(T_, 1024, G, bid);
                  pg8::EpiBf16 E{(bf16_t*)(ws + WS_YB), 1024, 1000, nullptr, 0, 1000, nullptr, 0, 1.0f}; pg8::gemm_phase(lds, g, S, E, wv); }
            } else if (st == 10 && EN(10)) {
                pg8::Gemm g{(const bf16_t*)(ws + WS_H2), (const bf16_t*)(ws + W_G), T_, 2048, 1024, 1024, 1024}; pg8::StaticOrder S; S.init(T_, 2048, G, bid);
                pg8::EpiGate E{(const bf16_t*)(ws + WS_YA), (const bf16_t*)(ws + WS_YB), (bf16_t*)(ws + WS_Y)}; pg8::gemm_phase(lds, g, S, E, wv);
            } else if (st == 11 && EN(11)) {
                pg8::Gemm g{(const bf16_t*)(ws + WS_Y), (const bf16_t*)(ws + W_OUT), T_, 1024, 1024, 1024, 1024}; pg8::StaticOrder S; S.init(T_, 1024, G, bid);
                pg8::EpiResid E{p.out, p.out, 1.0f}; pg8::gemm_phase(lds, g, S, E, wv);
            }
        }
        if (ph + 1 < ph_hi) {
            if (ph == ph_lo) cg::this_grid().sync(); else xcd_barrier((unsigned*)(ws + WS_BAR), xst, (unsigned)G, wv);
            for (int e = 0; e < PROBE_SYNC; ++e) xcd_barrier((unsigned*)(ws + WS_BAR), xst, (unsigned)G, wv); }
    }
}

extern "C" void kernel_launch(void* const* d_in, const int* in_sizes, int n_in, void* d_out, int out_size, void* d_ws, size_t ws_size, hipStream_t stream) {
    static int grid = 0;
    if (grid == 0) {
        if (ws_size < WS_END) { fprintf(stderr, "kernel_launch: workspace too small: %zu < %zu\n", ws_size, (size_t)WS_END); grid = -1; return; }
        int dev = 0, cus = 0;
        hipGetDevice(&dev); hipDeviceGetAttribute(&cus, hipDeviceAttributeMultiprocessorCount, dev);
        if (hipFuncSetAttribute((const void*)mega, hipFuncAttributeMaxDynamicSharedMemorySize, LDS_BYTES) != hipSuccess) { fprintf(stderr, "hipFuncSetAttribute failed\n"); grid = -1; return; }
        int per_cu = 0;
        if (hipOccupancyMaxActiveBlocksPerMultiprocessor(&per_cu, (const void*)mega, 512, LDS_BYTES) != hipSuccess || per_cu < 1) { fprintf(stderr, "occupancy query: %d\n", per_cu); per_cu = 1; }
        (void)hipGetLastError();
        grid = cus;
    }
    if (grid < 0) return;
    Params p{};
    for (int i = 0; i < 24; ++i) p.in[i] = (const float*)d_in[i];
    p.out = (float*)d_out; p.ws = (unsigned char*)d_ws;
    for (int i = 0; i < 16; ++i) p.invf_rev[i] = pow(10000.0, -(double)i / 16.0) / 6.283185307179586476925286766559;
#if COOP
    (void)hipMemsetAsync((unsigned char*)d_ws + WS_BAR, 0, 3456 * 4, stream);
    p.ph_lo = 0; p.ph_hi = NPH_;
    void* args[] = {&p};
    hipError_t e = hipLaunchCooperativeKernel((const void*)mega, dim3(grid), dim3(512), args, LDS_BYTES, stream);
    if (e != hipSuccess) fprintf(stderr, "cooperative launch failed: %s\n", hipGetErrorString(e));
#else
    for (int ph = 0; ph < NPH_; ++ph) { p.ph_lo = ph; p.ph_hi = ph + 1; hipLaunchKernelGGL(mega, dim3(grid), dim3(512), LDS_BYTES, stream, p); }
#endif
}
```

```cpp
#include <hip/hip_runtime.h>
#include <hip/hip_cooperative_groups.h>
#include <cstdio>
#include <cmath>
namespace cg = cooperative_groups;

#ifndef COOP
#define COOP 1
#endif
#ifndef PHMASK
#define PHMASK 0xffffffffu
#endif
#define EN(k) ((PHMASK >> (k)) & 1u)
#ifndef PROBE_ST
#define PROBE_ST (-1)
#endif
constexpr int NS_ = 15 + (PROBE_ST >= 0 ? 1 : 0), NPH_ = 2 + 2 * NS_;
#ifndef PROBE_SYNC
#define PROBE_SYNC 0
#endif

#define LAS __attribute__((address_space(3)))
#define DI __device__ __forceinline__
typedef unsigned short bf16_t;
typedef short bf16x8 __attribute__((ext_vector_type(8)));
typedef short s16x4 __attribute__((ext_vector_type(4)));
typedef float f32x4 __attribute__((ext_vector_type(4)));
typedef float f32x16 __attribute__((ext_vector_type(16)));
typedef unsigned u32x4 __attribute__((ext_vector_type(4)));
typedef unsigned u32x2 __attribute__((ext_vector_type(2)));

constexpr int T_ = 32768, S_ = 8192, NB_ = 4, D_ = 1024, FF_ = 2816;
constexpr int LDS_BYTES = 131072 + 64;
constexpr float EPS_ = 1e-6f;
constexpr size_t MiB = 1u << 20;
constexpr size_t WS_W = 0;
constexpr size_t W_GU = WS_W, W_D = WS_W + 11 * MiB;
constexpr size_t W_IN = WS_W, W_G = WS_W + 5632 * 1024, W_PA = WS_W + 9728 * 1024, W_PB = W_PA + MiB, W_OUT = W_PB + MiB,
                 W_UQ = W_OUT + 2 * MiB, W_UK = W_UQ + MiB, W_UV = W_UK + 256 * 1024;
constexpr size_t WS_H = 20 * MiB;
constexpr size_t WS_KT = 20 * MiB, WS_OF = 52 * MiB;
constexpr size_t WS_BIG = 84 * MiB;
constexpr size_t WS_GQKV = WS_BIG, WS_Z = WS_BIG + 96 * MiB, WS_REST = WS_BIG + 128 * MiB;
constexpr size_t WS_KN = 84 * MiB, WS_VT = 116 * MiB, WS_OB = 148 * MiB;
constexpr size_t WS_H2 = 84 * MiB;
constexpr size_t WS_AO = 212 * MiB;
constexpr size_t WS_X2 = 260 * MiB;
constexpr size_t WS_QH = 260 * MiB, WS_WF = 292 * MiB, WS_WB = 324 * MiB;
constexpr size_t WS_UF = 356 * MiB, WS_UB = 388 * MiB;
constexpr size_t WS_IF = 420 * MiB, WS_IB = 436 * MiB;
constexpr size_t WS_Q = 452 * MiB;
constexpr size_t WS_BETA = 500 * MiB, WS_G = 501 * MiB, WS_KR = 502 * MiB, WS_COS = 504 * MiB, WS_SIN = 506 * MiB,
                 WS_EG = 508 * MiB, WS_EK = 509 * MiB, WS_ETOT = 510 * MiB, WS_CTR = 510 * MiB + 512 * 1024;
constexpr size_t WS_AG = 420 * MiB;
constexpr size_t WS_YA = 260 * MiB, WS_YB = 324 * MiB, WS_Y = 388 * MiB;
constexpr size_t WS_BAR = 510 * MiB + 768 * 1024;
constexpr size_t WS_END = 511 * MiB;

typedef __bf16 bf16v2 __attribute__((ext_vector_type(2)));
typedef float f32x2 __attribute__((ext_vector_type(2)));
DI unsigned pk2(float lo, float hi) { return __builtin_bit_cast(unsigned, __builtin_convertvector((f32x2){lo, hi}, bf16v2)); }
typedef __bf16 bf16v2_ __attribute__((ext_vector_type(2))); typedef float f32x2_ __attribute__((ext_vector_type(2)));
DI unsigned cvt_pk_bf16(float lo, float hi) { return __builtin_bit_cast(unsigned, __builtin_convertvector((f32x2_){lo, hi}, bf16v2_)); }
DI float bf2f(bf16_t b) { return __uint_as_float(((unsigned)b) << 16); }
DI float bflo(unsigned w) { return __uint_as_float(w << 16); }
DI float bfhi(unsigned w) { return __uint_as_float(w & 0xffff0000u); }
DI float sigmoidf_(float x) { return __builtin_amdgcn_rcpf(1.0f + __expf(-x)); }
DI float siluf_(float x) { return x * sigmoidf_(x); }
DI int otid(int wv) { int z; asm volatile("s_mov_b32 %0, 0" : "=s"(z)); return wv * 64 + (int)__builtin_amdgcn_mbcnt_hi(~0u, __builtin_amdgcn_mbcnt_lo(~0u, (unsigned)z)); }
DI float lane_xor(float v, int lane, int o) { return __int_as_float(__builtin_amdgcn_ds_bpermute((lane ^ o) << 2, __float_as_int(v))); }
DI float wave_sum(float v, int lane) {
#pragma unroll
    for (int o = 32; o >= 1; o >>= 1) v += lane_xor(v, lane, o);
    return v; }

namespace pg8 {
constexpr int BM = 256, BK = 64, HALF = 128, HTB = HALF * BK * 2, NXCD = 8, WGM = 8;
DI int lds_byte(int r, int c) { const int st = (r >> 4) * 2 + (c >> 5), rr = r & 15, cc = c & 31, ob = rr * 64 + cc * 2; return st * 1024 + (ob ^ (((ob >> 9) & 1) << 5)); }
DI void stage_rc(int b, int& R, int& C) { const int st = b / 1024, sb = b % 1024, swz = sb ^ (((sb >> 9) & 1) << 5); R = (st >> 1) * 16 + swz / 64; C = (st & 1) * 32 + (swz % 64) / 2; }
DI int perm32(int rho) { const int n = rho >> 4, i = rho & 15; return 8 * (i >> 2) + 4 * n + (i & 3); }
struct Unit { int pm, pn; };
struct Gemm { const bf16_t* A; const bf16_t* Bt; int M, N, K, lda, ldb; };
struct StaticOrder {
    int nM, nN, nwg, G, c;
    DI void init(int M, int N, int G_, int c_) { nM = M / BM; nN = N / BM; nwg = nM * nN; G = G_; c = c_; }
    DI bool next(int i, Unit& u) const {
        const long L = (long)i * G + c; if (L >= nwg) return false;
        int wgid = (int)L; { const int q = nwg / NXCD, r = nwg % NXCD, xcd = wgid % NXCD, off = wgid / NXCD; wgid = (xcd < r ? xcd * (q + 1) : r * (q + 1) + (xcd - r) * q) + off; }
        const int nig = WGM * nN, gid = wgid / nig, fm = gid * WGM, gsz = (nM - fm) < WGM ? (nM - fm) : WGM;
        u.pm = fm + ((wgid % nig) % gsz); u.pn = (wgid % nig) / gsz; return true;
    }
};
template <class Epi>
DI void gemm_phase(LAS unsigned char* lds, const Gemm g, const StaticOrder& S, const Epi& E, const int wv) {
    const int tid = otid(wv), wid = __builtin_amdgcn_readfirstlane(tid >> 6), lane = tid & 63, wr = wid >> 2, wc = wid & 3, fr = lane & 15, fq = lane >> 4;
    const int K = g.K, nt = K / BK;
    unsigned voffA[2], voffB[2];
#pragma unroll
    for (int i = 0; i < 2; ++i) { int R, C; stage_rc(tid * 16 + i * 8192, R, C); const int Rb = Epi::PERM ? ((R & ~31) + perm32(R & 31)) : R;
        voffA[i] = (unsigned)(R * g.lda + C) * 2u; voffB[i] = (unsigned)(Rb * g.ldb + C) * 2u; }
    const size_t kstep = (size_t)(BK * 2);
    const size_t hstepA = (size_t)HALF * g.lda * 2, hstepB = (size_t)HALF * g.ldb * 2;
    const size_t tstepA = 2 * hstepA, tstepB = 2 * hstepB;
    const unsigned ldsw = (unsigned)wid * 1024u;
    const int aoff = lds_byte(wr * 64 + fr, fq * 8), boff = lds_byte(wc * 32 + fr, fq * 8);
#define PG8_SA(b, h) (((b) * 2 + (h)) * HTB)
#define PG8_SB(b, h) ((4 + (b) * 2 + (h)) * HTB)
#define PG8_STAGE(bufoff, gbase, voff) do { _Pragma("unroll") for (int _i = 0; _i < 2; ++_i) \
        __builtin_amdgcn_global_load_lds((const unsigned*)((const char*)(gbase) + (voff)[_i]), (LAS unsigned*)(lds + (bufoff) + ldsw + _i * 8192), 16, 0, 0); } while (0)
#define PG8_LDA(dst, b, h) do { _Pragma("unroll") for (int m = 0; m < 4; ++m) _Pragma("unroll") for (int k = 0; k < 2; ++k) dst[m][k] = *(const LAS bf16x8*)(lds + PG8_SA(b, h) + aoff + m * 2048 + k * 1024); } while (0)
#define PG8_LDB(dst, b, h) do { _Pragma("unroll") for (int n = 0; n < 2; ++n) _Pragma("unroll") for (int k = 0; k < 2; ++k) dst[n][k] = *(const LAS bf16x8*)(lds + PG8_SB(b, h) + boff + n * 2048 + k * 1024); } while (0)
#define PG8_MMA(ai, bj, At, Bt) do { __builtin_amdgcn_s_setprio(1); _Pragma("unroll") for (int m = 0; m < 4; ++m) _Pragma("unroll") for (int n = 0; n < 2; ++n) _Pragma("unroll") for (int k = 0; k < 2; ++k) \
        acc[ai][bj][m][n] = __builtin_amdgcn_mfma_f32_16x16x32_bf16(Bt[n][k], At[m][k], acc[ai][bj][m][n], 0, 0, 0); __builtin_amdgcn_s_setprio(0); } while (0)
#define PG8_WAIT_V(n) asm volatile("s_waitcnt vmcnt(" #n ")" ::: "memory")
#define PG8_WAIT_L(n) asm volatile("s_waitcnt lgkmcnt(" #n ")" ::: "memory")
#define PG8_BAR __builtin_amdgcn_s_barrier()
#define PG8_SCHED __builtin_amdgcn_sched_barrier(0)
    Unit cur, nxt; int ui = 0;
    if (!S.next(0, cur)) return;
    f32x4 acc[2][2][4][2];
#pragma unroll
    for (int a = 0; a < 2; ++a)
#pragma unroll
        for (int b = 0; b < 2; ++b)
#pragma unroll
            for (int m = 0; m < 4; ++m)
#pragma unroll
                for (int n = 0; n < 2; ++n) acc[a][b][m][n] = (f32x4){0.f, 0.f, 0.f, 0.f};
    bf16x8 At[4][2], B0[2][2], B1[2][2];
    const char* cA = (const char*)g.A + (size_t)cur.pm * tstepA; const char* cB = (const char*)g.Bt + (size_t)cur.pn * tstepB;
    PG8_STAGE(PG8_SB(0, 0), cB, voffB); PG8_STAGE(PG8_SA(0, 0), cA, voffA); PG8_STAGE(PG8_SB(0, 1), cB + hstepB, voffB); PG8_STAGE(PG8_SA(0, 1), cA + hstepA, voffA);
    if (wr == 1) PG8_BAR;
    PG8_WAIT_V(4); PG8_BAR;
    PG8_STAGE(PG8_SB(1, 0), cB + kstep, voffB); PG8_STAGE(PG8_SA(1, 0), cA + kstep, voffA); PG8_STAGE(PG8_SB(1, 1), cB + hstepB + kstep, voffB);
    PG8_WAIT_V(6); PG8_BAR;
    for (;;) {
        const bool has_next = S.next(ui + 1, nxt);
        const char* nA = has_next ? (const char*)g.A + (size_t)nxt.pm * tstepA : cA; const char* nB = has_next ? (const char*)g.Bt + (size_t)nxt.pn * tstepB : cB;
        for (int t = 0; t < nt; t += 2) {
            const bool last = (t == nt - 2);
            const char* a1 = cA + (size_t)(t + 1) * kstep;
            const char* a2 = last ? nA : cA + (size_t)(t + 2) * kstep; const char* b2 = last ? nB : cB + (size_t)(t + 2) * kstep;
            const char* a3 = a2 + kstep; const char* b3 = b2 + kstep;
            PG8_LDB(B0, 0, 0); PG8_SCHED; PG8_LDA(At, 0, 0); PG8_STAGE(PG8_SA(1, 1), a1 + hstepA, voffA);
            PG8_WAIT_L(8); PG8_BAR; PG8_WAIT_L(0); PG8_MMA(0, 0, At, B0); PG8_BAR; PG8_SCHED;
            PG8_LDB(B1, 0, 1); PG8_STAGE(PG8_SB(0, 0), b2, voffB);
            PG8_BAR; PG8_WAIT_L(0); PG8_MMA(0, 1, At, B1); PG8_BAR;
            PG8_LDA(At, 0, 1); PG8_STAGE(PG8_SA(0, 0), a2, voffA);
            PG8_BAR; PG8_WAIT_L(0); PG8_MMA(1, 0, At, B0); PG8_BAR; PG8_SCHED;
            PG8_STAGE(PG8_SB(0, 1), b2 + hstepB, voffB);
            PG8_WAIT_V(6); PG8_BAR; PG8_MMA(1, 1, At, B1); PG8_BAR;
            PG8_LDB(B0, 1, 0); PG8_SCHED; PG8_LDA(At, 1, 0); PG8_STAGE(PG8_SA(0, 1), a2 + hstepA, voffA);
            PG8_WAIT_L(8); PG8_BAR; PG8_WAIT_L(0); PG8_MMA(0, 0, At, B0); PG8_BAR; PG8_SCHED;
            PG8_LDB(B1, 1, 1); PG8_STAGE(PG8_SB(1, 0), b3, voffB);
            PG8_BAR; PG8_WAIT_L(0); PG8_MMA(0, 1, At, B1); PG8_BAR;
            PG8_LDA(At, 1, 1); PG8_STAGE(PG8_SA(1, 0), a3, voffA);
            PG8_BAR; PG8_WAIT_L(0); PG8_MMA(1, 0, At, B0); PG8_BAR; PG8_SCHED;
            PG8_STAGE(PG8_SB(1, 1), b3 + hstepB, voffB);
            PG8_WAIT_V(6); PG8_BAR; PG8_MMA(1, 1, At, B1); PG8_BAR;
        }
        E(acc, cur, wr, wc, fr, fq);
        if (!has_next) break;
#pragma unroll
        for (int a = 0; a < 2; ++a)
#pragma unroll
            for (int b = 0; b < 2; ++b)
#pragma unroll
                for (int m = 0; m < 4; ++m)
#pragma unroll
                    for (int n = 0; n < 2; ++n) acc[a][b][m][n] = (f32x4){0.f, 0.f, 0.f, 0.f};
        cur = nxt; cA = nA; cB = nB; ++ui;
    }
    PG8_WAIT_V(0);
    if (wr == 0) PG8_BAR;
    PG8_BAR;
#undef PG8_SA
#undef PG8_SB
#undef PG8_STAGE
#undef PG8_LDA
#undef PG8_LDB
#undef PG8_MMA
#undef PG8_WAIT_V
#undef PG8_WAIT_L
#undef PG8_BAR
#undef PG8_SCHED
}
typedef f32x4 Acc[2][2][4][2];

struct EpiSwiglu {
    static constexpr bool PERM = true; bf16_t* O; int ldc;
    DI void operator()(const Acc& acc, const Unit& u, int wr, int wc, int fr, int fq) const {
        const int row0 = u.pm * BM + wr * 64 + fr, col0 = u.pn * 128 + wc * 32 + 8 * fq;
#pragma unroll
        for (int ai = 0; ai < 2; ++ai)
#pragma unroll
            for (int m = 0; m < 4; ++m) {
                bf16_t* rowp = O + (size_t)(row0 + ai * HALF + m * 16) * ldc + col0; float r[8];
#pragma unroll
                for (int n = 0; n < 2; ++n)
#pragma unroll
                    for (int j = 0; j < 4; j += 2) {
                        const f32x2 g2 = {acc[ai][0][m][n][j], acc[ai][0][m][n][j + 1]}, u2 = {acc[ai][1][m][n][j], acc[ai][1][m][n][j + 1]};
                        const f32x2 e2 = g2 * -1.4426950408889634f; f32x2 t; t.x = __builtin_amdgcn_exp2f(e2.x); t.y = __builtin_amdgcn_exp2f(e2.y); t = t + 1.0f;
                        f32x2 rc; rc.x = __builtin_amdgcn_rcpf(t.x); rc.y = __builtin_amdgcn_rcpf(t.y); const f32x2 o = (g2 * u2) * rc;
                        r[n * 4 + j] = o.x; r[n * 4 + j + 1] = o.y; }
                u32x4 w; w.x = cvt_pk_bf16(r[0], r[1]); w.y = cvt_pk_bf16(r[2], r[3]); w.z = cvt_pk_bf16(r[4], r[5]); w.w = cvt_pk_bf16(r[6], r[7]);
                *(u32x4*)rowp = w; }
    }
};
struct EpiResid {
    static constexpr bool PERM = false; const float* X; float* Y; float alpha;
    DI void operator()(const Acc& acc, const Unit& u, int wr, int wc, int fr, int fq) const {
        const int row0 = u.pm * BM + wr * 64 + fr, col0 = u.pn * BM + wc * 32 + 4 * fq;
#pragma unroll
        for (int ai = 0; ai < 2; ++ai)
#pragma unroll
            for (int m = 0; m < 4; ++m) { const size_t off = (size_t)(row0 + ai * HALF + m * 16) * D_ + col0;
#pragma unroll
                for (int bj = 0; bj < 2; ++bj)
#pragma unroll
                    for (int n = 0; n < 2; ++n) { const f32x4 xv = *(const f32x4*)(X + off + bj * HALF + n * 16); *(f32x4*)(Y + off + bj * HALF + n * 16) = xv + alpha * acc[ai][bj][m][n]; }
                asm volatile("" ::: "memory"); }
    }
};
struct EpiBf16 {
    static constexpr bool PERM = true;
    bf16_t* O0; int ld0; int t1; bf16_t* O1; int ld1; int t2; bf16_t* O2; int ld2; float scale;
    DI void operator()(const Acc& acc, const Unit& u, int wr, int wc, int fr, int fq) const {
        bf16_t* base = O0; int ld = ld0, colt = u.pn * BM;
        if (u.pn >= t2) { base = O2; ld = ld2; colt = (u.pn - t2) * BM; } else if (u.pn >= t1) { base = O1; ld = ld1; colt = (u.pn - t1) * BM; }
        const int row0 = u.pm * BM + wr * 64 + fr, col0 = colt + wc * 32 + 8 * fq;
#pragma unroll
        for (int ai = 0; ai < 2; ++ai)
#pragma unroll
            for (int m = 0; m < 4; ++m) { const int row = row0 + ai * HALF + m * 16; bf16_t* rowp = base + (size_t)row * ld + col0;
#pragma unroll
                for (int bj = 0; bj < 2; ++bj) { const f32x4 v0 = acc[ai][bj][m][0] * scale, v1 = acc[ai][bj][m][1] * scale;
                    u32x4 w; w.x = cvt_pk_bf16(v0[0], v0[1]); w.y = cvt_pk_bf16(v0[2], v0[3]); w.z = cvt_pk_bf16(v1[0], v1[1]); w.w = cvt_pk_bf16(v1[2], v1[3]);
                    *(u32x4*)(rowp + bj * HALF) = w; } }
    }
};
struct EpiGate {
    static constexpr bool PERM = true; const bf16_t* YA; const bf16_t* YB; bf16_t* Y;
    DI void operator()(const Acc& acc, const Unit& u, int wr, int wc, int fr, int fq) const {
        const int row0 = u.pm * BM + wr * 64 + fr, col0 = u.pn * 128 + wc * 32 + 8 * fq;
#pragma unroll
        for (int ai = 0; ai < 2; ++ai)
#pragma unroll
            for (int m = 0; m < 4; ++m) { const size_t off = (size_t)(row0 + ai * HALF + m * 16) * D_ + col0;
                const u32x4 a = *(const u32x4*)(YA + off), b = *(const u32x4*)(YB + off); float r[8];
#pragma unroll
                for (int n = 0; n < 2; ++n)
#pragma unroll
                    for (int jj = 0; jj < 2; ++jj) { const unsigned aw = a[n * 2 + jj], bw = b[n * 2 + jj];
                        const f32x2 ga = {acc[ai][0][m][n][jj * 2], acc[ai][0][m][n][jj * 2 + 1]}, gb = {acc[ai][1][m][n][jj * 2], acc[ai][1][m][n][jj * 2 + 1]};
                        const f32x2 ea = ga * -1.4426950408889634f, eb = gb * -1.4426950408889634f; f32x2 ta, tb;
                        ta.x = __builtin_amdgcn_exp2f(ea.x); ta.y = __builtin_amdgcn_exp2f(ea.y); tb.x = __builtin_amdgcn_exp2f(eb.x); tb.y = __builtin_amdgcn_exp2f(eb.y);
                        ta = ta + 1.0f; tb = tb + 1.0f; f32x2 ra, rb; ra.x = __builtin_amdgcn_rcpf(ta.x); ra.y = __builtin_amdgcn_rcpf(ta.y); rb.x = __builtin_amdgcn_rcpf(tb.x); rb.y = __builtin_amdgcn_rcpf(tb.y);
                        const f32x2 ya = {bflo(aw), bfhi(aw)}, yb = {bflo(bw), bfhi(bw)}; const f32x2 o = ra * ya + rb * yb;
                        r[n * 4 + jj * 2] = o.x; r[n * 4 + jj * 2 + 1] = o.y; }
                u32x4 w; w.x = cvt_pk_bf16(r[0], r[1]); w.y = cvt_pk_bf16(r[2], r[3]); w.z = cvt_pk_bf16(r[4], r[5]); w.w = cvt_pk_bf16(r[6], r[7]);
                *(u32x4*)(Y + off) = w;
                asm volatile("" ::: "memory"); }
    }
};
}

struct Params { const float* in[24]; float* out; unsigned char* ws; double invf_rev[16]; int ph_lo, ph_hi; };

DI int conv_col(int n, int mode, bool& second) {
    second = false; int col = n;
    if (mode == 1) { const int t = n >> 8, r = n & 255; col = t * 128 + (r & 127); second = r >= 128; }
    else if (mode == 2) { if (n < 2048) col = n; else if (n < 2720) col = 2064 + (n - 2048); else if (n < 2736) col = 2048 + (n - 2720); else col = -1; }
    else if (mode == 3) { const int t = n >> 8, r = n & 255; col = 2736 + ((r >= 128) ? 1024 : 0) + t * 128 + (r & 127); }
    else if (mode == 4) { col = (n >> 6) * 128 + (n & 63); }
    else if (mode == 5) { col = (n >> 6) * 128 + 64 + (n & 63); }
    return col;
}
DI void conv_w(const float* src0, const float* src1, int ldsrc, bf16_t* dst, int N, int K, int mode, const float* kscale, int gtid, int gstride) {
    const int total = N * (K / 8);
    for (int idx = gtid; idx < total; idx += 2 * gstride) {
        const int idx2 = idx + gstride; const bool has2 = idx2 < total;
        const int nA = idx % N, kA = idx / N, nB = has2 ? idx2 % N : nA, kB = has2 ? idx2 / N : kA;
        bool sA, sB; const int cA = conv_col(nA, mode, sA), cB = conv_col(nB, mode, sB);
        const float* pA = sA ? src1 : src0; const float* pB = sB ? src1 : src0;
        float vA[8], vB[8];
#pragma unroll
        for (int j = 0; j < 8; ++j) { vA[j] = (cA >= 0) ? pA[(size_t)(kA * 8 + j) * ldsrc + cA] : 0.f; vB[j] = (cB >= 0) ? pB[(size_t)(kB * 8 + j) * ldsrc + cB] : 0.f; }
        if (kscale) {
#pragma unroll
            for (int j = 0; j < 8; ++j) { vA[j] *= kscale[kA * 8 + j]; vB[j] *= kscale[kB * 8 + j]; } }
        u32x4 w; w.x = cvt_pk_bf16(vA[0], vA[1]); w.y = cvt_pk_bf16(vA[2], vA[3]); w.z = cvt_pk_bf16(vA[4], vA[5]); w.w = cvt_pk_bf16(vA[6], vA[7]);
        *(u32x4*)(dst + (size_t)nA * K + kA * 8) = w;
        if (has2) { u32x4 w2; w2.x = cvt_pk_bf16(vB[0], vB[1]); w2.y = cvt_pk_bf16(vB[2], vB[3]); w2.z = cvt_pk_bf16(vB[4], vB[5]); w2.w = cvt_pk_bf16(vB[6], vB[7]);
            *(u32x4*)(dst + (size_t)nB * K + kB * 8) = w2; }
    }
}

template <bool F32OUT>
DI void rms_rows(const float* x, const float* w, void* out, const int wv) {
    const int tid_ = otid(wv); const int lane = tid_ & 63, wid = tid_ >> 6;
    f32x4 wv4[4];
#pragma unroll
    for (int i = 0; i < 4; ++i) wv4[i] = *(const f32x4*)(w + i * 256 + lane * 4);
    for (int row = (blockIdx.x * 8 + wid) * 4; row < T_; row += gridDim.x * 32) {
        f32x4 v[4][4]; float ss[4] = {0.f, 0.f, 0.f, 0.f};
#pragma unroll
        for (int rr = 0; rr < 4; ++rr)
#pragma unroll
            for (int i = 0; i < 4; ++i) v[rr][i] = *(const f32x4*)(x + (size_t)(row + rr) * D_ + i * 256 + lane * 4);
#pragma unroll
        for (int rr = 0; rr < 4; ++rr)
#pragma unroll
            for (int i = 0; i < 4; ++i) ss[rr] += v[rr][i][0] * v[rr][i][0] + v[rr][i][1] * v[rr][i][1] + v[rr][i][2] * v[rr][i][2] + v[rr][i][3] * v[rr][i][3];
#pragma unroll
        for (int o = 32; o >= 1; o >>= 1) { ss[0] += lane_xor(ss[0], lane, o); ss[1] += lane_xor(ss[1], lane, o); ss[2] += lane_xor(ss[2], lane, o); ss[3] += lane_xor(ss[3], lane, o); }
#pragma unroll
        for (int rr = 0; rr < 4; ++rr) { const float rstd = rsqrtf(ss[rr] * (1.0f / D_) + EPS_);
#pragma unroll
            for (int i = 0; i < 4; ++i) { const f32x4 y = v[rr][i] * rstd * wv4[i];
                if (F32OUT) *(f32x4*)((float*)out + (size_t)(row + rr) * D_ + i * 256 + lane * 4) = y;
                else { u32x2 pk; pk.x = cvt_pk_bf16(y[0], y[1]); pk.y = cvt_pk_bf16(y[2], y[3]); *(u32x2*)((bf16_t*)out + (size_t)(row + rr) * D_ + i * 256 + lane * 4) = pk; } } }
    }
}

DI void mla_latent_pass(const Params& p, unsigned char* ws, int l, const int wv) {
    const int tid_ = otid(wv); const int lane = tid_ & 63, wid = tid_ >> 6;
    bf16_t* restw = (bf16_t*)(ws + WS_REST); bf16_t* kr = (bf16_t*)(ws + WS_KR); const float* qnw = p.in[13] + l * 384; const float* kvnw = p.in[15] + l * 256;
    const float* cosT = (const float*)(ws + WS_COS); const float* sinT = (const float*)(ws + WS_SIN);
    for (int t0 = (blockIdx.x * 8 + wid) * 2; t0 < T_; t0 += gridDim.x * 16) {
        float cq[2][6], ck[2][4], s1[2] = {0.f, 0.f}, s2[2] = {0.f, 0.f};
#pragma unroll
        for (int rr = 0; rr < 2; ++rr) { const bf16_t* r = restw + (size_t)(t0 + rr) * 768;
#pragma unroll
            for (int i = 0; i < 6; ++i) cq[rr][i] = bf2f(r[i * 64 + lane]);
#pragma unroll
            for (int i = 0; i < 4; ++i) ck[rr][i] = bf2f(r[384 + i * 64 + lane]); }
#pragma unroll
        for (int rr = 0; rr < 2; ++rr) {
#pragma unroll
            for (int i = 0; i < 6; ++i) s1[rr] += cq[rr][i] * cq[rr][i];
#pragma unroll
            for (int i = 0; i < 4; ++i) s2[rr] += ck[rr][i] * ck[rr][i]; }
#pragma unroll
        for (int o = 32; o >= 1; o >>= 1) { s1[0] += lane_xor(s1[0], lane, o); s1[1] += lane_xor(s1[1], lane, o); s2[0] += lane_xor(s2[0], lane, o); s2[1] += lane_xor(s2[1], lane, o); }
#pragma unroll
        for (int rr = 0; rr < 2; ++rr) { const int t = t0 + rr; bf16_t* r = restw + (size_t)t * 768;
            const float r1 = rsqrtf(s1[rr] * (1.0f / 384.f) + EPS_), r2 = rsqrtf(s2[rr] * (1.0f / 256.f) + EPS_);
#pragma unroll
            for (int i = 0; i < 6; ++i) r[i * 64 + lane] = (bf16_t)(cvt_pk_bf16(cq[rr][i] * r1 * qnw[i * 64 + lane], 0.f) & 0xffff);
#pragma unroll
            for (int i = 0; i < 4; ++i) r[384 + i * 64 + lane] = (bf16_t)(cvt_pk_bf16(ck[rr][i] * r2 * kvnw[i * 64 + lane], 0.f) & 0xffff);
            if (lane < 16) { const float x1 = bf2f(r[640 + lane]), x2 = bf2f(r[656 + lane]), c = cosT[(size_t)t * 16 + lane], sn = sinT[(size_t)t * 16 + lane];
                const unsigned w = cvt_pk_bf16(x1 * c - x2 * sn, x2 * c + x1 * sn); kr[(size_t)t * 32 + lane] = (bf16_t)(w & 0xffff); kr[(size_t)t * 32 + 16 + lane] = (bf16_t)(w >> 16); } }
    }
}

constexpr int CP_QS = 0, CP_KS = 17408, CP_KT = 34816, CP_VT = CP_KT + 18432, CP_T = CP_VT + 18432, CP_SM = CP_T + 36864;
DI bf16x8 pack8n(const f32x16& x, int s) {
    u32x4 pk;
    if (s == 0) { pk.x = pk2(x[0], x[1]); pk.y = pk2(x[2], x[3]); pk.z = pk2(x[4], x[5]); pk.w = pk2(x[6], x[7]); }
    else { pk.x = pk2(x[8], x[9]); pk.y = pk2(x[10], x[11]); pk.z = pk2(x[12], x[13]); pk.w = pk2(x[14], x[15]); }
    return __builtin_bit_cast(bf16x8, pk);
}
DI void tri_solve(const LAS float* L, LAS bf16_t* Tu, LAS bf16_t* Tw, int c, const LAS float* bet, const LAS float* gc, bool rev) {
    float Tc[64];
#pragma unroll
    for (int i = 0; i < 64; ++i) {
        float a = (i == c) ? 1.f : 0.f, a1 = 0.f, a2 = 0.f, a3 = 0.f;
#pragma unroll
        for (int j4 = 0; j4 < (i + 3) / 4; ++j4) { const f32x4 lv = *(const LAS f32x4*)(L + i * 64 + j4 * 4);
            if (j4 * 4 + 0 < i) a -= lv[0] * Tc[j4 * 4 + 0];
            if (j4 * 4 + 1 < i) a1 -= lv[1] * Tc[j4 * 4 + 1];
            if (j4 * 4 + 2 < i) a2 -= lv[2] * Tc[j4 * 4 + 2];
            if (j4 * 4 + 3 < i) a3 -= lv[3] * Tc[j4 * 4 + 3]; }
        a = (a + a1) + (a2 + a3);
        asm volatile("" : "+v"(a));
        Tc[i] = a;
    }
    const int col = rev ? 63 - c : c; const float su = bet[col], sw = su * __expf(gc[col]);
#pragma unroll
    for (int i = 0; i < 64; ++i) { const int row = rev ? 63 - i : i; const unsigned w = pk2(Tc[i] * su, Tc[i] * sw);
        Tu[row * 72 + col] = (bf16_t)(w & 0xffff); Tw[row * 72 + col] = (bf16_t)(w >> 16); }
}
DI void gdn_chunk_pre(LAS unsigned char* lds, unsigned char* ws, const float* cw, const float* Alog, const float* dtb, int unit, const int wv) {
    const int b = unit >> 9, n = (unit >> 2) & 127, hh = unit & 3; const size_t t0 = (size_t)b * S_ + (size_t)n * 64;
    const bf16_t* gqkv = (const bf16_t*)(ws + WS_GQKV); const bf16_t* rest = (const bf16_t*)(ws + WS_REST); bf16_t* qh = (bf16_t*)(ws + WS_QH);
    const int tid = otid(wv), wid = tid >> 6, lane = tid & 63, r = lane & 31, h = lane >> 5;
    LAS bf16_t* kT = (LAS bf16_t*)(lds + CP_KT); LAS bf16_t* vT = (LAS bf16_t*)(lds + CP_VT);
    LAS float* sm = (LAS float*)(lds + CP_SM); LAS float* betf = sm; LAS float* betb = sm + 64; LAS float* gcf = sm + 128; LAS float* gcb = sm + 192;
    {
        const int pc = tid & 15, ig = tid >> 4, sp0 = n * 64 + 2 * ig - 2;
#pragma unroll
        for (int part = 0; part < 3; ++part) {
            const int col = part * 512 + hh * 128 + pc * 8;
            f32x4 wt[5][2];
#pragma unroll
            for (int j = 0; j < 5; ++j) { wt[j][0] = *(const f32x4*)(cw + j * 1536 + col); wt[j][1] = *(const f32x4*)(cw + j * 1536 + col + 4); }
            u32x4 rows[6];
#pragma unroll
            for (int rr = 0; rr < 6; ++rr) { const int sp = sp0 + rr; rows[rr] = (sp >= 0 && sp < S_) ? *(const u32x4*)(gqkv + ((size_t)b * S_ + sp) * 1536 + col) : (u32x4){0u, 0u, 0u, 0u}; }
#pragma unroll
            for (int tk = 0; tk < 2; ++tk) {
                float y[8];
#pragma unroll
                for (int e = 0; e < 8; ++e) y[e] = 0.f;
#pragma unroll
                for (int j = 0; j < 5; ++j)
#pragma unroll
                    for (int e = 0; e < 4; ++e) { const unsigned w = rows[tk + j][e]; y[2 * e] += bflo(w) * wt[j][(2 * e) >> 2][(2 * e) & 3]; y[2 * e + 1] += bfhi(w) * wt[j][(2 * e + 1) >> 2][(2 * e + 1) & 3]; }
                float ss = 0.f;
#pragma unroll
                for (int e = 0; e < 8; ++e) { y[e] = siluf_(y[e]); ss += y[e] * y[e]; }
                float sc = 1.f;
                if (part < 2) { ss += lane_xor(ss, lane, 1); ss += lane_xor(ss, lane, 2); ss += lane_xor(ss, lane, 4); ss += lane_xor(ss, lane, 8);
                    sc = rsqrtf(ss + EPS_) * (part == 0 ? 0.08838834764831845f : 1.f); }
                u32x4 o; o.x = pk2(y[0] * sc, y[1] * sc); o.y = pk2(y[2] * sc, y[3] * sc); o.z = pk2(y[4] * sc, y[5] * sc); o.w = pk2(y[6] * sc, y[7] * sc);
                const int i = 2 * ig + tk;
                if (part == 0) { *(LAS u32x4*)(lds + CP_QS + i * 272 + pc * 16) = o; *(u32x4*)(qh + (t0 + i) * 512 + hh * 128 + pc * 8) = o; }
                else { if (part == 1) *(LAS u32x4*)(lds + CP_KS + i * 272 + pc * 16) = o;
                    LAS bf16_t* dstT = (part == 1) ? kT : vT;
#pragma unroll
                    for (int e = 0; e < 4; ++e) { dstT[(pc * 8 + 2 * e) * 72 + i] = (bf16_t)(o[e] & 0xffff); dstT[(pc * 8 + 2 * e + 1) * 72 + i] = (bf16_t)(o[e] >> 16); } }
            }
        }
        if (tid < 128) { const int i = tid & 63, dir = tid >> 6, di = dir * 4 + hh;
            const float bb = bf2f(rest[(t0 + i) * 768 + 672 + di]), aa = bf2f(rest[(t0 + i) * 768 + 680 + di]);
            const float xx = aa + dtb[di]; const float ey = __expf(-fabsf(xx)); const float sp = fmaxf(xx, 0.f) + (ey < 0.01f ? ey * (1.f - ey * (0.5f - ey * 0.33333333f)) : __logf(1.f + ey));
            (dir ? betb : betf)[i] = sigmoidf_(bb); (dir ? gcb : gcf)[i] = -__expf(Alog[di]) * sp; }
    }
    __syncthreads();
    if (wv < 2) {
        LAS float* gp = wv ? gcb : gcf; const int idx = wv ? 63 - lane : lane; float v = gp[idx];
#pragma unroll
        for (int o = 1; o < 64; o <<= 1) { const float t = __int_as_float(__builtin_amdgcn_ds_bpermute((lane - o) << 2, __float_as_int(v))); if (lane >= o) v += t; }
        gp[idx] = v; }
    const int mat = wid >> 2, bi = (wid >> 1) & 1, bj = wid & 1;
    f32x16 acc;
#pragma unroll
    for (int i = 0; i < 16; ++i) acc[i] = 0.f;
#pragma unroll
    for (int ks = 0; ks < 8; ++ks) { const bf16x8 a = *(const LAS bf16x8*)(lds + (mat ? CP_QS : CP_KS) + (32 * bi + r) * 272 + (ks * 16 + 8 * h) * 2);
        const bf16x8 bb = *(const LAS bf16x8*)(lds + CP_KS + (32 * bj + r) * 272 + (ks * 16 + 8 * h) * 2);
        acc = __builtin_amdgcn_mfma_f32_32x32x16_bf16(a, bb, acc, 0, 0, 0); }
    __syncthreads();
    LAS float* Lf = (LAS float*)(lds + CP_QS); LAS float* Lb = Lf + 4096;
    { const int j = 32 * bj + r; const float gfj = gcf[j], gbj = gcb[j];
        bf16_t* inf = (bf16_t*)(ws + WS_IF); bf16_t* inb = (bf16_t*)(ws + WS_IB);
#pragma unroll
        for (int x = 0; x < 16; ++x) { const int i = 32 * bi + (x & 3) + 8 * (x >> 2) + 4 * h; const float v = acc[x];
            const float df = __expf(fminf(gcf[i] - gfj, 0.f)), db = __expf(fminf(gcb[i] - gbj, 0.f));
            if (mat == 0) { Lf[i * 64 + j] = (j < i) ? betf[i] * v * df : 0.f; Lb[(63 - i) * 64 + (63 - j)] = (j > i) ? betb[i] * v * db : 0.f; }
            else { const size_t o = ((t0 + i) * 4 + hh) * 64 + j; inf[o] = (bf16_t)(pk2((j <= i) ? v * df : 0.f, 0.f) & 0xffff); inb[o] = (bf16_t)(pk2((j >= i) ? v * db : 0.f, 0.f) & 0xffff); } } }
    __syncthreads();
    if (wv == 0) tri_solve(Lf, (LAS bf16_t*)(lds + CP_T), (LAS bf16_t*)(lds + CP_T + 9216), lane, betf, gcf, false);
    else if (wv == 1) tri_solve(Lb, (LAS bf16_t*)(lds + CP_T + 18432), (LAS bf16_t*)(lds + CP_T + 27648), lane, betb, gcb, true);
    else if (wv == 2) {
        float* eg = (float*)(ws + WS_EG); float* ek = (float*)(ws + WS_EK); float* etot = (float*)(ws + WS_ETOT);
        const float gtf = gcf[63], gtb = gcb[0];
        eg[(t0 + lane) * 8 + hh] = __expf(gcf[lane]); ek[(t0 + lane) * 8 + hh] = __expf(gtf - gcf[lane]);
        eg[(t0 + lane) * 8 + 4 + hh] = __expf(gcb[lane]); ek[(t0 + lane) * 8 + 4 + hh] = __expf(gtb - gcb[lane]);
        if (lane == 0) { etot[((size_t)b * 128 + n) * 8 + hh] = __expf(gtf); etot[((size_t)b * 128 + n) * 8 + 4 + hh] = __expf(gtb); }
    } else if (wv >= 4) {
        bf16_t* kTg = (bf16_t*)(ws + WS_KT);
        for (int ch = tid - 256; ch < 1024; ch += 256) { const int dk = ch >> 3, pc = ch & 7;
            *(u32x4*)(kTg + ((size_t)(b * 4 + hh) * 128 + dk) * S_ + (size_t)n * 64 + pc * 8) = *(const LAS u32x4*)(lds + CP_KT + dk * 144 + pc * 16); }
    }
    __syncthreads();
    { const int dir = wid >> 2, wq = wid & 3; const LAS unsigned char* Tu = lds + CP_T + dir * 18432; const LAS unsigned char* Tw = Tu + 9216;
        if (wq < 2) { const int tb = wq; bf16_t* uT = (bf16_t*)(ws + (dir ? WS_UB : WS_UF));
#pragma unroll
            for (int nb = 0; nb < 4; ++nb) { f32x16 c;
#pragma unroll
                for (int i = 0; i < 16; ++i) c[i] = 0.f;
#pragma unroll
                for (int s = 0; s < 4; ++s) { const bf16x8 a = *(const LAS bf16x8*)(Tu + (32 * tb + r) * 144 + (16 * s + 8 * h) * 2);
                    const bf16x8 bb = *(const LAS bf16x8*)(lds + CP_VT + (32 * nb + r) * 144 + (16 * s + 8 * h) * 2);
                    c = __builtin_amdgcn_mfma_f32_32x32x16_bf16(a, bb, c, 0, 0, 0); }
                bf16_t* dst = uT + ((size_t)(b * 4 + hh) * 128 + 32 * nb + r) * S_ + (size_t)n * 64 + 32 * tb + 4 * h;
#pragma unroll
                for (int g4 = 0; g4 < 4; ++g4) { u32x2 w; w.x = pk2(c[4 * g4], c[4 * g4 + 1]); w.y = pk2(c[4 * g4 + 2], c[4 * g4 + 3]); *(u32x2*)(dst + 8 * g4) = w; } }
        } else { const int ib = wq - 2; bf16_t* wd = (bf16_t*)(ws + (dir ? WS_WB : WS_WF));
#pragma unroll
            for (int kb = 0; kb < 4; ++kb) { f32x16 c;
#pragma unroll
                for (int i = 0; i < 16; ++i) c[i] = 0.f;
#pragma unroll
                for (int s = 0; s < 4; ++s) { const bf16x8 a = *(const LAS bf16x8*)(lds + CP_KT + (32 * kb + r) * 144 + (16 * s + 8 * h) * 2);
                    const bf16x8 bb = *(const LAS bf16x8*)(Tw + (32 * ib + r) * 144 + (16 * s + 8 * h) * 2);
                    c = __builtin_amdgcn_mfma_f32_32x32x16_bf16(a, bb, c, 0, 0, 0); }
                bf16_t* dst = wd + (t0 + 32 * ib + r) * 512 + hh * 128 + 32 * kb + 4 * h;
#pragma unroll
                for (int g4 = 0; g4 < 4; ++g4) { u32x2 w; w.x = pk2(c[4 * g4], c[4 * g4 + 1]); w.y = pk2(c[4 * g4 + 2], c[4 * g4 + 3]); *(u32x2*)(dst + 8 * g4) = w; } }
        } }
    __syncthreads();
}

constexpr int SC_W = 0, SC_Q = 16896, SC_KT = 33792, SC_IN = SC_KT + 17408, SC_EG = SC_IN + 8704, SC_BUF = SC_EG + 528;
DI void gdn_scan(LAS unsigned char* lds, unsigned char* ws, int chain, const int wv) {
    const int b = chain >> 3, hh = (chain >> 1) & 3, dir = chain & 1;
    const bf16_t* wg = (const bf16_t*)(ws + (dir ? WS_WB : WS_WF)); const bf16_t* qg = (const bf16_t*)(ws + WS_QH); const bf16_t* kTg = (const bf16_t*)(ws + WS_KT);
    const bf16_t* ing = (const bf16_t*)(ws + (dir ? WS_IB : WS_IF)); const bf16_t* uTg = (const bf16_t*)(ws + (dir ? WS_UB : WS_UF));
    const float* egg = (const float*)(ws + WS_EG); const float* ekg = (const float*)(ws + WS_EK); const float* etg = (const float*)(ws + WS_ETOT);
    bf16_t* out = (bf16_t*)(ws + (dir ? WS_OB : WS_OF));
    const int tid = otid(wv), wid = tid >> 6, lane = tid & 63, r = lane & 31, h = lane >> 5;
    const int di = dir * 4 + hh;
    if (wv >= 4) {
        const int lt = tid - 256;
        for (int c = -1; c < 127; ++c) {
            const int n = dir ? 127 - (c + 1) : (c + 1); const size_t t0 = (size_t)b * S_ + (size_t)n * 64;
            LAS unsigned char* buf = lds + ((c + 1) & 1) * SC_BUF;
            u32x4 rw[4], rq[4], rk[4], ri[2];
#pragma unroll
            for (int k = 0; k < 4; ++k) { const int ch = lt + k * 256, i = ch >> 4, pc = ch & 15; const size_t src = (t0 + i) * 512 + hh * 128 + pc * 8; rw[k] = *(const u32x4*)(wg + src); rq[k] = *(const u32x4*)(qg + src); }
#pragma unroll
            for (int k = 0; k < 4; ++k) { const int ch = lt + k * 256, dk = ch >> 3, pc = ch & 7; rk[k] = *(const u32x4*)(kTg + ((size_t)(b * 4 + hh) * 128 + dk) * S_ + (size_t)n * 64 + pc * 8); }
#pragma unroll
            for (int k = 0; k < 2; ++k) { const int ch = lt + k * 256, i = ch >> 3, pc = ch & 7; ri[k] = *(const u32x4*)(ing + ((t0 + i) * 4 + hh) * 64 + pc * 8); }
            float ev = 0.f;
            if (lt < 64) ev = egg[(t0 + lt) * 8 + di]; else if (lt < 128) ev = ekg[(t0 + lt - 64) * 8 + di]; else if (lt == 128) ev = etg[((size_t)b * 128 + n) * 8 + di];
#pragma unroll
            for (int k = 0; k < 4; ++k) { const int ch = lt + k * 256, i = ch >> 4, pc = ch & 15;
                *(LAS u32x2*)(buf + SC_W + i * 264 + pc * 16) = (u32x2){rw[k].x, rw[k].y}; *(LAS u32x2*)(buf + SC_W + i * 264 + pc * 16 + 8) = (u32x2){rw[k].z, rw[k].w};
                *(LAS u32x2*)(buf + SC_Q + i * 264 + pc * 16) = (u32x2){rq[k].x, rq[k].y}; *(LAS u32x2*)(buf + SC_Q + i * 264 + pc * 16 + 8) = (u32x2){rq[k].z, rq[k].w}; }
#pragma unroll
            for (int k = 0; k < 4; ++k) { const int ch = lt + k * 256, dk = ch >> 3, pc = ch & 7;
                *(LAS u32x2*)(buf + SC_KT + dk * 136 + pc * 16) = (u32x2){rk[k].x, rk[k].y}; *(LAS u32x2*)(buf + SC_KT + dk * 136 + pc * 16 + 8) = (u32x2){rk[k].z, rk[k].w}; }
#pragma unroll
            for (int k = 0; k < 2; ++k) { const int ch = lt + k * 256, i = ch >> 3, pc = ch & 7;
                *(LAS u32x2*)(buf + SC_IN + i * 136 + pc * 16) = (u32x2){ri[k].x, ri[k].y}; *(LAS u32x2*)(buf + SC_IN + i * 136 + pc * 16 + 8) = (u32x2){ri[k].z, ri[k].w}; }
            if (lt <= 128) *(LAS float*)(buf + SC_EG + lt * 4) = ev;
            __syncthreads();
        }
        __syncthreads();
    } else {
        const int nb = wid;
        f32x16 Sa[4];
#pragma unroll
        for (int kb = 0; kb < 4; ++kb)
#pragma unroll
            for (int i = 0; i < 16; ++i) Sa[kb][i] = 0.f;
        __syncthreads();
        for (int c = 0; c < 128; ++c) {
            const int n = dir ? 127 - c : c; const size_t t0 = (size_t)b * S_ + (size_t)n * 64;
            const LAS unsigned char* buf = lds + (c & 1) * SC_BUF;
            u32x2 ur[2][4];
            { const bf16_t* up = uTg + ((size_t)(b * 4 + hh) * 128 + 32 * nb + r) * S_ + (size_t)n * 64 + 4 * h;
#pragma unroll
                for (int tb = 0; tb < 2; ++tb)
#pragma unroll
                    for (int g4 = 0; g4 < 4; ++g4) ur[tb][g4] = *(const u32x2*)(up + 32 * tb + 8 * g4); }
            bf16x8 Sb[4][2];
#pragma unroll
            for (int kb = 0; kb < 4; ++kb) { Sb[kb][0] = pack8n(Sa[kb], 0); Sb[kb][1] = pack8n(Sa[kb], 1); }
            f32x16 X[2], Y[2];
#pragma unroll
            for (int i = 0; i < 16; ++i) { X[0][i] = 0.f; X[1][i] = 0.f; Y[0][i] = 0.f; Y[1][i] = 0.f; }
#pragma unroll
            for (int kb = 0; kb < 4; ++kb)
#pragma unroll
                for (int s = 0; s < 2; ++s)
#pragma unroll
                    for (int tb = 0; tb < 2; ++tb) { const int off = (32 * tb + r) * 264 + (32 * kb + 16 * s + 4 * h) * 2;
                        const s16x4 w0 = *(const LAS s16x4*)(buf + SC_W + off), w1 = *(const LAS s16x4*)(buf + SC_W + off + 16);
                        const s16x4 q0 = *(const LAS s16x4*)(buf + SC_Q + off), q1 = *(const LAS s16x4*)(buf + SC_Q + off + 16);
                        X[tb] = __builtin_amdgcn_mfma_f32_32x32x16_bf16(__builtin_shufflevector(w0, w1, 0, 1, 2, 3, 4, 5, 6, 7), Sb[kb][s], X[tb], 0, 0, 0);
                        Y[tb] = __builtin_amdgcn_mfma_f32_32x32x16_bf16(__builtin_shufflevector(q0, q1, 0, 1, 2, 3, 4, 5, 6, 7), Sb[kb][s], Y[tb], 0, 0, 0); }
            f32x16 vn[2];
#pragma unroll
            for (int tb = 0; tb < 2; ++tb)
#pragma unroll
                for (int g4 = 0; g4 < 4; ++g4) { const u32x2 uu = ur[tb][g4];
                    vn[tb][4 * g4] = bflo(uu.x) - X[tb][4 * g4]; vn[tb][4 * g4 + 1] = bfhi(uu.x) - X[tb][4 * g4 + 1];
                    vn[tb][4 * g4 + 2] = bflo(uu.y) - X[tb][4 * g4 + 2]; vn[tb][4 * g4 + 3] = bfhi(uu.y) - X[tb][4 * g4 + 3]; }
            bf16x8 vb[2][2];
#pragma unroll
            for (int tb = 0; tb < 2; ++tb) { vb[tb][0] = pack8n(vn[tb], 0); vb[tb][1] = pack8n(vn[tb], 1); }
#pragma unroll
            for (int tb = 0; tb < 2; ++tb)
#pragma unroll
                for (int g4 = 0; g4 < 4; ++g4) { const f32x4 e4 = *(const LAS f32x4*)(buf + SC_EG + (32 * tb + 8 * g4 + 4 * h) * 4);
#pragma unroll
                    for (int e = 0; e < 4; ++e) Y[tb][4 * g4 + e] *= e4[e]; }
#pragma unroll
            for (int tb = 0; tb < 2; ++tb)
#pragma unroll
                for (int t2 = 0; t2 < 2; ++t2)
#pragma unroll
                    for (int s = 0; s < 2; ++s) { const int off = (32 * tb + r) * 136 + (32 * t2 + 16 * s + 4 * h) * 2;
                        const s16x4 a0 = *(const LAS s16x4*)(buf + SC_IN + off), a1 = *(const LAS s16x4*)(buf + SC_IN + off + 16);
                        Y[tb] = __builtin_amdgcn_mfma_f32_32x32x16_bf16(__builtin_shufflevector(a0, a1, 0, 1, 2, 3, 4, 5, 6, 7), vb[t2][s], Y[tb], 0, 0, 0); }
#pragma unroll
            for (int tb = 0; tb < 2; ++tb)
#pragma unroll
                for (int g4 = 0; g4 < 4; ++g4) { const f32x4 e4 = *(const LAS f32x4*)(buf + SC_EG + 256 + (32 * tb + 8 * g4 + 4 * h) * 4);
#pragma unroll
                    for (int e = 0; e < 4; ++e) vn[tb][4 * g4 + e] *= e4[e]; }
#pragma unroll
            for (int tb = 0; tb < 2; ++tb) { vb[tb][0] = pack8n(vn[tb], 0); vb[tb][1] = pack8n(vn[tb], 1); }
            const float et = *(const LAS float*)(buf + SC_EG + 512);
#pragma unroll
            for (int kb = 0; kb < 4; ++kb) {
#pragma unroll
                for (int i = 0; i < 16; ++i) Sa[kb][i] *= et;
#pragma unroll
                for (int tb = 0; tb < 2; ++tb)
#pragma unroll
                    for (int s = 0; s < 2; ++s) { const int off = (32 * kb + r) * 136 + (32 * tb + 16 * s + 4 * h) * 2;
                        const s16x4 a0 = *(const LAS s16x4*)(buf + SC_KT + off), a1 = *(const LAS s16x4*)(buf + SC_KT + off + 16);
                        Sa[kb] = __builtin_amdgcn_mfma_f32_32x32x16_bf16(__builtin_shufflevector(a0, a1, 0, 1, 2, 3, 4, 5, 6, 7), vb[tb][s], Sa[kb], 0, 0, 0); } }
#pragma unroll
            for (int tb = 0; tb < 2; ++tb)
#pragma unroll
                for (int x = 0; x < 16; ++x) { const int i = 32 * tb + (x & 3) + 8 * (x >> 2) + 4 * h;
                    out[(t0 + i) * 512 + hh * 128 + 32 * nb + r] = (bf16_t)(pk2(Y[tb][x], 0.f) & 0xffff); }
            __syncthreads();
        }
    }
}

DI bf16x8 pack8(const f32x16& x, int s) {
    u32x4 pk;
    if (s == 0) asm volatile("v_cvt_pk_bf16_f32 %0, %4, %5\n\tv_cvt_pk_bf16_f32 %1, %6, %7\n\tv_cvt_pk_bf16_f32 %2, %8, %9\n\tv_cvt_pk_bf16_f32 %3, %10, %11\n\ts_nop 1"
               : "=&v"(pk[0]), "=&v"(pk[1]), "=&v"(pk[2]), "=&v"(pk[3]) : "v"(x[0]), "v"(x[1]), "v"(x[2]), "v"(x[3]), "v"(x[4]), "v"(x[5]), "v"(x[6]), "v"(x[7]));
    else asm volatile("v_cvt_pk_bf16_f32 %0, %4, %5\n\tv_cvt_pk_bf16_f32 %1, %6, %7\n\tv_cvt_pk_bf16_f32 %2, %8, %9\n\tv_cvt_pk_bf16_f32 %3, %10, %11\n\ts_nop 1"
               : "=&v"(pk[0]), "=&v"(pk[1]), "=&v"(pk[2]), "=&v"(pk[3]) : "v"(x[8]), "v"(x[9]), "v"(x[10]), "v"(x[11]), "v"(x[12]), "v"(x[13]), "v"(x[14]), "v"(x[15]));
    return __builtin_bit_cast(bf16x8, pk);
}
constexpr int AT_KROW = 208, AT_VROW = 136, AT_KBYTES = 64 * AT_KROW, AT_BUF = AT_KBYTES + 64 * AT_VROW;
DI void attn_tile(const LAS unsigned char* kcur, const LAS unsigned char* vcur, const bf16x8 (&bq)[2][6], f32x16 (&oT)[2][2],
                  float (&mrun)[2], float (&lrun)[2], int lane, int r, int hf, int kh) {
    f32x16 sT[2];
#pragma unroll
    for (int i = 0; i < 16; ++i) { sT[0][i] = 0.f; sT[1][i] = 0.f; }
#pragma unroll
    for (int ks = 0; ks < 6; ++ks) { const bf16x8 a = *(const LAS bf16x8*)(kcur + (kh * 32 + r) * AT_KROW + (ks * 16 + 8 * hf) * 2);
        sT[0] = __builtin_amdgcn_mfma_f32_32x32x16_bf16(a, bq[0][ks], sT[0], 0, 0, 0);
        sT[1] = __builtin_amdgcn_mfma_f32_32x32x16_bf16(a, bq[1][ks], sT[1], 0, 0, 0); }
#pragma unroll
    for (int qb = 0; qb < 2; ++qb) {
        float mx = sT[qb][0];
#pragma unroll
        for (int i = 1; i < 16; ++i) mx = fmaxf(mx, sT[qb][i]);
        mx = fmaxf(mx, lane_xor(mx, lane, 32));
        if (__builtin_amdgcn_ballot_w64(mx > mrun[qb] + 8.0f) != 0ull) {
            const float mnew = fmaxf(mrun[qb], mx), alpha = __builtin_amdgcn_exp2f(mrun[qb] - mnew); mrun[qb] = mnew; lrun[qb] *= alpha;
#pragma unroll
            for (int i = 0; i < 16; ++i) { oT[qb][0][i] *= alpha; oT[qb][1][i] *= alpha; }
        }
        float rs = 0.f;
#pragma unroll
        for (int i = 0; i < 16; ++i) { sT[qb][i] = __builtin_amdgcn_exp2f(sT[qb][i] - mrun[qb]); rs += sT[qb][i]; }
        lrun[qb] += rs;
    }
#pragma unroll
    for (int s = 0; s < 2; ++s) { const bf16x8 bp0 = pack8n(sT[0], s), bp1 = pack8n(sT[1], s);
#pragma unroll
        for (int dvb = 0; dvb < 2; ++dvb) { const LAS unsigned char* va = vcur + (dvb * 32 + r) * AT_VROW + (kh * 32 + 16 * s + 4 * hf) * 2;
            const s16x4 lo = *(const LAS s16x4*)va, hi = *(const LAS s16x4*)(va + 16); const bf16x8 a = __builtin_shufflevector(lo, hi, 0, 1, 2, 3, 4, 5, 6, 7);
            oT[0][dvb] = __builtin_amdgcn_mfma_f32_32x32x16_bf16(a, bp0, oT[0][dvb], 0, 0, 0);
            oT[1][dvb] = __builtin_amdgcn_mfma_f32_32x32x16_bf16(a, bp1, oT[1][dvb], 0, 0, 0); } }
}
constexpr int AT_XCH = 45056;
DI void attn_unit(LAS unsigned char* lds, const bf16_t* Q, const bf16_t* Kn, const bf16_t* Kr, const bf16_t* Vt, bf16_t* O, const float* cosT, const float* sinT, int b, int hh, int qblk, const int wv) {
    const int tid = otid(wv), wid = tid >> 6, lane = tid & 63, r = lane & 31, hf = lane >> 5, g = wv & 3, kh = wv >> 2;
    const size_t q0 = (size_t)b * S_ + (size_t)qblk * 256 + g * 64;
    const int kc0 = tid, kc1 = tid + 512; const bool has1 = tid < 256;
    const int key0 = kc0 / 12, part0 = kc0 % 12, key1 = has1 ? kc1 / 12 : 0, part1 = has1 ? kc1 % 12 : 0;
    const bf16_t* ks0 = (part0 < 8) ? Kn + ((size_t)b * S_ + key0) * 512 + hh * 64 + part0 * 8 : Kr + ((size_t)b * S_ + key0) * 32 + (part0 - 8) * 8;
    const bf16_t* ks1 = (part1 < 8) ? Kn + ((size_t)b * S_ + key1) * 512 + hh * 64 + part1 * 8 : Kr + ((size_t)b * S_ + key1) * 32 + (part1 - 8) * 8;
    const size_t kst0 = (part0 < 8) ? 512 : 32, kst1 = (part1 < 8) ? 512 : 32;
    const int kd0 = key0 * AT_KROW + part0 * 16, kd1 = key1 * AT_KROW + part1 * 16;
    const int vdv = tid >> 3, vpart = tid & 7;
    const bf16_t* vsrc = Vt + (size_t)(hh * 64 + vdv) * T_ + (size_t)b * S_ + vpart * 8;
    const int vd = AT_KBYTES + vdv * AT_VROW + vpart * 16;
    u32x4 kr0, kr1 = (u32x4){0, 0, 0, 0}, vr;
    kr0 = *(const u32x4*)ks0; if (has1) kr1 = *(const u32x4*)ks1; vr = *(const u32x4*)vsrc;
    bf16x8 bq[2][6];
#pragma unroll
    for (int qb = 0; qb < 2; ++qb) {
#pragma unroll
        for (int ks = 0; ks < 6; ++ks) bq[qb][ks] = *(const bf16x8*)(Q + (q0 + qb * 32 + r) * 768 + hh * 96 + ks * 16 + 8 * hf);
        const float* cp = cosT + (q0 + qb * 32 + r) * 16 + 8 * hf; const float* sp = sinT + (q0 + qb * 32 + r) * 16 + 8 * hf;
        const f32x4 c0 = *(const f32x4*)cp, c1 = *(const f32x4*)(cp + 4), s0 = *(const f32x4*)sp, s1 = *(const f32x4*)(sp + 4);
        const u32x4 x1 = __builtin_bit_cast(u32x4, bq[qb][4]), x2 = __builtin_bit_cast(u32x4, bq[qb][5]); u32x4 y1, y2;
#pragma unroll
        for (int e = 0; e < 4; ++e) { const float a0 = bflo(x1[e]), a1 = bfhi(x1[e]), b0 = bflo(x2[e]), b1 = bfhi(x2[e]);
            const float cc0 = e < 2 ? c0[2 * e] : c1[2 * e - 4], cc1 = e < 2 ? c0[2 * e + 1] : c1[2 * e - 3], ss0 = e < 2 ? s0[2 * e] : s1[2 * e - 4], ss1 = e < 2 ? s0[2 * e + 1] : s1[2 * e - 3];
            y1[e] = pk2(a0 * cc0 - b0 * ss0, a1 * cc1 - b1 * ss1); y2[e] = pk2(b0 * cc0 + a0 * ss0, b1 * cc1 + a1 * ss1); }
        bq[qb][4] = __builtin_bit_cast(bf16x8, y1); bq[qb][5] = __builtin_bit_cast(bf16x8, y2); }
    f32x16 oT[2][2];
#pragma unroll
    for (int i = 0; i < 16; ++i) { oT[0][0][i] = 0.f; oT[0][1][i] = 0.f; oT[1][0][i] = 0.f; oT[1][1][i] = 0.f; }
    float mrun[2] = {-1e30f, -1e30f}, lrun[2] = {0.f, 0.f};
    *(LAS u32x4*)(lds + kd0) = kr0; if (has1) *(LAS u32x4*)(lds + kd1) = kr1;
    *(LAS u32x2*)(lds + vd) = (u32x2){vr.x, vr.y}; *(LAS u32x2*)(lds + vd + 8) = (u32x2){vr.z, vr.w};
    __syncthreads();
    for (int t = 0; t < 128; ++t) {
        const LAS unsigned char* kb_ = lds + (t & 1) * AT_BUF;
        if (t + 1 < 128) { const size_t ko = (size_t)(t + 1) * 64; kr0 = *(const u32x4*)(ks0 + ko * kst0); if (has1) kr1 = *(const u32x4*)(ks1 + ko * kst1); vr = *(const u32x4*)(vsrc + ko); }
        attn_tile(kb_, kb_ + AT_KBYTES, bq, oT, mrun, lrun, lane, r, hf, kh);
        if (t + 1 < 128) { LAS unsigned char* nb = lds + ((t + 1) & 1) * AT_BUF;
            *(LAS u32x4*)(nb + kd0) = kr0; if (has1) *(LAS u32x4*)(nb + kd1) = kr1;
            *(LAS u32x2*)(nb + vd) = (u32x2){vr.x, vr.y}; *(LAS u32x2*)(nb + vd + 8) = (u32x2){vr.z, vr.w}; }
        __syncthreads();
    }
    LAS float* xw = (LAS float*)(lds + AT_XCH) + g * (68 * 64) + lane;
    if (kh == 1) {
#pragma unroll
        for (int qb = 0; qb < 2; ++qb) { xw[(64 + qb) * 64] = mrun[qb]; xw[(64 + 2 + qb) * 64 - 128 + 128] = lrun[qb];
#pragma unroll
            for (int dvb = 0; dvb < 2; ++dvb)
#pragma unroll
                for (int i = 0; i < 16; ++i) xw[((qb * 2 + dvb) * 16 + i) * 64] = oT[qb][dvb][i]; }
    }
    __syncthreads();
    if (kh == 0) {
#pragma unroll
        for (int qb = 0; qb < 2; ++qb) { const float m1 = xw[(64 + qb) * 64], l1 = xw[(66 + qb) * 64 - 128 + 128];
            const float m = fmaxf(mrun[qb], m1), a0 = __builtin_amdgcn_exp2f(mrun[qb] - m), a1 = __builtin_amdgcn_exp2f(m1 - m);
            float l = lrun[qb] * a0 + l1 * a1; l += lane_xor(l, lane, 32); const float inv = 1.0f / l, f0 = a0 * inv, f1 = a1 * inv;
#pragma unroll
            for (int dvb = 0; dvb < 2; ++dvb)
#pragma unroll
                for (int g4 = 0; g4 < 4; ++g4) { float o[4];
#pragma unroll
                    for (int e = 0; e < 4; ++e) o[e] = oT[qb][dvb][4 * g4 + e] * f0 + xw[((qb * 2 + dvb) * 16 + 4 * g4 + e) * 64] * f1;
                    u32x2 w; w.x = pk2(o[0], o[1]); w.y = pk2(o[2], o[3]);
                    *(u32x2*)(O + (q0 + qb * 32 + r) * 512 + hh * 64 + dvb * 32 + 8 * g4 + 4 * hf) = w; } }
    }
}

DI void gdn_gate_norm(const Params& p, unsigned char* ws, int l, const int wv) {
    const bf16_t* of = (const bf16_t*)(ws + WS_OF); const bf16_t* ob = (const bf16_t*)(ws + WS_OB); const bf16_t* z = (const bf16_t*)(ws + WS_Z);
    bf16_t* ag = (bf16_t*)(ws + WS_AG); const float* nw = p.in[11] + l * 128;
    const int tid_ = otid(wv); const int lane = tid_ & 63, wid = tid_ >> 6;
    const f32x4 n0 = *(const f32x4*)(nw + (lane & 15) * 8), n1 = *(const f32x4*)(nw + (lane & 15) * 8 + 4);
    for (int t = (blockIdx.x * 8 + wid) * 2; t < T_; t += gridDim.x * 16) {
        u32x4 a[2], b[2], zz[2];
#pragma unroll
        for (int rr = 0; rr < 2; ++rr) { const size_t o = (size_t)(t + rr) * 512 + lane * 8; a[rr] = *(const u32x4*)(of + o); b[rr] = *(const u32x4*)(ob + o); zz[rr] = *(const u32x4*)(z + o); }
#pragma unroll
        for (int rr = 0; rr < 2; ++rr) { float v[8]; float ss = 0.f;
#pragma unroll
            for (int e = 0; e < 4; ++e) { v[2 * e] = bflo(a[rr][e]) + bflo(b[rr][e]); v[2 * e + 1] = bfhi(a[rr][e]) + bfhi(b[rr][e]); ss += v[2 * e] * v[2 * e] + v[2 * e + 1] * v[2 * e + 1]; }
            ss += lane_xor(ss, lane, 1); ss += lane_xor(ss, lane, 2); ss += lane_xor(ss, lane, 4); ss += lane_xor(ss, lane, 8);
            const float rstd = rsqrtf(ss * (1.0f / 128.f) + EPS_); u32x4 w;
#pragma unroll
            for (int e = 0; e < 4; ++e) { const float w0 = (2 * e < 4) ? n0[2 * e] : n1[2 * e - 4], w1 = (2 * e + 1 < 4) ? n0[2 * e + 1] : n1[2 * e - 3];
                w[e] = pk2(v[2 * e] * rstd * w0 * siluf_(bflo(zz[rr][e])), v[2 * e + 1] * rstd * w1 * siluf_(bfhi(zz[rr][e]))); }
            *(u32x4*)(ag + (size_t)(t + rr) * 512 + lane * 8) = w; }
    }
}

#define XB_TMO      128
#define XB_XCNT(j)  (256  + 64 * (j))
#define XB_XSUB(j)  (1280 + 64 * (j))
#define XB_XGEN(j)  (2304 + 64 * (j))
#define XB_TOP      3328
#define XB_TOPGEN   3392
#define XCD_BAR_WORDS 3456
#define XB_SPIN_CAP (1u << 18)
DI unsigned xb_ld(unsigned* p)              { return __hip_atomic_load(p, __ATOMIC_RELAXED, __HIP_MEMORY_SCOPE_AGENT); }
DI unsigned xb_add(unsigned* p, unsigned v) { return __hip_atomic_fetch_add(p, v, __ATOMIC_RELAXED, __HIP_MEMORY_SCOPE_AGENT); }
DI unsigned xb_xcc_id() { return (unsigned)__builtin_amdgcn_s_getreg((3 << 11) | 20) & 0xFu; }
#define XB_SPIN(cond, bar) do { unsigned _sp = 0; while (cond) { __builtin_amdgcn_s_sleep(1); \
    if ((++_sp & 255u) == 0u) { if (xb_ld(&(bar)[XB_TMO])) break; if (_sp > XB_SPIN_CAP) { atomicAdd(&(bar)[XB_TMO], 1u); break; } } } } while (0)
DI void xcd_barrier_complete(unsigned* bar, unsigned x, unsigned G, unsigned& nloc, unsigned& nx) {
    unsigned sum, cnt, mine, sp = 0u;
    for (;;) {
        sum = 0u; cnt = 0u; mine = 0u;
#pragma unroll
        for (unsigned j = 0; j < 16; ++j) { const unsigned c = xb_ld(&bar[XB_XCNT(j)]); sum += c; cnt += (c > 0u) ? 1u : 0u; mine = (j == x) ? c : mine; }
        if (sum == G) break;
        __builtin_amdgcn_s_sleep(1);
        if ((++sp & 255u) == 0u) { if (xb_ld(&bar[XB_TMO])) break; if (sp > XB_SPIN_CAP) { atomicAdd(&bar[XB_TMO], 1u); break; } }
    }
    nloc = mine > 0u ? mine : 1u; nx = cnt > 0u ? cnt : 1u;
}
DI void xcd_barrier(unsigned* bar, volatile LAS unsigned* st, unsigned G, const int wv) {
    asm volatile("s_waitcnt vmcnt(0)" ::: "memory");
    __syncthreads();
    if (otid(wv) == 0) {
        const unsigned x = xb_xcc_id();
        __builtin_amdgcn_s_waitcnt(0);
        unsigned nloc = st[0], nx = st[1];
        if (nloc == 0u) { xcd_barrier_complete(bar, x, G, nloc, nx); st[0] = nloc; st[1] = nx; }
        const unsigned old = xb_add(&bar[XB_XSUB(x)], 1u);
        const unsigned gen = old / nloc;
        if (old + 1u == (gen + 1u) * nloc) {
            __builtin_amdgcn_fence(__ATOMIC_RELEASE, "agent");
            asm volatile("s_waitcnt vmcnt(0)" ::: "memory");
            const unsigned og = xb_add(&bar[XB_TOP], 1u);
            const unsigned tg = og / nx;
            if (og + 1u == (tg + 1u) * nx) xb_add(&bar[XB_TOPGEN], 1u);
            else XB_SPIN(xb_ld(&bar[XB_TOPGEN]) == tg, bar);
            __builtin_amdgcn_fence(__ATOMIC_ACQUIRE, "agent");
            xb_add(&bar[XB_XGEN(x)], 1u);
            asm volatile("s_waitcnt vmcnt(0)" ::: "memory");
        } else {
            XB_SPIN(xb_ld(&bar[XB_XGEN(x)]) == gen, bar);
            __builtin_amdgcn_fence(__ATOMIC_ACQUIRE, "agent");
            asm volatile("s_waitcnt vmcnt(0)" ::: "memory");
        }
    }
    __syncthreads();
}

__global__ void __launch_bounds__(512, 2) mega(Params p) {
    extern __shared__ __attribute__((aligned(16))) unsigned char shm[];
    LAS unsigned char* lds = (LAS unsigned char*)shm;
    const int wv = __builtin_amdgcn_readfirstlane(threadIdx.x >> 6);
    volatile LAS unsigned* xst = (volatile LAS unsigned*)(lds + 131072);
    if (threadIdx.x < 2) xst[threadIdx.x] = 0u;
    __syncthreads();
    if (threadIdx.x == 0) (void)xb_add((unsigned*)(p.ws + WS_BAR) + XB_XCNT(xb_xcc_id()), 1u);
    const int ph_lo = __builtin_amdgcn_readfirstlane(p.ph_lo), ph_hi = __builtin_amdgcn_readfirstlane(p.ph_hi);
    for (int ph = ph_lo; ph < ph_hi; ++ph) {
        size_t zoff = 0; int G = gridDim.x, bid = blockIdx.x;
        asm volatile("" : "+s"(zoff), "+s"(G), "+s"(bid));
        unsigned char* ws = p.ws + zoff;
        const int gstride = G * 512;
        if (ph == 0) {
            const int gtid = bid * 512 + otid(wv);
            if (bid == 0 && gtid < 16) *((unsigned*)(ws + WS_CTR) + gtid * 64) = 0u;
            const int* pos = (const int*)p.in[1]; float* cosT = (float*)(ws + WS_COS); float* sinT = (float*)(ws + WS_SIN);
            for (int idx = gtid; idx < T_ * 16; idx += gstride) { const int t = idx >> 4, i = idx & 15;
                const double rev = (double)pos[t] * p.invf_rev[i]; const float fr = (float)(rev - rint(rev));
                cosT[idx] = __builtin_amdgcn_cosf(fr); sinT[idx] = __builtin_amdgcn_sinf(fr); }
        } else if (ph == NPH_ - 1) {
            rms_rows<true>(p.out, p.in[23], p.out, wv);
        } else {
            const int l = (ph - 1) / NS_, sl = (ph - 1) % NS_, st = (PROBE_ST >= 0 && sl > PROBE_ST) ? sl - 1 : sl;
            const bool ffn2 = st >= 12; const int fs = ffn2 ? st - 12 : st;
            const float* xin = (l == 0 && st < 3) ? p.in[0] : p.out;
            if ((st < 3 || ffn2)) {
                const int ig = ffn2 ? 20 : 3, iu = ffn2 ? 21 : 4, idn = ffn2 ? 22 : 5, inw = ffn2 ? 19 : 2;
                if (fs == 0 && EN(0)) {
                    const int gtid = bid * 512 + otid(wv);
                    rms_rows<false>(xin, p.in[inw] + (size_t)l * D_, ws + WS_H, wv);
                    conv_w(p.in[ig] + (size_t)l * D_ * FF_, p.in[iu] + (size_t)l * D_ * FF_, FF_, (bf16_t*)(ws + W_GU), 5632, 1024, 1, nullptr, gtid, gstride);
                    conv_w(p.in[idn] + (size_t)l * D_ * FF_, nullptr, D_, (bf16_t*)(ws + W_D), 1024, FF_, 0, nullptr, gtid, gstride);
                } else if (fs == 1 && EN(1)) {
                    pg8::Gemm g{(const bf16_t*)(ws + WS_H), (const bf16_t*)(ws + W_GU), T_, 5632, 1024, 1024, 1024}; pg8::StaticOrder S; S.init(T_, 5632, G, bid);
                    pg8::EpiSwiglu E{(bf16_t*)(ws + WS_BIG), FF_}; pg8::gemm_phase(lds, g, S, E, wv);
                } else if (EN(2)) {
                    pg8::Gemm g{(const bf16_t*)(ws + WS_BIG), (const bf16_t*)(ws + W_D), T_, 1024, FF_, FF_, FF_}; pg8::StaticOrder S; S.init(T_, 1024, G, bid);
                    pg8::EpiResid E{xin, p.out, 0.5f}; pg8::gemm_phase(lds, g, S, E, wv);
                }
            } else if (st == 3 && EN(3)) {
                const int gtid = bid * 512 + otid(wv);
                rms_rows<false>(p.out, p.in[6] + (size_t)l * D_, ws + WS_H, wv);
                const float* win = p.in[7] + (size_t)l * D_ * 4784;
                conv_w(win, nullptr, 4784, (bf16_t*)(ws + W_IN), 2816, 1024, 2, nullptr, gtid, gstride);
                conv_w(win, nullptr, 4784, (bf16_t*)(ws + W_G), 2048, 1024, 3, nullptr, gtid, gstride);
                conv_w(p.in[12] + (size_t)l * 512 * 1024, nullptr, 1024, (bf16_t*)(ws + W_PA), 1024, 512, 0, nullptr, gtid, gstride);
                conv_w(p.in[17] + (size_t)l * 512 * 1024, nullptr, 1024, (bf16_t*)(ws + W_PB), 1024, 512, 0, nullptr, gtid, gstride);
                conv_w(p.in[18] + (size_t)l * 1024 * 1024, nullptr, 1024, (bf16_t*)(ws + W_OUT), 1024, 1024, 0, nullptr, gtid, gstride);
                conv_w(p.in[14] + (size_t)l * 384 * 768, nullptr, 768, (bf16_t*)(ws + W_UQ), 768, 384, 0, nullptr, gtid, gstride);
                conv_w(p.in[16] + (size_t)l * 256 * 1024, nullptr, 1024, (bf16_t*)(ws + W_UK), 512, 256, 4, nullptr, gtid, gstride);
                conv_w(p.in[16] + (size_t)l * 256 * 1024, nullptr, 1024, (bf16_t*)(ws + W_UV), 512, 256, 5, nullptr, gtid, gstride);
            } else if (st == 4 && EN(4)) {
                pg8::Gemm g{(const bf16_t*)(ws + WS_H), (const bf16_t*)(ws + W_IN), T_, 2816, 1024, 1024, 1024}; pg8::StaticOrder S; S.init(T_, 2816, G, bid);
                pg8::EpiBf16 E{(bf16_t*)(ws + WS_GQKV), 1536, 6, (bf16_t*)(ws + WS_Z), 512, 8, (bf16_t*)(ws + WS_REST), 768, 1.0f};
                pg8::gemm_phase(lds, g, S, E, wv);
            } else if (st == 5 && EN(5)) {
                const float* cw = p.in[8] + (size_t)l * 5 * 1536;
                for (int u = bid; u < 2048; u += G) gdn_chunk_pre(lds, ws, cw, p.in[9] + l * 8, p.in[10] + l * 8, u, wv);
                mla_latent_pass(p, ws, l, wv);
            } else if (st == 6 && EN(6)) {
                const bf16_t* rest = (const bf16_t*)(ws + WS_REST);
                if (EN(16)) { pg8::Gemm g{rest, (const bf16_t*)(ws + W_UQ), T_, 768, 384, 768, 384}; pg8::StaticOrder S; S.init(T_, 768, G, bid);
                  pg8::EpiBf16 E{(bf16_t*)(ws + WS_Q), 768, 1000, nullptr, 0, 1000, nullptr, 0, 0.10206207261596575f * 1.4426950408889634f};
                  pg8::gemm_phase(lds, g, S, E, wv); }
                if (EN(17)) { pg8::Gemm g{rest + 384, (const bf16_t*)(ws + W_UK), T_, 512, 256, 768, 256}; pg8::StaticOrder S; S.init(T_, 512, G, bid);
                  pg8::EpiBf16 E{(bf16_t*)(ws + WS_KN), 512, 1000, nullptr, 0, 1000, nullptr, 0, 1.0f};
                  pg8::gemm_phase(lds, g, S, E, wv); }
                if (EN(18)) { pg8::Gemm g{(const bf16_t*)(ws + W_UV), rest + 384, 512, T_, 256, 256, 768}; pg8::StaticOrder S; S.init(512, T_, G, bid);
                  pg8::EpiBf16 E{(bf16_t*)(ws + WS_VT), T_, 1000, nullptr, 0, 1000, nullptr, 0, 1.0f};
                  pg8::gemm_phase(lds, g, S, E, wv); }
            } else if (st == 7 && EN(7)) {
                if (bid < 32) gdn_scan(lds, ws, bid, wv);
                const bf16_t* Q = (const bf16_t*)(ws + WS_Q); const bf16_t* Kn = (const bf16_t*)(ws + WS_KN); const bf16_t* Kr = (const bf16_t*)(ws + WS_KR);
                const bf16_t* Vt = (const bf16_t*)(ws + WS_VT); bf16_t* AO = (bf16_t*)(ws + WS_AO);
                if (G == 256) { const int xcd = bid & 7; unsigned* ctr = (unsigned*)(ws + WS_CTR) + (l * 8 + xcd) * 64;
                    const bool t0 = otid(wv) == 0; unsigned nxt = 0u; if (t0) nxt = atomicAdd(ctr, 1u);
                    for (;;) { __syncthreads(); if (t0) *(LAS unsigned*)(lds + 131072 + 32) = nxt; __syncthreads();
                        const unsigned u = *(const LAS unsigned*)(lds + 131072 + 32); if (u >= 128u) break;
                        if (t0) nxt = atomicAdd(ctr, 1u);
                        const int pair = (int)(u >> 5) * 8 + xcd; attn_unit(lds, Q, Kn, Kr, Vt, AO, (const float*)(ws + WS_COS), (const float*)(ws + WS_SIN), pair >> 3, pair & 7, (int)(u & 31), wv); } }
                else for (int u = bid; u < 1024; u += G) { const int pair = u >> 5; attn_unit(lds, Q, Kn, Kr, Vt, AO, (const float*)(ws + WS_COS), (const float*)(ws + WS_SIN), pair >> 3, pair & 7, u & 31, wv); }
            } else if (st == 8 && EN(8)) {
                gdn_gate_norm(p, ws, l, wv);
                rms_rows<false>(p.out, p.in[6] + (size_t)l * D_, ws + WS_H2, wv);
            } else if (st == 9 && EN(9)) {
                { pg8::Gemm g{(const bf16_t*)(ws + WS_AG), (const bf16_t*)(ws + W_PA), T_, 1024, 512, 512, 512}; pg8::StaticOrder S; S.init(T_, 1024, G, bid);
                  pg8::EpiBf16 E{(bf16_t*)(ws + WS_YA), 1024, 1000, nullptr, 0, 1000, nullptr, 0, 1.0f}; pg8::gemm_phase(lds, g, S, E, wv); }
                { pg8::Gemm g{(const bf16_t*)(ws + WS_AO), (const bf16_t*)(ws + W_PB), T_, 1024, 512, 512, 512}; pg8::StaticOrder S; S.init(T_, 1024, G, bid);
                  pg8::EpiBf16 E{(bf16_t*)(ws + WS_YB), 1024, 1000, nullptr, 0, 1000, nullptr, 0, 1.0f}; pg8::gemm_phase(lds, g, S, E, wv); }
            } else if (st == 10 && EN(10)) {
                pg8::Gemm g{(const bf16_t*)(ws + WS_H2), (const bf16_t*)(ws + W_G), T_, 2048, 1024, 1024, 1024}; pg8::StaticOrder S; S.init(T_, 2048, G, bid);
                pg8::EpiGate E{(const bf16_t*)(ws + WS_YA), (const bf16_t*)(ws + WS_YB), (bf16_t*)(ws + WS_Y)}; pg8::gemm_phase(lds, g, S, E, wv);
            } else if (st == 11 && EN(11)) {
                pg8::Gemm g{(const bf16_t*)(ws + WS_Y), (const bf16_t*)(ws + W_OUT), T_, 1024, 1024, 1024, 1024}; pg8::StaticOrder S; S.init(T_, 1024, G, bid);
                pg8::EpiResid E{p.out, p.out, 1.0f}; pg8::gemm_phase(lds, g, S, E, wv);
            }
        }
        if (ph + 1 < ph_hi) {
            if (ph == ph_lo) cg::this_grid().sync(); else xcd_barrier((unsigned*)(ws + WS_BAR), xst, (unsigned)G, wv);
            for (int e = 0; e < PROBE_SYNC; ++e) xcd_barrier((unsigned*)(ws + WS_BAR), xst, (unsigned)G, wv); }
    }
}

extern "C" void kernel_launch(void* const* d_in, const int* in_sizes, int n_in, void* d_out, int out_size, void* d_ws, size_t ws_size, hipStream_t stream) {
    static int grid = 0;
    if (grid == 0) {
        if (ws_size < WS_END) { fprintf(stderr, "kernel_launch: workspace too small: %zu < %zu\n", ws_size, (size_t)WS_END); grid = -1; return; }
        int dev = 0, cus = 0;
        hipGetDevice(&dev); hipDeviceGetAttribute(&cus, hipDeviceAttributeMultiprocessorCount, dev);
        if (hipFuncSetAttribute((const void*)mega, hipFuncAttributeMaxDynamicSharedMemorySize, LDS_BYTES) != hipSuccess) { fprintf(stderr, "hipFuncSetAttribute failed\n"); grid = -1; return; }
        int per_cu = 0;
        if (hipOccupancyMaxActiveBlocksPerMultiprocessor(&per_cu, (const void*)mega, 512, LDS_BYTES) != hipSuccess || per_cu < 1) { fprintf(stderr, "occupancy query: %d\n", per_cu); per_cu = 1; }
        (void)hipGetLastError();
        grid = cus;
    }
    if (grid < 0) return;
    Params p{};
    for (int i = 0; i < 24; ++i) p.in[i] = (const float*)d_in[i];
    p.out = (float*)d_out; p.ws = (unsigned char*)d_ws;
    for (int i = 0; i < 16; ++i) p.invf_rev[i] = pow(10000.0, -(double)i / 16.0) / 6.283185307179586476925286766559;
#if COOP
    (void)hipMemsetAsync((unsigned char*)d_ws + WS_BAR, 0, 3456 * 4, stream);
    p.ph_lo = 0; p.ph_hi = NPH_;
    void* args[] = {&p};
    hipError_t e = hipLaunchCooperativeKernel((const void*)mega, dim3(grid), dim3(512), args, LDS_BYTES, stream);
    if (e != hipSuccess) fprintf(stderr, "cooperative launch failed: %s\n", hipGetErrorString(e));
#else
    for (int ph = 0; ph < NPH_; ++ph) { p.ph_lo = ph; p.ph_hi = ph + 1; hipLaunchKernelGGL(mega, dim3(grid), dim3(512), LDS_BYTES, stream, p); }
#endif
}
```
